# Optimizing an MI355X kernel written in HIP

```python
import math
import jax, jax.numpy as jnp
from jax import lax
import numpy as np

D_MODEL = 2048
BATCH = 16
SEQ = 256
DEPTH = 2
DEC_BATCH = 2
DEC_SEQ = 1024
PAST_LEN = 512

GRID_W = 64
HEAD_DIM = 128
N_Q_HEADS = D_MODEL // 2 // HEAD_DIM
N_KV_HEADS = 2
Q_PER_KV = N_Q_HEADS // N_KV_HEADS
ATTN_W = N_Q_HEADS * HEAD_DIM
KV_W = N_KV_HEADS * HEAD_DIM
SSM_W = D_MODEL // 4
SSM_GROUP = 16
SSM_GROUPS = SSM_W // SSM_GROUP
SSM_STATE = 64
RET_HEADS = D_MODEL // 4 // HEAD_DIM
RET_W = RET_HEADS * HEAD_DIM
MIX_W = ATTN_W + SSM_W + RET_W
IN_SIZES = (ATTN_W, KV_W, KV_W, SSM_W, RET_W, RET_W, RET_W, RET_W)
IN_W = ATTN_W + 2 * KV_W + SSM_W + 4 * RET_W
D_FF = 256 * ((8 * D_MODEL // 3 + 255) // 256)
N_SUB = 3
Q_BLOCK = 128
RET_CHUNK = 128
ROPE_BASE = 10000.0
ROPE_FREQS = HEAD_DIM // 4
EPS = 1e-6

kernel_name = "hybrid_diffusion_trunk_step"


def rmsnorm(x, g):
    x32 = x.astype(jnp.float32)
    y = x32 * lax.rsqrt(jnp.mean(x32 * x32, axis=-1, keepdims=True) + EPS)
    return (y * g.astype(jnp.float32)).astype(x.dtype)


def grid_rope(length):
    rows = length // GRID_W
    r = jnp.repeat(jnp.arange(rows), GRID_W).astype(jnp.float32)
    col = jnp.tile(jnp.arange(GRID_W), rows).astype(jnp.float32)
    inv = ROPE_BASE ** (-jnp.arange(ROPE_FREQS, dtype=jnp.float32) / ROPE_FREQS)
    ang = jnp.stack([r, col], axis=-1)[:, :, None] * inv
    return jnp.cos(ang), jnp.sin(ang)


def apply_rope(x, rope):
    cos, sin = rope
    b, l, h, d = x.shape
    x4 = x.astype(jnp.float32).reshape(b, l, h, 2, 2, ROPE_FREQS)
    rot = jnp.stack([-x4[..., 1, :], x4[..., 0, :]], axis=-2)
    c4 = cos[None, :, None, :, None, :]
    s4 = sin[None, :, None, :, None, :]
    return (x4 * c4 + rot * s4).reshape(b, l, h, d).astype(x.dtype)


def adaln(cond, w, b):
    m = (jax.nn.silu(cond) @ w + b).reshape(cond.shape[0], N_SUB, 3, D_MODEL)
    return m[:, :, 0], m[:, :, 1], m[:, :, 2]


def swiglu(x, w_in, w_out):
    a, u = jnp.split(x @ w_in, 2, axis=-1)
    return (jax.nn.silu(a) * u) @ w_out


def block_attention(q, k, v):
    b, lq = q.shape[:2]
    nb = lq // Q_BLOCK
    qb = jnp.moveaxis(q.reshape(b, nb, Q_BLOCK, N_KV_HEADS, Q_PER_KV, HEAD_DIM), 1, 0)
    scale = HEAD_DIM ** -0.5

    def one(qc):
        s = jnp.einsum("bqkgd,bskd->bkgqs", qc, k, preferred_element_type=jnp.float32) * scale
        p = jax.nn.softmax(s, axis=-1).astype(v.dtype)
        return jnp.einsum("bkgqs,bskd->bqkgd", p, v)

    out = lax.map(one, qb)
    return jnp.moveaxis(out, 0, 1).reshape(b, lq, ATTN_W)


def _lin_rec(e1, e2):
    a1, b1 = e1
    a2, b2 = e2
    return a1 * a2, a2 * b1 + b2


def s5_scan(u, a_re, a_im, log_dt, b_re, b_im, c_re, c_im, h0):
    lam = lax.complex(a_re.astype(jnp.float32), a_im.astype(jnp.float32))
    lam_bar = jnp.exp(lam * jnp.exp(log_dt.astype(jnp.float32))[:, None])
    bmat = lax.complex(b_re.astype(jnp.float32), b_im.astype(jnp.float32))
    b_bar = ((lam_bar - 1.0) / lam)[..., None] * bmat
    bu = jnp.einsum("gph,blgh->blgp", b_bar, u.astype(jnp.complex64))
    bu = bu.at[:, 0].add(lam_bar[None] * h0)
    a = jnp.broadcast_to(lam_bar, bu.shape)
    _, xs = lax.associative_scan(_lin_rec, (a, bu), axis=1)
    cmat = lax.complex(c_re.astype(jnp.float32), c_im.astype(jnp.float32))
    y = jnp.real(jnp.einsum("ghp,blgp->blgh", cmat, xs))
    return y, xs[:, -1]


def s5_mixer(u, p, h0):
    b, l, _ = u.shape
    u32 = u.astype(jnp.float32)
    ug = u32.reshape(b, l, SSM_GROUPS, SSM_GROUP)

    def run(d, seq):
        return s5_scan(seq, p["ssm_a_re"][d], p["ssm_a_im"][d], p["ssm_log_dt"][d],
                       p["ssm_b_re"][d], p["ssm_b_im"][d], p["ssm_c_re"][d], p["ssm_c_im"][d], h0[:, d])

    y_f, h_f = run(0, ug)
    y_b, h_b = run(1, ug[:, ::-1])
    y = (y_f + y_b[:, ::-1]).reshape(b, l, SSM_W) + p["ssm_d"].astype(jnp.float32) * u32
    z = jax.nn.gelu(y).astype(u.dtype) @ p["w_ssm_glu"]
    return z[..., :SSM_W] * jax.nn.sigmoid(z[..., SSM_W:]), jnp.stack([h_f, h_b], axis=1)


def retention_scan(q, k, v, log_g, s0):
    b, l = q.shape[:2]
    n = l // RET_CHUNK

    def chunks(t):
        return jnp.moveaxis(t.reshape(b, n, RET_CHUNK, RET_HEADS, HEAD_DIM), 1, 0)

    idx = jnp.arange(RET_CHUNK, dtype=jnp.float32)
    diff = idx[:, None] - idx[None, :]
    inner = jnp.where(diff >= 0, jnp.exp(jnp.maximum(diff, 0.0)[None] * log_g[:, None, None]), 0.0)
    q_dec = jnp.exp((idx[:, None] + 1.0) * log_g[None])
    k_dec = jnp.exp((RET_CHUNK - 1.0 - idx)[:, None] * log_g[None])
    c_dec = jnp.exp(RET_CHUNK * log_g)

    def step(s, qkv):
        qc, kc, vc = qkv
        att = jnp.einsum("bihd,bjhd->bhij", qc, kc) * inner
        o = (jnp.einsum("bhij,bjhe->bihe", att, vc)
             + jnp.einsum("bihd,bhde->bihe", qc, s) * q_dec[None, :, :, None])
        s = s * c_dec[None, :, None, None] + jnp.einsum("bjhd,bjhe->bhde", kc * k_dec[None, :, :, None], vc)
        return s, o

    s_fin, o = lax.scan(step, s0, (chunks(q), chunks(k), chunks(v)))
    return jnp.moveaxis(o, 0, 1).reshape(b, l, RET_HEADS, HEAD_DIM), s_fin


def retention(q, k, v, g, decay_logit, s0):
    b, l = q.shape[:2]
    log_g = jax.nn.log_sigmoid(decay_logit.astype(jnp.float32))
    q32, k32, v32 = (t.astype(jnp.float32) for t in (q, k, v))
    o_f, s_f = retention_scan(q32, k32, v32, log_g[0], s0[:, 0])
    o_b, s_b = retention_scan(q32[:, ::-1], k32[:, ::-1], v32[:, ::-1], log_g[1], s0[:, 1])
    o = o_f + o_b[:, ::-1]
    o = o - jnp.mean(o, axis=-1, keepdims=True)
    o = o * lax.rsqrt(jnp.mean(o * o, axis=-1, keepdims=True) + EPS)
    out = o.reshape(b, l, RET_W) * jax.nn.silu(g.astype(jnp.float32))
    return out.astype(g.dtype), jnp.stack([s_f, s_b], axis=1)


def mixer(h, p, rope, ctx):
    b, l, _ = h.shape
    cuts = [int(i) for i in np.cumsum(IN_SIZES)[:-1]]
    qa, ka, va, us, qr, kr, vr, gr = jnp.split(h @ p["w_in"], cuts, axis=-1)
    qa = rmsnorm(qa.reshape(b, l, N_Q_HEADS, HEAD_DIM), p["q_norm_g"])
    ka = rmsnorm(ka.reshape(b, l, N_KV_HEADS, HEAD_DIM), p["k_norm_g"])
    va = va.reshape(b, l, N_KV_HEADS, HEAD_DIM)
    qr = qr.reshape(b, l, RET_HEADS, HEAD_DIM)
    kr = kr.reshape(b, l, RET_HEADS, HEAD_DIM) * HEAD_DIM ** -0.5
    vr = vr.reshape(b, l, RET_HEADS, HEAD_DIM)
    if ctx is None:
        k_all, v_all = ka, va
        h0 = jnp.zeros((b, 2, SSM_GROUPS, SSM_STATE), jnp.complex64)
        s0 = jnp.zeros((b, 2, RET_HEADS, HEAD_DIM, HEAD_DIM), jnp.float32)
    else:
        k_ctx, v_ctx, h0, s0 = ctx
        qa, ka, qr, kr = (apply_rope(t, rope) for t in (qa, ka, qr, kr))
        k_all = jnp.concatenate([k_ctx.astype(ka.dtype), ka], axis=1)
        v_all = jnp.concatenate([v_ctx.astype(va.dtype), va], axis=1)
    attn = block_attention(qa.reshape(b, l, N_KV_HEADS, Q_PER_KV, HEAD_DIM), k_all, v_all)
    ssm, h_fin = s5_mixer(us, p, h0)
    ret, s_fin = retention(qr, kr, vr, gr, p["ret_decay_logit"], s0)
    out = jnp.concatenate([attn, ssm.astype(attn.dtype), ret.astype(attn.dtype)], axis=-1) @ p["w_out"]
    return out, ((ka, va, h_fin, s_fin) if ctx is None else None)


def layer(x, mod, p, rope, ctx):
    shift, scale, gate = mod

    def pre(x, i):
        return rmsnorm(x, p["norm_g"][i]) * (1.0 + scale[:, i, None]) + shift[:, i, None]

    x = x + 0.5 * gate[:, 0, None] * swiglu(pre(x, 0), p["w_ffn_in"][0], p["w_ffn_out"][0])
    y, ctx_out = mixer(pre(x, 1), p, rope, ctx)
    x = x + gate[:, 1, None] * y
    x = x + 0.5 * gate[:, 2, None] * swiglu(pre(x, 2), p["w_ffn_in"][1], p["w_ffn_out"][1])
    return x, ctx_out


def setup_inputs(seed: int = 0) -> dict:
    key = jax.random.key(seed)
    ks = jax.random.split(key, 32)
    f32 = jnp.float32

    def nrm(k, shape, s):
        return jax.random.normal(k, shape, f32) * s

    a_im0 = jnp.pi * jnp.arange(SSM_STATE, dtype=f32)
    ret_logit0 = jnp.log(2.0 ** (5.0 + jnp.arange(RET_HEADS, dtype=f32)) - 1.0)
    return {
        "x_prompt": nrm(ks[0], (BATCH, SEQ, D_MODEL), 1.0),
        "x_sample": nrm(ks[1], (DEC_BATCH, DEC_SEQ, D_MODEL), 1.0),
        "cache_k": nrm(ks[2], (DEC_BATCH, DEPTH, PAST_LEN, N_KV_HEADS, HEAD_DIM), 1.0),
        "cache_v": nrm(ks[3], (DEC_BATCH, DEPTH, PAST_LEN, N_KV_HEADS, HEAD_DIM), 1.0),
        "state_ssm": nrm(ks[4], (DEC_BATCH, DEPTH, 2, SSM_GROUPS, SSM_STATE, 2), 0.1),
        "state_ret": nrm(ks[5], (DEC_BATCH, DEPTH, 2, RET_HEADS, HEAD_DIM, HEAD_DIM), 0.5),
        "c": nrm(ks[6], (DEC_BATCH, D_MODEL), 1.0),
        "c_ctx": nrm(ks[7], (D_MODEL,), 1.0),
        "w_mod": nrm(ks[8], (DEPTH, D_MODEL, N_SUB * 3 * D_MODEL), 0.5 * D_MODEL ** -0.5),
        "b_mod": nrm(ks[9], (DEPTH, N_SUB * 3 * D_MODEL), 0.02),
        "norm_g": 1.0 + nrm(ks[10], (DEPTH, N_SUB, D_MODEL), 0.02),
        "w_ffn_in": nrm(ks[11], (DEPTH, 2, D_MODEL, 2 * D_FF), D_MODEL ** -0.5),
        "w_ffn_out": nrm(ks[12], (DEPTH, 2, D_FF, D_MODEL), D_FF ** -0.5),
        "w_in": nrm(ks[13], (DEPTH, D_MODEL, IN_W), D_MODEL ** -0.5),
        "w_out": nrm(ks[14], (DEPTH, MIX_W, D_MODEL), MIX_W ** -0.5),
        "q_norm_g": 1.0 + nrm(ks[15], (DEPTH, HEAD_DIM), 0.02),
        "k_norm_g": 1.0 + nrm(ks[16], (DEPTH, HEAD_DIM), 0.02),
        "ssm_a_re": -0.5 + nrm(ks[17], (DEPTH, 2, SSM_GROUPS, SSM_STATE), 0.01),
        "ssm_a_im": a_im0 + nrm(ks[18], (DEPTH, 2, SSM_GROUPS, SSM_STATE), 0.01),
        "ssm_log_dt": jax.random.uniform(ks[19], (DEPTH, 2, SSM_GROUPS), f32, math.log(1e-3), math.log(1e-1)),
        "ssm_b_re": nrm(ks[20], (DEPTH, 2, SSM_GROUPS, SSM_STATE, SSM_GROUP), (2 * SSM_GROUP) ** -0.5),
        "ssm_b_im": nrm(ks[21], (DEPTH, 2, SSM_GROUPS, SSM_STATE, SSM_GROUP), (2 * SSM_GROUP) ** -0.5),
        "ssm_c_re": nrm(ks[22], (DEPTH, 2, SSM_GROUPS, SSM_GROUP, SSM_STATE), SSM_STATE ** -0.5),
        "ssm_c_im": nrm(ks[23], (DEPTH, 2, SSM_GROUPS, SSM_GROUP, SSM_STATE), SSM_STATE ** -0.5),
        "ssm_d": nrm(ks[24], (DEPTH, SSM_W), 1.0),
        "w_ssm_glu": nrm(ks[25], (DEPTH, SSM_W, 2 * SSM_W), SSM_W ** -0.5),
        "ret_decay_logit": ret_logit0 + nrm(ks[26], (DEPTH, 2, RET_HEADS), 0.01),
        "final_norm_g": 1.0 + nrm(ks[27], (D_MODEL,), 0.02),
    }


def reference(x_prompt, x_sample, cache_k, cache_v, state_ssm, state_ret, c, c_ctx,
              w_mod, b_mod, norm_g, w_ffn_in, w_ffn_out, w_in, w_out, q_norm_g, k_norm_g,
              ssm_a_re, ssm_a_im, ssm_log_dt, ssm_b_re, ssm_b_im, ssm_c_re, ssm_c_im, ssm_d,
              w_ssm_glu, ret_decay_logit, final_norm_g):
    rope = grid_rope(x_sample.shape[1])
    xp, xs = x_prompt, x_sample
    ks_, vs_, hs_, ss_ = [], [], [], []
    for l in range(DEPTH):
        p = {
            "norm_g": norm_g[l], "w_ffn_in": w_ffn_in[l], "w_ffn_out": w_ffn_out[l],
            "w_in": w_in[l], "w_out": w_out[l], "q_norm_g": q_norm_g[l], "k_norm_g": k_norm_g[l],
            "ssm_a_re": ssm_a_re[l], "ssm_a_im": ssm_a_im[l], "ssm_log_dt": ssm_log_dt[l],
            "ssm_b_re": ssm_b_re[l], "ssm_b_im": ssm_b_im[l], "ssm_c_re": ssm_c_re[l],
            "ssm_c_im": ssm_c_im[l], "ssm_d": ssm_d[l], "w_ssm_glu": w_ssm_glu[l],
            "ret_decay_logit": ret_decay_logit[l],
        }
        xp, (k_l, v_l, h_l, s_l) = layer(xp, adaln(c_ctx[None], w_mod[l], b_mod[l]), p, None, None)
        ks_.append(k_l)
        vs_.append(v_l)
        hs_.append(jnp.stack([jnp.real(h_l), jnp.imag(h_l)], axis=-1))
        ss_.append(s_l)
        st = state_ssm[:, l]
        ctx_l = (cache_k[:, l], cache_v[:, l],
                 lax.complex(st[..., 0].astype(jnp.float32), st[..., 1].astype(jnp.float32)),
                 state_ret[:, l].astype(jnp.float32))
        xs, _ = layer(xs, adaln(c, w_mod[l], b_mod[l]), p, rope, ctx_l)
    y_prompt = rmsnorm(xp, final_norm_g)
    y_sample = rmsnorm(xs, final_norm_g)
    new_cache_k = jnp.stack(ks_, axis=1)
    new_cache_v = jnp.stack(vs_, axis=1)
    new_state_ssm = jnp.stack(hs_, axis=1)
    new_state_ret = jnp.stack(ss_, axis=1)
    return (y_prompt, y_sample, new_cache_k, new_cache_v, new_state_ssm, new_state_ret)
```

```cpp
#include <hip/hip_runtime.h>
#include <cstdio>
#include <cstdint>
#include <cmath>

constexpr int DM = 2048, NPR = 4096, NSR = 2048, MT = 6144, DFF = 5632, INW = 4096;
constexpr int SEQ = 256, DSEQ = 1024, PAST = 512, NBP = 16, NBS = 2, NLAYER = 2;
constexpr int KALL = PAST + DSEQ;
constexpr int MODW = 9 * DM;
constexpr float EPS = 1e-6f;
constexpr int C_QA = 0, C_KA = 1024, C_VA = 1280, C_US = 1536, C_QR = 2048, C_KR = 2560, C_VR = 3072, C_GR = 3584;
constexpr size_t O_Y = 0, O_CK = 12582912, O_CV = 14680064, O_SSM = 16777216, O_RET = 17039360, O_END = 21233664;

namespace pg8 {
#define PG8_LAS __attribute__((address_space(3)))
typedef unsigned short bf16_t;
typedef short bf16x8 __attribute__((ext_vector_type(8)));
typedef float f32x4 __attribute__((ext_vector_type(4)));
typedef unsigned u32x4 __attribute__((ext_vector_type(4)));
constexpr int BM = 256, BK = 64, HALF = 128, HTB = HALF * BK * 2, STAGE_BYTES = 8 * HTB, NXCD = 8, WGM = 8;

__host__ __device__ __forceinline__ int lds_byte(int r, int c) { const int st = (r >> 4) * 2 + (c >> 5), rr = r & 15, cc = c & 31, ob = rr * 64 + cc * 2; return st * 1024 + (ob ^ (((ob >> 9) & 1) << 5)); }
__host__ __device__ __forceinline__ void stage_rc(int b, int& R, int& C) { const int st = b / 1024, sb = b % 1024, swz = sb ^ (((sb >> 9) & 1) << 5); R = (st >> 1) * 16 + swz / 64; C = (st & 1) * 32 + (swz % 64) / 2; }
__host__ __device__ __forceinline__ int perm32(int rho) { const int n = rho >> 4, i = rho & 15; return 8 * (i >> 2) + 4 * n + (i & 3); }

struct Unit { int pm, pn; };
struct Gemm { const bf16_t* A; const bf16_t* Bt; int M, N, K; };

struct StaticOrder {
    int nM, nN, nwg, G, c;
    __host__ __device__ void init(int M, int N, int G_, int c_) { nM = M / BM; nN = N / BM; nwg = nM * nN; G = G_; c = c_; }
    __host__ __device__ bool next(int i, Unit& u) const {
        const long L = (long)i * G + c; if (L >= nwg) return false;
        int wgid = (int)L; { const int q = nwg / NXCD, r = nwg % NXCD, xcd = wgid % NXCD, off = wgid / NXCD; wgid = (xcd < r ? xcd * (q + 1) : r * (q + 1) + (xcd - r) * q) + off; }
        const int nig = WGM * nN, gid = wgid / nig, fm = gid * WGM, gsz = (nM - fm) < WGM ? (nM - fm) : WGM;
        u.pm = fm + ((wgid % nig) % gsz); u.pn = (wgid % nig) / gsz; return true;
    }
    __device__ __forceinline__ void a_ready(const Unit&) const {}
    __device__ __forceinline__ void done(const Unit&) const {}
};

__device__ __forceinline__ unsigned cvt_pk_bf16(float lo, float hi) { unsigned r; asm volatile("v_cvt_pk_bf16_f32 %0, %1, %2" : "=v"(r) : "v"(lo), "v"(hi)); return r; }
__device__ __forceinline__ float fast_sigmoid(float x) { return __builtin_amdgcn_rcpf(1.0f + __builtin_amdgcn_exp2f(-1.4426950408889634f * x)); }

struct EpiBf16 {
    static constexpr bool PERM = true, AFTER_DRAIN = false;
    bf16_t* O; int ldc;
    __device__ __forceinline__ void operator()(const f32x4 (&acc)[2][2][4][2], const Unit& u, int wr, int wc, int fr, int fq) const {
        const int row0 = u.pm * BM + wr * 64 + fr; const int col0 = u.pn * BM + wc * 32 + 8 * fq;
#pragma unroll
        for (int ai = 0; ai < 2; ++ai)
#pragma unroll
            for (int m = 0; m < 4; ++m) { bf16_t* rowp = O + (size_t)(row0 + ai * HALF + m * 16) * ldc + col0;
#pragma unroll
                for (int bj = 0; bj < 2; ++bj) { const f32x4 v0 = acc[ai][bj][m][0], v1 = acc[ai][bj][m][1];
                    u32x4 w; w.x = cvt_pk_bf16(v0[0], v0[1]); w.y = cvt_pk_bf16(v0[2], v0[3]); w.z = cvt_pk_bf16(v1[0], v1[1]); w.w = cvt_pk_bf16(v1[2], v1[3]);
                    *(u32x4*)(rowp + bj * HALF) = w; } }
    }
};
template <int ACT> struct EpiPair {
    static constexpr bool PERM = true, AFTER_DRAIN = false;
    bf16_t* O; int ldc; int coff;
    __device__ __forceinline__ void operator()(const f32x4 (&acc)[2][2][4][2], const Unit& u, int wr, int wc, int fr, int fq) const {
        const int row0 = u.pm * BM + wr * 64 + fr; const int col0 = coff + u.pn * HALF + wc * 32 + 8 * fq;
#pragma unroll
        for (int ai = 0; ai < 2; ++ai)
#pragma unroll
            for (int m = 0; m < 4; ++m) { bf16_t* rowp = O + (size_t)(row0 + ai * HALF + m * 16) * ldc + col0;
                float r[8];
#pragma unroll
                for (int n = 0; n < 2; ++n)
#pragma unroll
                    for (int j = 0; j < 4; ++j) { const float a = acc[ai][0][m][n][j], g = acc[ai][1][m][n][j];
                        r[n * 4 + j] = (ACT == 0) ? a * fast_sigmoid(a) * g : a * fast_sigmoid(g); }
                u32x4 w; w.x = cvt_pk_bf16(r[0], r[1]); w.y = cvt_pk_bf16(r[2], r[3]); w.z = cvt_pk_bf16(r[4], r[5]); w.w = cvt_pk_bf16(r[6], r[7]);
                *(u32x4*)rowp = w; }
    }
};
struct EpiResid {
    static constexpr bool PERM = false, AFTER_DRAIN = false;
    float* X; const float* gate0; int gstride; float s;
    __device__ __forceinline__ void operator()(const f32x4 (&acc)[2][2][4][2], const Unit& u, int wr, int wc, int fr, int fq) const {
        const int row0 = u.pm * BM + wr * 64 + fr, col0 = u.pn * BM + wc * 32 + 4 * fq;
        const int var = u.pm < 16 ? 0 : (u.pm < 20 ? 1 : 2);
        const float* gp = gate0 + (size_t)var * gstride + col0;
        f32x4 gv[2][2];
#pragma unroll
        for (int bj = 0; bj < 2; ++bj)
#pragma unroll
            for (int n = 0; n < 2; ++n) gv[bj][n] = *(const f32x4*)(gp + bj * HALF + n * 16) * s;
#pragma unroll
        for (int ai = 0; ai < 2; ++ai)
#pragma unroll
            for (int m = 0; m < 4; ++m) { float* rowp = X + (size_t)(row0 + ai * HALF + m * 16) * DM + col0;
#pragma unroll
                for (int bj = 0; bj < 2; ++bj)
#pragma unroll
                    for (int n = 0; n < 2; ++n) { float* p = rowp + bj * HALF + n * 16; const f32x4 x = *(const f32x4*)p; *(f32x4*)p = x + gv[bj][n] * acc[ai][bj][m][n]; } }
    }
};

template <class Epi, class Sched, bool ALIGN_EPI = false, bool SP2 = false>
__device__ __forceinline__ void gemm_phase(PG8_LAS unsigned char* lds, const Gemm g, const Sched& S, const Epi& E) {
    int tid_ = threadIdx.x; asm volatile("" : "+v"(tid_));
    const int tid = tid_, wid = __builtin_amdgcn_readfirstlane(tid >> 6), lane = tid & 63, wr = wid >> 2, wc = wid & 3, fr = lane & 15, fq = lane >> 4;
    const int K = g.K, nt = K / BK;
    unsigned voffA[2], voffB[2];
#pragma unroll
    for (int i = 0; i < 2; ++i) { int R, C; stage_rc(tid * 16 + i * 8192, R, C); const int Rb = Epi::PERM ? ((R & ~31) + perm32(R & 31)) : R;
        voffA[i] = (unsigned)(R * K + C) * 2u; voffB[i] = (unsigned)(Rb * K + C) * 2u; }
    const size_t kstep = (size_t)(BK * 2);
    const size_t hstep = (size_t)HALF * K * 2;
    const size_t tstep = 2 * hstep;
    const unsigned ldsw = (unsigned)wid * 1024u;
    const int aoff = lds_byte(wr * 64 + fr, fq * 8), boff = lds_byte(wc * 32 + fr, fq * 8);
#define PG8_SA(b, h) (((b) * 2 + (h)) * HTB)
#define PG8_SB(b, h) ((4 + (b) * 2 + (h)) * HTB)
#define PG8_STAGE(bufoff, gbase, voff) do { _Pragma("unroll") for (int _i = 0; _i < 2; ++_i) \
        __builtin_amdgcn_global_load_lds((const unsigned*)((const char*)(gbase) + (voff)[_i]), (PG8_LAS unsigned*)(lds + (bufoff) + ldsw + _i * 8192), 16, 0, 0); } while (0)
#define PG8_LDA(dst, b, h) do { _Pragma("unroll") for (int m = 0; m < 4; ++m) _Pragma("unroll") for (int k = 0; k < 2; ++k) dst[m][k] = *(const PG8_LAS bf16x8*)(lds + PG8_SA(b, h) + aoff + m * 2048 + k * 1024); } while (0)
#define PG8_LDB(dst, b, h) do { _Pragma("unroll") for (int n = 0; n < 2; ++n) _Pragma("unroll") for (int k = 0; k < 2; ++k) dst[n][k] = *(const PG8_LAS bf16x8*)(lds + PG8_SB(b, h) + boff + n * 2048 + k * 1024); } while (0)
#define PG8_MMA(ai, bj, At, Bt) do { __builtin_amdgcn_s_setprio(1); _Pragma("unroll") for (int m = 0; m < 4; ++m) _Pragma("unroll") for (int n = 0; n < 2; ++n) _Pragma("unroll") for (int k = 0; k < 2; ++k) \
        acc[ai][bj][m][n] = __builtin_amdgcn_mfma_f32_16x16x32_bf16(Bt[n][k], At[m][k], acc[ai][bj][m][n], 0, 0, 0); __builtin_amdgcn_s_setprio(0); } while (0)
#define PG8_WAIT_V(n) asm volatile("s_waitcnt vmcnt(" #n ")" ::: "memory")
#define PG8_WAIT_L(n) asm volatile("s_waitcnt lgkmcnt(" #n ")" ::: "memory")
#define PG8_BAR __builtin_amdgcn_s_barrier()
#define PG8_SCHED __builtin_amdgcn_sched_barrier(0)
    Unit cur, nxt; int ui = 0;
    if (!S.next(0, cur)) return;
    f32x4 acc[2][2][4][2];
#pragma unroll
    for (int a = 0; a < 2; ++a)
#pragma unroll
        for (int b = 0; b < 2; ++b)
#pragma unroll
            for (int m = 0; m < 4; ++m)
#pragma unroll
                for (int n = 0; n < 2; ++n) acc[a][b][m][n] = (f32x4){0.f, 0.f, 0.f, 0.f};
    bf16x8 At[4][2], B0[2][2], B1[2][2];
    const char* cA = (const char*)g.A + (size_t)cur.pm * tstep; const char* cB = (const char*)g.Bt + (size_t)cur.pn * tstep;
    S.a_ready(cur);
    if constexpr (SP2) {
        PG8_STAGE(PG8_SB(0, 0), cB, voffB); PG8_STAGE(PG8_SB(0, 1), cB + hstep, voffB); PG8_STAGE(PG8_SA(0, 0), cA, voffA); PG8_STAGE(PG8_SA(0, 1), cA + hstep, voffA);
        if (wr == 1) PG8_BAR;
        PG8_WAIT_V(2); PG8_BAR;
        PG8_STAGE(PG8_SB(1, 0), cB + kstep, voffB); PG8_STAGE(PG8_SA(1, 0), cA + kstep, voffA); PG8_STAGE(PG8_SB(1, 1), cB + hstep + kstep, voffB);
        PG8_WAIT_V(6); PG8_BAR;
    } else {
        PG8_STAGE(PG8_SB(0, 0), cB, voffB); PG8_STAGE(PG8_SA(0, 0), cA, voffA); PG8_STAGE(PG8_SB(0, 1), cB + hstep, voffB); PG8_STAGE(PG8_SA(0, 1), cA + hstep, voffA);
        if (wr == 1) PG8_BAR;
        PG8_WAIT_V(4); PG8_BAR;
        PG8_STAGE(PG8_SB(1, 0), cB + kstep, voffB); PG8_STAGE(PG8_SA(1, 0), cA + kstep, voffA); PG8_STAGE(PG8_SB(1, 1), cB + hstep + kstep, voffB);
        PG8_WAIT_V(6); PG8_BAR;
    }
    for (;;) {
        const bool has_next = S.next(ui + 1, nxt);
        const char* nA = has_next ? (const char*)g.A + (size_t)nxt.pm * tstep : cA; const char* nB = has_next ? (const char*)g.Bt + (size_t)nxt.pn * tstep : cB;
        for (int t = 0; t < nt; t += 2) {
            const bool last = (t == nt - 2);
            const char* a1 = cA + (size_t)(t + 1) * kstep;
            const char* a2 = last ? nA : cA + (size_t)(t + 2) * kstep; const char* b2 = last ? nB : cB + (size_t)(t + 2) * kstep;
            const char* a3 = a2 + kstep; const char* b3 = b2 + kstep;
            if (last && has_next) S.a_ready(nxt);
            if constexpr (SP2) {
            PG8_LDB(B0, 0, 0); PG8_LDB(B1, 0, 1); PG8_SCHED; PG8_LDA(At, 0, 0); PG8_STAGE(PG8_SA(1, 1), a1 + hstep, voffA);
            PG8_WAIT_V(8); PG8_WAIT_L(0); PG8_BAR; PG8_MMA(0, 0, At, B0); PG8_MMA(0, 1, At, B1); PG8_BAR; PG8_SCHED;
            PG8_LDA(At, 0, 1); PG8_STAGE(PG8_SB(0, 0), b2, voffB); PG8_STAGE(PG8_SB(0, 1), b2 + hstep, voffB); PG8_STAGE(PG8_SA(0, 0), a2, voffA);
            PG8_WAIT_V(8); PG8_WAIT_L(0); PG8_BAR; PG8_MMA(1, 0, At, B0); PG8_MMA(1, 1, At, B1); PG8_BAR; PG8_SCHED;
            PG8_LDB(B0, 1, 0); PG8_LDB(B1, 1, 1); PG8_SCHED; PG8_LDA(At, 1, 0); PG8_STAGE(PG8_SA(0, 1), a2 + hstep, voffA);
            PG8_WAIT_V(8); PG8_WAIT_L(0); PG8_BAR; PG8_MMA(0, 0, At, B0); PG8_MMA(0, 1, At, B1); PG8_BAR; PG8_SCHED;
            PG8_LDA(At, 1, 1); PG8_STAGE(PG8_SB(1, 0), b3, voffB); PG8_STAGE(PG8_SB(1, 1), b3 + hstep, voffB); PG8_STAGE(PG8_SA(1, 0), a3, voffA);
            PG8_WAIT_V(8); PG8_WAIT_L(0); PG8_BAR; PG8_MMA(1, 0, At, B0); PG8_MMA(1, 1, At, B1); PG8_BAR; PG8_SCHED;
            } else {
            PG8_LDB(B0, 0, 0); PG8_SCHED; PG8_LDA(At, 0, 0); PG8_STAGE(PG8_SA(1, 1), a1 + hstep, voffA);
            PG8_WAIT_L(8); PG8_BAR; PG8_WAIT_L(0); PG8_MMA(0, 0, At, B0); PG8_BAR; PG8_SCHED;
            PG8_LDB(B1, 0, 1); PG8_STAGE(PG8_SB(0, 0), b2, voffB);
            PG8_BAR; PG8_WAIT_L(0); PG8_MMA(0, 1, At, B1); PG8_BAR;
            PG8_LDA(At, 0, 1); PG8_STAGE(PG8_SA(0, 0), a2, voffA);
            PG8_BAR; PG8_WAIT_L(0); PG8_MMA(1, 0, At, B0); PG8_BAR; PG8_SCHED;
            PG8_STAGE(PG8_SB(0, 1), b2 + hstep, voffB);
            PG8_WAIT_V(6); PG8_BAR; PG8_MMA(1, 1, At, B1); PG8_BAR;
            PG8_LDB(B0, 1, 0); PG8_SCHED; PG8_LDA(At, 1, 0); PG8_STAGE(PG8_SA(0, 1), a2 + hstep, voffA);
            PG8_WAIT_L(8); PG8_BAR; PG8_WAIT_L(0); PG8_MMA(0, 0, At, B0); PG8_BAR; PG8_SCHED;
            PG8_LDB(B1, 1, 1); PG8_STAGE(PG8_SB(1, 0), b3, voffB);
            PG8_BAR; PG8_WAIT_L(0); PG8_MMA(0, 1, At, B1); PG8_BAR;
            PG8_LDA(At, 1, 1); PG8_STAGE(PG8_SA(1, 0), a3, voffA);
            PG8_BAR; PG8_WAIT_L(0); PG8_MMA(1, 0, At, B0); PG8_BAR; PG8_SCHED;
            PG8_STAGE(PG8_SB(1, 1), b3 + hstep, voffB);
            PG8_WAIT_V(6); PG8_BAR; PG8_MMA(1, 1, At, B1); PG8_BAR;
            }
        }
        if constexpr (ALIGN_EPI) { if (wr == 0) PG8_BAR; }
        if constexpr (!Epi::AFTER_DRAIN) { E(acc, cur, wr, wc, fr, fq); S.done(cur); }
        if (!has_next) break;
#pragma unroll
        for (int a = 0; a < 2; ++a)
#pragma unroll
            for (int b = 0; b < 2; ++b)
#pragma unroll
                for (int m = 0; m < 4; ++m)
#pragma unroll
                    for (int n = 0; n < 2; ++n) acc[a][b][m][n] = (f32x4){0.f, 0.f, 0.f, 0.f};
        cur = nxt; cA = nA; cB = nB; ++ui;
        if constexpr (ALIGN_EPI) { if (wr == 1) PG8_BAR; }
    }
    PG8_WAIT_V(0);
    if constexpr (!ALIGN_EPI) { if (wr == 0) PG8_BAR; }
    PG8_BAR;
    if constexpr (Epi::AFTER_DRAIN) { E.fused(acc, cur, wr, wc, fr, fq, lds, wid, lane); S.done(cur); }
#undef PG8_SA
#undef PG8_SB
#undef PG8_STAGE
#undef PG8_LDA
#undef PG8_LDB
#undef PG8_MMA
#undef PG8_WAIT_V
#undef PG8_WAIT_L
#undef PG8_BAR
#undef PG8_SCHED
}
}

typedef unsigned short bf16;
typedef unsigned v4u __attribute__((ext_vector_type(4)));
typedef float f32x4 __attribute__((ext_vector_type(4)));
#define GAS __attribute__((address_space(1)))
#define LAS __attribute__((address_space(3)))
typedef GAS unsigned gu32;
#define RLX_AGENT __ATOMIC_RELAXED, __HIP_MEMORY_SCOPE_AGENT
#define LDS_WAIT() asm volatile("s_waitcnt lgkmcnt(0)" ::: "memory")
#define VM_WAIT() asm volatile("s_waitcnt vmcnt(0)" ::: "memory")

constexpr int NWAVES = 8;
#ifndef MK_ONE_LAUNCH
#define MK_ONE_LAUNCH 0
#endif
constexpr size_t MiB = 1u << 20;
constexpr size_t WS_CTL = 0, CTL_ZERO_BYTES = 2 * MiB;
constexpr size_t WS_MOD = 1 * MiB;
constexpr size_t WS_COS = 2 * MiB, WS_SIN = 2 * MiB + 256 * 1024, WS_LAM = 2 * MiB + 512 * 1024, WS_BBAR = 3 * MiB;
constexpr size_t WS_WFI = 8 * MiB, WS_WFO = 184 * MiB, WS_WIN = 272 * MiB, WS_WOUT = 304 * MiB, WS_WGLU = 320 * MiB;
constexpr size_t WS_XR = 322 * MiB, WS_H = 370 * MiB, WS_ACT = 394 * MiB, WS_PROJ = 460 * MiB, WS_QB = 508 * MiB;
constexpr size_t WS_KP = 520 * MiB, WS_VP = 522 * MiB, WS_KS = 524 * MiB, WS_VS = 526 * MiB, WS_QR = 528 * MiB, WS_KR = 534 * MiB;
constexpr size_t WS_MIX = 540 * MiB, WS_YS = 564 * MiB, WS_YSB = 576 * MiB, WS_END = 582 * MiB;
constexpr int CW_BAR = 4096;
constexpr int RING_BYTES = 131072, LDSCTL_OFF = RING_BYTES, MISC_OFF = LDSCTL_OFF + 320, LDS_BYTES = 147456;

__device__ __forceinline__ unsigned f2bf(float f) { unsigned u = __builtin_bit_cast(unsigned, f); return (u + 0x7fffu + ((u >> 16) & 1u)) >> 16; }
__device__ __forceinline__ unsigned pk2(float lo, float hi) { return f2bf(lo) | (f2bf(hi) << 16); }
__device__ __forceinline__ float bf2f(unsigned short h) { return __builtin_bit_cast(float, (unsigned)h << 16); }
__device__ __forceinline__ float bflo(unsigned w) { return __builtin_bit_cast(float, w << 16); }
__device__ __forceinline__ float bfhi(unsigned w) { return __builtin_bit_cast(float, w & 0xffff0000u); }

#define XB_TMO      128
#define XB_XCNT(j)  (256  + 64 * (j))
#define XB_XSUB(j)  (1280 + 64 * (j))
#define XB_XGEN(j)  (2304 + 64 * (j))
#define XB_TOP      3328
#define XB_TOPGEN   3392
#define XCD_BAR_WORDS 3456
#define XB_SPIN_CAP (1u << 18)
__device__ __forceinline__ unsigned xb_ld(unsigned* p)              { return __hip_atomic_load(p, __ATOMIC_RELAXED, __HIP_MEMORY_SCOPE_AGENT); }
__device__ __forceinline__ unsigned xb_add(unsigned* p, unsigned v) { return __hip_atomic_fetch_add(p, v, __ATOMIC_RELAXED, __HIP_MEMORY_SCOPE_AGENT); }
__device__ __forceinline__ unsigned xb_xcc_id() { return (unsigned)__builtin_amdgcn_s_getreg((3 << 11) | 20) & 0xFu; }
#define XB_SPIN(cond, bar) do { unsigned _sp = 0; while (cond) { __builtin_amdgcn_s_sleep(1); \
    if ((++_sp & 255u) == 0u) { if (xb_ld(&(bar)[XB_TMO])) break; if (_sp > XB_SPIN_CAP) { atomicAdd(&(bar)[XB_TMO], 1u); break; } } } } while (0)
struct XcdBarrier { unsigned* bar; unsigned x; volatile LAS unsigned* st; };
__device__ __forceinline__ XcdBarrier xcd_barrier_post(unsigned* bar, volatile LAS unsigned* st) {
    XcdBarrier b; b.bar = bar; b.x = xb_xcc_id(); b.st = st;
    if (threadIdx.x == 0) (void)xb_add(&bar[XB_XCNT(b.x)], 1u);
    return b;
}
__device__ __forceinline__ void xcd_barrier_complete(unsigned* bar, unsigned x, unsigned& nloc, unsigned& nx) {
    const unsigned G = gridDim.x * gridDim.y * gridDim.z;
    unsigned sum, cnt, mine, sp = 0u;
    for (;;) {
        sum = 0u; cnt = 0u; mine = 0u;
#pragma unroll
        for (unsigned j = 0; j < 16; ++j) { const unsigned c = xb_ld(&bar[XB_XCNT(j)]); sum += c; cnt += (c > 0u) ? 1u : 0u; mine = (j == x) ? c : mine; }
        if (sum == G) break;
        __builtin_amdgcn_s_sleep(1);
        if ((++sp & 255u) == 0u) { if (xb_ld(&bar[XB_TMO])) break; if (sp > XB_SPIN_CAP) { atomicAdd(&bar[XB_TMO], 1u); break; } }
    }
    nloc = mine > 0u ? mine : 1u; nx = cnt > 0u ? cnt : 1u;
}
__device__ __forceinline__ void xcd_barrier(const XcdBarrier& b) {
    asm volatile("s_waitcnt vmcnt(0)" ::: "memory");
    __syncthreads();
    if (threadIdx.x == 0) {
        unsigned* bar = b.bar;
        __builtin_amdgcn_s_waitcnt(0);
        unsigned nloc = b.st[0], nx = b.st[1];
        if (nloc == 0u) { xcd_barrier_complete(bar, b.x, nloc, nx); b.st[0] = nloc; b.st[1] = nx; }
        const unsigned old = xb_add(&bar[XB_XSUB(b.x)], 1u);
        const unsigned gen = old / nloc;
        if (old + 1u == (gen + 1u) * nloc) {
            __builtin_amdgcn_fence(__ATOMIC_RELEASE, "agent");
            asm volatile("s_waitcnt vmcnt(0)" ::: "memory");
            const unsigned og = xb_add(&bar[XB_TOP], 1u);
            const unsigned tg = og / nx;
            if (og + 1u == (tg + 1u) * nx) xb_add(&bar[XB_TOPGEN], 1u);
            else XB_SPIN(xb_ld(&bar[XB_TOPGEN]) == tg, bar);
            __builtin_amdgcn_fence(__ATOMIC_ACQUIRE, "agent");
            xb_add(&bar[XB_XGEN(b.x)], 1u);
            asm volatile("s_waitcnt vmcnt(0)" ::: "memory");
        } else {
            XB_SPIN(xb_ld(&bar[XB_XGEN(b.x)]) == gen, bar);
            __builtin_amdgcn_fence(__ATOMIC_ACQUIRE, "agent");
            asm volatile("s_waitcnt vmcnt(0)" ::: "memory");
        }
    }
    __syncthreads();
}

struct KArgs { const float* in[28]; float* out; unsigned char* ws; int ph_lo, ph_hi, li, pad; };
typedef const __attribute__((address_space(4))) KArgs* KA;
enum { I_XP = 0, I_XS, I_CK, I_CV, I_SSSM, I_SRET, I_C, I_CCTX, I_WMOD, I_BMOD, I_NORMG, I_WFI, I_WFO, I_WIN, I_WOUT, I_QNG, I_KNG,
       I_ARE, I_AIM, I_LOGDT, I_BRE, I_BIM, I_CRE, I_CIM, I_SSMD, I_WGLU, I_DECAY, I_FNG };

struct Frame {
    LAS unsigned char* lds;
    int tid, lane, wave, G, gw, NGW;
};

__device__ __forceinline__ float wave_sum(float v) {
#pragma unroll
    for (int o = 1; o < 64; o <<= 1) v += __shfl_xor(v, o);
    return v;
}
__device__ __forceinline__ float wave_max(float v) {
#pragma unroll
    for (int o = 1; o < 64; o <<= 1) v = fmaxf(v, __shfl_xor(v, o));
    return v;
}
__device__ __forceinline__ float silu_f(float x) { return x / (1.0f + __expf(-x)); }
__device__ __forceinline__ float gelu_tanh(float x) { const float u = 0.7978845608028654f * (x + 0.044715f * x * x * x); return 0.5f * x * (1.0f + tanhf(u)); }

__device__ __forceinline__ void p0_transpose_item(const float* W, int K, int N, bf16* WT, int halfN, LAS float* scr, int item, int lane) {
    const int nblk = N / 32, kb = item / nblk, nb = item % nblk, k0 = 64 * kb, n0 = 32 * nb;
    int R0 = n0;
    if (halfN) { if (n0 < halfN) R0 = 256 * (n0 >> 7) + (n0 & 127); else { const int n1 = n0 - halfN; R0 = 256 * (n1 >> 7) + 128 + (n1 & 127); } }
#pragma unroll 8
    for (int i = 0; i < 32; ++i) { const int kk = 2 * i + (lane >> 5); scr[kk * 33 + (lane & 31)] = W[(size_t)(k0 + kk) * N + n0 + (lane & 31)]; }
    LDS_WAIT(); asm volatile("" ::: "memory");
    const int c = lane & 7;
#pragma unroll
    for (int j = 0; j < 4; ++j) { const int n = (lane >> 3) + 8 * j; const LAS float* s = scr + (8 * c) * 33 + n;
        v4u o; o.x = pk2(s[0 * 33], s[1 * 33]); o.y = pk2(s[2 * 33], s[3 * 33]); o.z = pk2(s[4 * 33], s[5 * 33]); o.w = pk2(s[6 * 33], s[7 * 33]);
        *(GAS v4u*)(WT + (size_t)(R0 + n) * K + k0 + 8 * c) = o; }
    LDS_WAIT(); asm volatile("" ::: "memory");
}

__device__ __forceinline__ void phase_prologue(const Frame& F, KA a) {
    unsigned char* ws = a->ws;
    LAS float* cs = (LAS float*)(F.lds);
    LAS float* red = (LAS float*)(F.lds + 24576);
    for (int i = F.tid; i < 3 * DM; i += 512) { const int v = i / DM, k = i % DM; const float c = v == 0 ? a->in[I_CCTX][k] : a->in[I_C][(v - 1) * DM + k]; cs[i] = silu_f(c); }
    __syncthreads();
    float* modb = (float*)(ws + WS_MOD);
    for (int task = blockIdx.x; task < 2 * 72 * 8; task += F.G) {
        const int l = task / 576, r = task % 576, cb = r / 8, kc = r % 8;
        const int kbase = kc * 256 + F.wave * 32, col = cb * 256 + F.lane * 4;
        const float* wp = a->in[I_WMOD] + ((size_t)l * DM + kbase) * MODW + col;
        f32x4 s0 = {0, 0, 0, 0}, s1 = s0, s2 = s0;
#pragma unroll 8
        for (int k = 0; k < 32; ++k) { const f32x4 w = *(const GAS f32x4*)(wp + (size_t)k * MODW);
            s0 += w * cs[kbase + k]; s1 += w * cs[DM + kbase + k]; s2 += w * cs[2 * DM + kbase + k]; }
        LAS float* rp = red + (F.wave * 64 + F.lane) * 12;
#pragma unroll
        for (int j = 0; j < 4; ++j) { rp[j] = s0[j]; rp[4 + j] = s1[j]; rp[8 + j] = s2[j]; }
        __syncthreads();
        for (int o = F.tid; o < 768; o += 512) { const int v = o >> 8, c = o & 255; float s = 0.f;
#pragma unroll
            for (int w = 0; w < 8; ++w) s += red[(w * 64 + (c >> 2)) * 12 + v * 4 + (c & 3)];
            if (kc == 0) s += a->in[I_BMOD][l * MODW + cb * 256 + c];
            unsafeAtomicAdd(modb + ((size_t)l * 3 + v) * MODW + cb * 256 + c, s); }
        __syncthreads();
    }
    {
        float* cosT = (float*)(ws + WS_COS); float* sinT = (float*)(ws + WS_SIN);
        for (int i = blockIdx.x * 512 + F.tid; i < DSEQ * 64; i += F.G * 512) { const int t = i >> 6, j = i & 63, ax = j >> 5, f = j & 31;
            const float pos = (float)(ax == 0 ? (t >> 6) : (t & 63)); const float inv = powf(10000.0f, -(float)f / 32.0f); const float ang = pos * inv;
            float sn, cn; sincosf(ang, &sn, &cn); cosT[i] = cn; sinT[i] = sn; }
        float* lamT = (float*)(ws + WS_LAM); float* bbT = (float*)(ws + WS_BBAR);
        for (int i = blockIdx.x * 512 + F.tid; i < NLAYER * 2 * 32 * 64; i += F.G * 512) {
            const int ldg = i >> 6;
            const float dt = expf(a->in[I_LOGDT][ldg]); const float ar = a->in[I_ARE][i], ai = a->in[I_AIM][i];
            const float x = ar * dt, y = ai * dt; float sn, cn; sincosf(y, &sn, &cn); const float ex = expf(x);
            lamT[2 * i] = ex * cn; lamT[2 * i + 1] = ex * sn;
            const float sh = sinf(0.5f * y); const float nr = expm1f(x) * cn - 2.0f * sh * sh, ni = ex * sn;
            const float d2 = ar * ar + ai * ai; const float cr = (nr * ar + ni * ai) / d2, ci = (ni * ar - nr * ai) / d2;
#pragma unroll
            for (int j = 0; j < 16; ++j) { const float br = a->in[I_BRE][(size_t)i * 16 + j], bi = a->in[I_BIM][(size_t)i * 16 + j];
                bbT[((size_t)i * 16 + j) * 2] = cr * br - ci * bi; bbT[((size_t)i * 16 + j) * 2 + 1] = cr * bi + ci * br; }
        }
    }
    {
        GAS f32x4* xr = (GAS f32x4*)(ws + WS_XR);
        const GAS f32x4* xp = (const GAS f32x4*)a->in[I_XP]; const GAS f32x4* xs = (const GAS f32x4*)a->in[I_XS];
        const int NP4 = NPR * DM / 4, NT4 = MT * DM / 4;
        for (int i = blockIdx.x * 512 + F.tid; i < NT4; i += F.G * 512) xr[i] = i < NP4 ? xp[i] : xs[i - NP4];
    }
    {
        LAS float* scr = (LAS float*)(F.lds + 49152 + F.wave * 8704);
        constexpr int I_FI = (DM / 64) * (2 * DFF / 32), I_FO = (DFF / 64) * (DM / 32), I_IN = (DM / 64) * (INW / 32), I_OUT = (DM / 64) * (DM / 32), I_GL = (512 / 64) * (1024 / 32);
        constexpr int NITEMS = 4 * I_FI + 4 * I_FO + 2 * I_IN + 2 * I_OUT + 2 * I_GL;
        for (int it = F.gw; it < NITEMS; it += F.NGW) {
            int r = it;
            if (r < 4 * I_FI) { const int m = r / I_FI; p0_transpose_item(a->in[I_WFI] + (size_t)m * DM * 2 * DFF, DM, 2 * DFF, (bf16*)(ws + WS_WFI) + (size_t)m * 2 * DFF * DM, DFF, scr, r % I_FI, F.lane); continue; } r -= 4 * I_FI;
            if (r < 4 * I_FO) { const int m = r / I_FO; p0_transpose_item(a->in[I_WFO] + (size_t)m * DFF * DM, DFF, DM, (bf16*)(ws + WS_WFO) + (size_t)m * DM * DFF, 0, scr, r % I_FO, F.lane); continue; } r -= 4 * I_FO;
            if (r < 2 * I_IN) { const int m = r / I_IN; p0_transpose_item(a->in[I_WIN] + (size_t)m * DM * INW, DM, INW, (bf16*)(ws + WS_WIN) + (size_t)m * INW * DM, 0, scr, r % I_IN, F.lane); continue; } r -= 2 * I_IN;
            if (r < 2 * I_OUT) { const int m = r / I_OUT; p0_transpose_item(a->in[I_WOUT] + (size_t)m * DM * DM, DM, DM, (bf16*)(ws + WS_WOUT) + (size_t)m * DM * DM, 0, scr, r % I_OUT, F.lane); continue; } r -= 2 * I_OUT;
            { const int m = r / I_GL; p0_transpose_item(a->in[I_WGLU] + (size_t)m * 512 * 1024, 512, 1024, (bf16*)(ws + WS_WGLU) + (size_t)m * 1024 * 512, 512, scr, r % I_GL, F.lane); }
        }
    }
}

__device__ __forceinline__ void phase_prenorm(const Frame& F, KA a, int l, int sub) {
    unsigned char* ws = a->ws;
    const float* xr = (const float*)(ws + WS_XR);
    for (int m = F.gw; m < MT; m += F.NGW) {
        const GAS f32x4* xp = (const GAS f32x4*)(xr + (size_t)m * DM) + F.lane;
        f32x4 v[8]; float s = 0.f;
#pragma unroll
        for (int j = 0; j < 8; ++j) { v[j] = xp[64 * j]; s += (v[j].x * v[j].x + v[j].y * v[j].y) + (v[j].z * v[j].z + v[j].w * v[j].w); }
        const float rstd = 1.0f / sqrtf(wave_sum(s) * (1.0f / DM) + EPS);
        if (sub == 3) {
            const GAS f32x4* gp = (const GAS f32x4*)a->in[I_FNG] + F.lane; GAS f32x4* op = (GAS f32x4*)(a->out + O_Y + (size_t)m * DM) + F.lane;
#pragma unroll
            for (int j = 0; j < 8; ++j) op[64 * j] = v[j] * rstd * gp[64 * j];
        } else {
            const int var = m < NPR ? 0 : 1 + (m - NPR) / DSEQ;
            const float* mod = (const float*)(ws + WS_MOD) + ((size_t)l * 3 + var) * MODW + sub * 3 * DM;
            const GAS f32x4* gp = (const GAS f32x4*)(a->in[I_NORMG] + ((size_t)l * 3 + sub) * DM) + F.lane;
            const GAS f32x4* shp = (const GAS f32x4*)mod + F.lane; const GAS f32x4* scp = (const GAS f32x4*)(mod + DM) + F.lane;
            GAS unsigned long long* o8 = (GAS unsigned long long*)((bf16*)(ws + WS_H) + (size_t)m * DM) + F.lane;
#pragma unroll
            for (int j = 0; j < 8; ++j) { const f32x4 y = v[j] * rstd * gp[64 * j] * (scp[64 * j] + 1.0f) + shp[64 * j];
                o8[64 * j] = (unsigned long long)pk2(y.x, y.y) | ((unsigned long long)pk2(y.z, y.w) << 32); }
        }
    }
}

__device__ __forceinline__ void phase_qkvpost(const Frame& F, KA a, int l) {
    unsigned char* ws = a->ws;
    const bf16* proj = (const bf16*)(ws + WS_PROJ);
    const float* cosT = (const float*)(ws + WS_COS); const float* sinT = (const float*)(ws + WS_SIN);
    const int i = F.lane, e0 = (i & 31) + 64 * (i >> 5), e1 = e0 + 32;
    const int NT1 = MT * 20, NT2 = NBS * PAST * 2 * 2;
    for (int task = F.gw; task < NT1 + NT2; task += F.NGW) {
        if (task >= NT1) {
            const int r = task - NT1; const int isv = r & 1, kvh = (r >> 1) & 1, t = (r >> 2) % PAST, b = (r >> 2) / PAST;
            const float* src = a->in[isv ? I_CV : I_CK] + ((((size_t)b * NLAYER + l) * PAST + t) * 2 + kvh) * 128;
            bf16* dst = (bf16*)(ws + (isv ? WS_VS : WS_KS)) + ((size_t)b * KALL + t) * 256 + kvh * 128;
            dst[e0] = (bf16)f2bf(src[e0]); dst[e1] = (bf16)f2bf(src[e1]);
            continue;
        }
        const int m = task / 20, ch = task % 20;
        const bool lat = m >= NPR; const int b = lat ? (m - NPR) / DSEQ : m / SEQ, t = lat ? (m - NPR) % DSEQ : m % SEQ;
        int scol; if (ch < 8) scol = C_QA + ch * 128; else if (ch < 10) scol = C_KA + (ch - 8) * 128; else if (ch < 12) scol = C_VA + (ch - 10) * 128; else if (ch < 16) scol = C_QR + (ch - 12) * 128; else scol = C_KR + (ch - 16) * 128;
        const bf16* src = proj + (size_t)m * INW + scol;
        float x0 = bf2f(src[e0]), x1 = bf2f(src[e1]);
        if (ch < 10) {
            const float ss = wave_sum(x0 * x0 + x1 * x1); const float r = 1.0f / sqrtf(ss * (1.0f / 128.0f) + EPS);
            const float* g = a->in[ch < 8 ? I_QNG : I_KNG] + l * 128;
            x0 *= r * g[e0]; x1 *= r * g[e1];
        }
        if (ch >= 16) { x0 *= 0.08838834764831845f; x1 *= 0.08838834764831845f; }
        if (lat && (ch < 10 || ch >= 12)) {
            const float c = cosT[t * 64 + i], s = sinT[t * 64 + i];
            const float y0 = x0 * c - x1 * s, y1 = x1 * c + x0 * s; x0 = y0; x1 = y1;
        }
        if (ch < 8) { bf16* d = (bf16*)(ws + WS_QB) + (size_t)m * 1024 + ch * 128; d[e0] = (bf16)f2bf(x0); d[e1] = (bf16)f2bf(x1); }
        else if (ch < 12) {
            const int isv = ch >= 10, kvh = (ch - 8) & 1;
            if (!lat) {
                float* o = a->out + (isv ? O_CV : O_CK) + ((((size_t)b * NLAYER + l) * SEQ + t) * 2 + kvh) * 128; o[e0] = x0; o[e1] = x1;
                bf16* d = (bf16*)(ws + (isv ? WS_VP : WS_KP)) + (size_t)m * 256 + kvh * 128; d[e0] = (bf16)f2bf(x0); d[e1] = (bf16)f2bf(x1);
            } else {
                bf16* d = (bf16*)(ws + (isv ? WS_VS : WS_KS)) + ((size_t)b * KALL + PAST + t) * 256 + kvh * 128; d[e0] = (bf16)f2bf(x0); d[e1] = (bf16)f2bf(x1);
            }
        }
        else if (ch < 16) { bf16* d = (bf16*)(ws + WS_QR) + (size_t)m * 512 + (ch - 12) * 128; d[e0] = (bf16)f2bf(x0); d[e1] = (bf16)f2bf(x1); }
        else { bf16* d = (bf16*)(ws + WS_KR) + (size_t)m * 512 + (ch - 16) * 128; d[e0] = (bf16)f2bf(x0); d[e1] = (bf16)f2bf(x1); }
    }
}

constexpr int NV_WAVE_LDS = 7168;

__device__ __forceinline__ void nv_attn_row(const bf16* qrow, const bf16* Kb, const bf16* Vb, int nkeys, bf16* out, LAS float* qs, LAS float* ps, int lane) {
    qs[lane] = bf2f(qrow[lane]); qs[lane + 64] = bf2f(qrow[lane + 64]);
    LDS_WAIT(); asm volatile("" ::: "memory");
    float mx = -3.0e38f;
    for (int j = lane; j < nkeys; j += 64) {
        const GAS v4u* kr = (const GAS v4u*)(Kb + (size_t)j * 256); float s = 0.f;
#pragma unroll 4
        for (int c = 0; c < 16; ++c) { const v4u w = kr[c]; const LAS float* q = qs + 8 * c;
            s += q[0] * bflo(w.x) + q[1] * bfhi(w.x) + q[2] * bflo(w.y) + q[3] * bfhi(w.y) + q[4] * bflo(w.z) + q[5] * bfhi(w.z) + q[6] * bflo(w.w) + q[7] * bfhi(w.w); }
        s *= 0.08838834764831845f; ps[j] = s; mx = fmaxf(mx, s);
    }
    mx = wave_max(mx);
    float sum = 0.f;
    for (int j = lane; j < nkeys; j += 64) { const float p = __expf(ps[j] - mx); ps[j] = p; sum += p; }
    sum = wave_sum(sum);
    LDS_WAIT(); asm volatile("" ::: "memory");
    float o0 = 0.f, o1 = 0.f;
#pragma unroll 4
    for (int j = 0; j < nkeys; ++j) { const float p = ps[j]; const bf16* vr = Vb + (size_t)j * 256; o0 += p * bf2f(vr[lane]); o1 += p * bf2f(vr[lane + 64]); }
    const float inv = 1.0f / sum;
    out[lane] = (bf16)f2bf(o0 * inv); out[lane + 64] = (bf16)f2bf(o1 * inv);
    LDS_WAIT(); asm volatile("" ::: "memory");
}

__device__ __forceinline__ void nv_ret_row(KA a, int l, int m0, int L, int t, int h, int bl  , float lgf, float lgb, LAS float* qs, LAS float* ps, int lane) {
    unsigned char* ws = a->ws;
    const bf16* QR = (const bf16*)(ws + WS_QR); const bf16* KR = (const bf16*)(ws + WS_KR); const bf16* proj = (const bf16*)(ws + WS_PROJ);
    const int m = m0 + t;
    const bf16* qrow = QR + (size_t)m * 512 + h * 128;
    qs[lane] = bf2f(qrow[lane]); qs[lane + 64] = bf2f(qrow[lane + 64]);
    LDS_WAIT(); asm volatile("" ::: "memory");
    for (int j = lane; j < L; j += 64) {
        const GAS v4u* kr = (const GAS v4u*)(KR + (size_t)(m0 + j) * 512 + h * 128); float s = 0.f;
#pragma unroll 4
        for (int c = 0; c < 16; ++c) { const v4u w = kr[c]; const LAS float* q = qs + 8 * c;
            s += q[0] * bflo(w.x) + q[1] * bfhi(w.x) + q[2] * bflo(w.y) + q[3] * bfhi(w.y) + q[4] * bflo(w.z) + q[5] * bfhi(w.z) + q[6] * bflo(w.w) + q[7] * bfhi(w.w); }
        const float d = j < t ? exp2f((float)(t - j) * lgf) : (j > t ? exp2f((float)(j - t) * lgb) : 2.0f);
        ps[j] = s * d;
    }
    LDS_WAIT(); asm volatile("" ::: "memory");
    float o0 = 0.f, o1 = 0.f;
#pragma unroll 4
    for (int j = 0; j < L; ++j) { const float p = ps[j]; const bf16* vr = proj + (size_t)(m0 + j) * INW + C_VR + h * 128; o0 += p * bf2f(vr[lane]); o1 += p * bf2f(vr[lane + 64]); }
    if (bl >= 0) {
        const float* S0f = a->in[I_SRET] + ((((size_t)bl * NLAYER + l) * 2 + 0) * 4 + h) * 16384;
        const float* S0b = a->in[I_SRET] + ((((size_t)bl * NLAYER + l) * 2 + 1) * 4 + h) * 16384;
        float f0 = 0.f, f1 = 0.f, b0 = 0.f, b1 = 0.f;
#pragma unroll 4
        for (int d = 0; d < 128; ++d) { const float q = qs[d]; f0 += q * S0f[d * 128 + lane]; f1 += q * S0f[d * 128 + 64 + lane]; b0 += q * S0b[d * 128 + lane]; b1 += q * S0b[d * 128 + 64 + lane]; }
        const float wf = exp2f((float)(t + 1) * lgf), wb = exp2f((float)(L - t) * lgb);
        o0 += wf * f0 + wb * b0; o1 += wf * f1 + wb * b1;
    }
    const float mean = wave_sum(o0 + o1) * (1.0f / 128.0f); o0 -= mean; o1 -= mean;
    const float var = wave_sum(o0 * o0 + o1 * o1) * (1.0f / 128.0f); const float r = 1.0f / sqrtf(var + EPS);
    const bf16* gr = proj + (size_t)m * INW + C_GR + h * 128;
    const float g0 = bf2f(gr[lane]), g1 = bf2f(gr[lane + 64]);
    bf16* out = (bf16*)(ws + WS_MIX) + (size_t)m * DM + 1536 + h * 128;
    out[lane] = (bf16)f2bf(o0 * r * silu_f(g0)); out[lane + 64] = (bf16)f2bf(o1 * r * silu_f(g1));
    LDS_WAIT(); asm volatile("" ::: "memory");
}

__device__ __forceinline__ void nv_ret_state(KA a, int l, int b, int h, int dir, int d, float lg, int lane) {
    unsigned char* ws = a->ws;
    const bf16* KR = (const bf16*)(ws + WS_KR); const bf16* proj = (const bf16*)(ws + WS_PROJ);
    float o0 = 0.f, o1 = 0.f;
#pragma unroll 4
    for (int s = 0; s < SEQ; ++s) { const int m = b * SEQ + s; const float w = exp2f((float)(dir == 0 ? SEQ - 1 - s : s) * lg) * bf2f(KR[(size_t)m * 512 + h * 128 + d]);
        const bf16* vr = proj + (size_t)m * INW + C_VR + h * 128; o0 += w * bf2f(vr[lane]); o1 += w * bf2f(vr[lane + 64]); }
    float* o = a->out + O_RET + (((((size_t)b * NLAYER + l) * 2 + dir) * 4 + h) * 128 + d) * 128;
    o[lane] = o0; o[lane + 64] = o1;
}

__device__ __forceinline__ void nv_s5(KA a, int l, int m0, int L, int g, int bl, int bp, LAS float* hb, int lane) {
    unsigned char* ws = a->ws;
    const bf16* proj = (const bf16*)(ws + WS_PROJ);
    float* YS = (float*)(ws + WS_YS); bf16* YSB = (bf16*)(ws + WS_YSB);
    const int ch = lane & 15, q4 = lane >> 4;
    const float dcoef = a->in[I_SSMD][l * 512 + g * 16 + ch];
    for (int dir = 1; dir >= 0; --dir) {
        const int ldg = (l * 2 + dir) * 32 + g;
        const float* lamT = (const float*)(ws + WS_LAM) + ((size_t)ldg * 64 + lane) * 2;
        const float lr = lamT[0], li = lamT[1];
        const float* bbp = (const float*)(ws + WS_BBAR) + ((size_t)ldg * 64 + lane) * 32;
        float bre[16], bim[16], cre[16], cim[16];
#pragma unroll
        for (int j = 0; j < 16; ++j) { bre[j] = bbp[2 * j]; bim[j] = bbp[2 * j + 1]; }
        const float* crp = a->in[I_CRE] + ((size_t)ldg * 16 + ch) * 64 + q4 * 16; const float* cip = a->in[I_CIM] + ((size_t)ldg * 16 + ch) * 64 + q4 * 16;
#pragma unroll
        for (int j = 0; j < 16; ++j) { cre[j] = crp[j]; cim[j] = cip[j]; }
        float hr = 0.f, hi = 0.f;
        if (bl >= 0) { const float* h0 = a->in[I_SSSM] + (((((size_t)bl * NLAYER + l) * 2 + dir) * 32 + g) * 64 + lane) * 2; hr = h0[0]; hi = h0[1]; }
        for (int step = 0; step < L; ++step) {
            const int t = dir == 0 ? step : L - 1 - step; const int m = m0 + t;
            const GAS v4u* up = (const GAS v4u*)(proj + (size_t)m * INW + C_US + g * 16);
            const v4u u0 = up[0], u1 = up[1];
            float u[16] = {bflo(u0.x), bfhi(u0.x), bflo(u0.y), bfhi(u0.y), bflo(u0.z), bfhi(u0.z), bflo(u0.w), bfhi(u0.w),
                           bflo(u1.x), bfhi(u1.x), bflo(u1.y), bfhi(u1.y), bflo(u1.z), bfhi(u1.z), bflo(u1.w), bfhi(u1.w)};
            float br_ = 0.f, bi_ = 0.f;
#pragma unroll
            for (int j = 0; j < 16; ++j) { br_ += bre[j] * u[j]; bi_ += bim[j] * u[j]; }
            const float nr = lr * hr - li * hi + br_, ni = lr * hi + li * hr + bi_; hr = nr; hi = ni;
            hb[2 * lane] = hr; hb[2 * lane + 1] = hi;
            LDS_WAIT(); asm volatile("" ::: "memory");
            float y = 0.f;
#pragma unroll
            for (int j = 0; j < 16; ++j) { y += cre[j] * hb[2 * (q4 * 16 + j)] - cim[j] * hb[2 * (q4 * 16 + j) + 1]; }
            y += __shfl_xor(y, 16); y += __shfl_xor(y, 32);
            LDS_WAIT(); asm volatile("" ::: "memory");
            if (q4 == 0) {
                if (dir == 1) YS[(size_t)m * 512 + g * 16 + ch] = y;
                else { float uch = 0.f;
#pragma unroll
                    for (int j = 0; j < 16; ++j) uch = (ch == j) ? u[j] : uch;
                    const float yt = y + YS[(size_t)m * 512 + g * 16 + ch] + dcoef * uch;
                    YSB[(size_t)m * 512 + g * 16 + ch] = (bf16)f2bf(gelu_tanh(yt)); }
            }
        }
        if (bp >= 0) { float* o = a->out + O_SSM + (((((size_t)bp * NLAYER + l) * 2 + dir) * 32 + g) * 64 + lane) * 2; o[0] = hr; o[1] = hi; }
    }
}

__device__ __forceinline__ void decay_log2(KA a, int l, int h, float& lgf, float& lgb) {
    const float xf = a->in[I_DECAY][(l * 2 + 0) * 4 + h], xb = a->in[I_DECAY][(l * 2 + 1) * 4 + h];
    lgf = -log1pf(expf(-xf)) * 1.4426950408889634f; lgb = -log1pf(expf(-xb)) * 1.4426950408889634f;
}

__device__ __forceinline__ void phase_mixer_naive(const Frame& F, KA a, int l) {
    unsigned char* ws = a->ws;
    LAS float* qs = (LAS float*)(F.lds + F.wave * NV_WAVE_LDS); LAS float* ps = qs + 128; LAS float* hb = ps + 1536;
    const bf16* QB = (const bf16*)(ws + WS_QB); bf16* MIX = (bf16*)(ws + WS_MIX);
    constexpr int T_S5S = NBS * 32, T_S5P = NBP * 32, T_AS = NBS * 8 * DSEQ, T_RS = NBS * 4 * DSEQ, T_AP = NBP * 8 * SEQ, T_RP = NBP * 4 * SEQ, T_ST = NBP * 4 * 2 * 128;
    constexpr int TOT = T_S5S + T_S5P + T_AS + T_RS + T_AP + T_RP + T_ST;
    for (int task = F.gw; task < TOT; task += F.NGW) {
        int r = task;
        if (r < T_S5S) { const int b = r / 32, g = r % 32; nv_s5(a, l, NPR + b * DSEQ, DSEQ, g, b, -1, hb, F.lane); continue; } r -= T_S5S;
        if (r < T_S5P) { const int b = r / 32, g = r % 32; nv_s5(a, l, b * SEQ, SEQ, g, -1, b, hb, F.lane); continue; } r -= T_S5P;
        if (r < T_AS) { const int t = r % DSEQ, h = (r / DSEQ) % 8, b = r / (DSEQ * 8); const int m = NPR + b * DSEQ + t;
            nv_attn_row(QB + (size_t)m * 1024 + h * 128, (const bf16*)(ws + WS_KS) + (size_t)b * KALL * 256 + (h >> 2) * 128, (const bf16*)(ws + WS_VS) + (size_t)b * KALL * 256 + (h >> 2) * 128, KALL,
                        MIX + (size_t)m * DM + h * 128, qs, ps, F.lane); continue; } r -= T_AS;
        if (r < T_RS) { const int t = r % DSEQ, h = (r / DSEQ) % 4, b = r / (DSEQ * 4); float lgf, lgb; decay_log2(a, l, h, lgf, lgb);
            nv_ret_row(a, l, NPR + b * DSEQ, DSEQ, t, h, b, lgf, lgb, qs, ps, F.lane); continue; } r -= T_RS;
        if (r < T_AP) { const int t = r % SEQ, h = (r / SEQ) % 8, b = r / (SEQ * 8); const int m = b * SEQ + t;
            nv_attn_row(QB + (size_t)m * 1024 + h * 128, (const bf16*)(ws + WS_KP) + (size_t)b * SEQ * 256 + (h >> 2) * 128, (const bf16*)(ws + WS_VP) + (size_t)b * SEQ * 256 + (h >> 2) * 128, SEQ,
                        MIX + (size_t)m * DM + h * 128, qs, ps, F.lane); continue; } r -= T_AP;
        if (r < T_RP) { const int t = r % SEQ, h = (r / SEQ) % 4, b = r / (SEQ * 4); float lgf, lgb; decay_log2(a, l, h, lgf, lgb);
            nv_ret_row(a, l, b * SEQ, SEQ, t, h, -1, lgf, lgb, qs, ps, F.lane); continue; } r -= T_RP;
        { const int d = r % 128, dir = (r / 128) % 2, h = (r / 256) % 4, b = r / 1024; float lgf, lgb; decay_log2(a, l, h, lgf, lgb);
          nv_ret_state(a, l, b, h, dir, d, dir == 0 ? lgf : lgb, F.lane); }
    }
}

constexpr int N_PHASES = 26;

template <class Epi> __device__ __forceinline__ void run_gemm(const Frame& F, const bf16* A, const bf16* Bt, int N, int K, const Epi& E) {
    pg8::Gemm g{A, Bt, MT, N, K}; pg8::StaticOrder S; S.init(MT, N, F.G, (int)blockIdx.x);
    pg8::gemm_phase<Epi, pg8::StaticOrder, true, true>(F.lds, g, S, E);
}

__global__ void __launch_bounds__(NWAVES * 64, 2) trunk_fwd(KArgs args) {
    extern __shared__ __attribute__((aligned(16))) unsigned char lds[];
    volatile LAS unsigned* MISC = (volatile LAS unsigned*)((LAS unsigned char*)lds + MISC_OFF);
    for (int u = threadIdx.x; u < (LDS_BYTES - LDSCTL_OFF) / 4; u += NWAVES * 64) ((LAS unsigned*)((LAS unsigned char*)lds + LDSCTL_OFF))[u] = 0u;
    __syncthreads();
    unsigned* ctl = (unsigned*)(args.ws + WS_CTL);
    XcdBarrier bar; bar.bar = ctl + CW_BAR; bar.x = 0; bar.st = nullptr;
    const bool multi = (args.ph_hi - args.ph_lo) > 1;
    if (multi) bar = xcd_barrier_post(ctl + CW_BAR, MISC + 8);

    for (int ph = args.ph_lo; ph < args.ph_hi; ++ph) {
        Frame F;
        { int t_ = threadIdx.x; asm volatile("" : "+v"(t_)); F.tid = t_; }
        F.lds = (LAS unsigned char*)lds; F.lane = F.tid & 63; F.wave = __builtin_amdgcn_readfirstlane(F.tid >> 6);
        F.G = gridDim.x; F.gw = blockIdx.x * NWAVES + F.wave; F.NGW = F.G * NWAVES;
        KA ap; { unsigned long long p_ = (unsigned long long)__builtin_amdgcn_kernarg_segment_ptr(); asm volatile("" : "+s"(p_)); ap = (KA)p_; }
        unsigned char* ws = ap->ws;
#ifndef PH_MASK
#define PH_MASK 0xFFFF
#endif
        if (ph == 0) { if (PH_MASK & 1) phase_prologue(F, ap); }
        else if (ph == N_PHASES - 1) phase_prenorm(F, ap, 0, 3);
        else {
            const int l = (ph - 1) / 12, s = (ph - 1) % 12;
            const float* modl = (const float*)(ws + WS_MOD) + (size_t)l * 3 * MODW;
            switch (s) {
                case 0: if (PH_MASK & 2) phase_prenorm(F, ap, l, 0); break;
                case 3: if (PH_MASK & 2) phase_prenorm(F, ap, l, 1); break;
                case 9: if (PH_MASK & 2) phase_prenorm(F, ap, l, 2); break;
                case 1: case 10: {
                    const int i = s == 1 ? 0 : 1;
                    pg8::EpiPair<0> E{(bf16*)(ws + WS_ACT), DFF, 0};
                    if (PH_MASK & 4) run_gemm(F, (const bf16*)(ws + WS_H), (const bf16*)(ws + WS_WFI) + (size_t)(l * 2 + i) * 2 * DFF * DM, 2 * DFF, DM, E); break; }
                case 2: case 11: {
                    const int i = s == 2 ? 0 : 1, sub = s == 2 ? 0 : 2;
                    pg8::EpiResid E{(float*)(ws + WS_XR), modl + sub * 3 * DM + 2 * DM, MODW, 0.5f};
                    if (PH_MASK & 8) run_gemm(F, (const bf16*)(ws + WS_ACT), (const bf16*)(ws + WS_WFO) + (size_t)(l * 2 + i) * DM * DFF, DM, DFF, E); break; }
                case 4: {
                    pg8::EpiBf16 E{(bf16*)(ws + WS_PROJ), INW};
                    if (PH_MASK & 16) run_gemm(F, (const bf16*)(ws + WS_H), (const bf16*)(ws + WS_WIN) + (size_t)l * INW * DM, INW, DM, E); break; }
                case 5: if (PH_MASK & 32) phase_qkvpost(F, ap, l); break;
                case 6: if (PH_MASK & 64) phase_mixer_naive(F, ap, l); break;
                case 7: {
                    pg8::EpiPair<1> E{(bf16*)(ws + WS_MIX), DM, 1024};
                    if (PH_MASK & 128) run_gemm(F, (const bf16*)(ws + WS_YSB), (const bf16*)(ws + WS_WGLU) + (size_t)l * 1024 * 512, 1024, 512, E); break; }
                case 8: {
                    pg8::EpiResid E{(float*)(ws + WS_XR), modl + 1 * 3 * DM + 2 * DM, MODW, 1.0f};
                    if (PH_MASK & 256) run_gemm(F, (const bf16*)(ws + WS_MIX), (const bf16*)(ws + WS_WOUT) + (size_t)l * DM * DM, DM, DM, E); break; }
                default: break;
            }
        }
        if (ph + 1 < args.ph_hi) xcd_barrier(bar);
    }
}

extern "C" void kernel_launch(void* const* d_in, const int* in_sizes, int n_in, void* d_out, int out_size, void* d_ws, size_t ws_size, hipStream_t stream) {
    static int grid = 0;
    if (grid == 0) {
        if (n_in != 28 || out_size != (int)O_END || ws_size < WS_END) { fprintf(stderr, "kernel_launch: unexpected shapes: n_in %d out %d ws %zu (need >= %zu)\n", n_in, out_size, ws_size, (size_t)WS_END); grid = -1; return; }
        int dev = 0, cus = 0, per_cu = 0;
        if (hipGetDevice(&dev) != hipSuccess || hipDeviceGetAttribute(&cus, hipDeviceAttributeMultiprocessorCount, dev) != hipSuccess) { fprintf(stderr, "kernel_launch: device query failed\n"); grid = -1; return; }
        if (hipFuncSetAttribute((const void*)trunk_fwd, hipFuncAttributeMaxDynamicSharedMemorySize, LDS_BYTES) != hipSuccess) { fprintf(stderr, "kernel_launch: hipFuncSetAttribute failed\n"); grid = -1; return; }
        if (hipOccupancyMaxActiveBlocksPerMultiprocessor(&per_cu, (const void*)trunk_fwd, NWAVES * 64, LDS_BYTES) != hipSuccess || per_cu < 1) { fprintf(stderr, "kernel_launch: occupancy query says %d blocks per CU\n", per_cu); (void)hipGetLastError(); grid = -1; return; }
        grid = cus;
        if (grid > 256) grid = 256;
    }
    if (grid < 0) return;
    (void)hipMemsetAsync((char*)d_ws + WS_CTL, 0, CTL_ZERO_BYTES, stream);
    KArgs a{};
    for (int i = 0; i < 28; ++i) a.in[i] = (const float*)d_in[i];
    a.out = (float*)d_out; a.ws = (unsigned char*)d_ws;
#if MK_ONE_LAUNCH
    a.ph_lo = 0; a.ph_hi = N_PHASES; a.li = 0;
    hipLaunchKernelGGL(trunk_fwd, dim3(grid), dim3(NWAVES * 64), LDS_BYTES, stream, a);
#else
    for (int ph = 0; ph < N_PHASES; ++ph) { a.ph_lo = ph; a.ph_hi = ph + 1; a.li = ph;
        hipLaunchKernelGGL(trunk_fwd, dim3(grid), dim3(NWAVES * 64), LDS_BYTES, stream, a); }
#endif
    const hipError_t le = hipPeekAtLastError();
    if (le != hipSuccess) fprintf(stderr, "kernel_launch: launch failed: %s\n", hipGetErrorName(le));
}
```

```cpp
#define MK_ONE_LAUNCH 1
#include <hip/hip_runtime.h>
#include <cstdio>
#include <cstdint>
#include <cmath>

constexpr int DM = 2048, NPR = 4096, NSR = 2048, MT = 6144, DFF = 5632, INW = 4096;
constexpr int SEQ = 256, DSEQ = 1024, PAST = 512, NBP = 16, NBS = 2, NLAYER = 2;
constexpr int KALL = PAST + DSEQ;
constexpr int MODW = 9 * DM;
constexpr float EPS = 1e-6f;
constexpr int C_QA = 0, C_KA = 1024, C_VA = 1280, C_US = 1536, C_QR = 2048, C_KR = 2560, C_VR = 3072, C_GR = 3584;
constexpr size_t O_Y = 0, O_CK = 12582912, O_CV = 14680064, O_SSM = 16777216, O_RET = 17039360, O_END = 21233664;

namespace pg8 {
#define PG8_LAS __attribute__((address_space(3)))
typedef unsigned short bf16_t;
typedef short bf16x8 __attribute__((ext_vector_type(8)));
typedef float f32x4 __attribute__((ext_vector_type(4)));
typedef unsigned u32x4 __attribute__((ext_vector_type(4)));
constexpr int BM = 256, BK = 64, HALF = 128, HTB = HALF * BK * 2, STAGE_BYTES = 8 * HTB, NXCD = 8, WGM = 8;

__host__ __device__ __forceinline__ int lds_byte(int r, int c) { const int st = (r >> 4) * 2 + (c >> 5), rr = r & 15, cc = c & 31, ob = rr * 64 + cc * 2; return st * 1024 + (ob ^ (((ob >> 9) & 1) << 5)); }
__host__ __device__ __forceinline__ void stage_rc(int b, int& R, int& C) { const int st = b / 1024, sb = b % 1024, swz = sb ^ (((sb >> 9) & 1) << 5); R = (st >> 1) * 16 + swz / 64; C = (st & 1) * 32 + (swz % 64) / 2; }
__host__ __device__ __forceinline__ int perm32(int rho) { const int n = rho >> 4, i = rho & 15; return 8 * (i >> 2) + 4 * n + (i & 3); }

struct Unit { int pm, pn; };
struct Gemm { const bf16_t* A; const bf16_t* Bt; int M, N, K; };

struct StaticOrder {
    int nM, nN, nwg, G, c;
    __host__ __device__ void init(int M, int N, int G_, int c_) { nM = M / BM; nN = N / BM; nwg = nM * nN; G = G_; c = c_; }
    __host__ __device__ bool next(int i, Unit& u) const {
        const long L = (long)i * G + c; if (L >= nwg) return false;
        int wgid = (int)L; { const int q = nwg / NXCD, r = nwg % NXCD, xcd = wgid % NXCD, off = wgid / NXCD; wgid = (xcd < r ? xcd * (q + 1) : r * (q + 1) + (xcd - r) * q) + off; }
        const int nig = WGM * nN, gid = wgid / nig, fm = gid * WGM, gsz = (nM - fm) < WGM ? (nM - fm) : WGM;
        u.pm = fm + ((wgid % nig) % gsz); u.pn = (wgid % nig) / gsz; return true;
    }
    __device__ __forceinline__ void a_ready(const Unit&) const {}
    __device__ __forceinline__ void done(const Unit&) const {}
};

__device__ __forceinline__ unsigned cvt_pk_bf16(float lo, float hi) { unsigned r; asm volatile("v_cvt_pk_bf16_f32 %0, %1, %2" : "=v"(r) : "v"(lo), "v"(hi)); return r; }
__device__ __forceinline__ float fast_sigmoid(float x) { return __builtin_amdgcn_rcpf(1.0f + __builtin_amdgcn_exp2f(-1.4426950408889634f * x)); }

struct EpiBf16 {
    static constexpr bool PERM = true, AFTER_DRAIN = false;
    bf16_t* O; int ldc;
    __device__ __forceinline__ void operator()(const f32x4 (&acc)[2][2][4][2], const Unit& u, int wr, int wc, int fr, int fq) const {
        const int row0 = u.pm * BM + wr * 64 + fr; const int col0 = u.pn * BM + wc * 32 + 8 * fq;
#pragma unroll
        for (int ai = 0; ai < 2; ++ai)
#pragma unroll
            for (int m = 0; m < 4; ++m) { bf16_t* rowp = O + (size_t)(row0 + ai * HALF + m * 16) * ldc + col0;
#pragma unroll
                for (int bj = 0; bj < 2; ++bj) { const f32x4 v0 = acc[ai][bj][m][0], v1 = acc[ai][bj][m][1];
                    u32x4 w; w.x = cvt_pk_bf16(v0[0], v0[1]); w.y = cvt_pk_bf16(v0[2], v0[3]); w.z = cvt_pk_bf16(v1[0], v1[1]); w.w = cvt_pk_bf16(v1[2], v1[3]);
                    *(u32x4*)(rowp + bj * HALF) = w; } }
    }
};
template <int ACT> struct EpiPair {
    static constexpr bool PERM = true, AFTER_DRAIN = false;
    bf16_t* O; int ldc; int coff;
    __device__ __forceinline__ void operator()(const f32x4 (&acc)[2][2][4][2], const Unit& u, int wr, int wc, int fr, int fq) const {
        const int row0 = u.pm * BM + wr * 64 + fr; const int col0 = coff + u.pn * HALF + wc * 32 + 8 * fq;
#pragma unroll
        for (int ai = 0; ai < 2; ++ai)
#pragma unroll
            for (int m = 0; m < 4; ++m) { bf16_t* rowp = O + (size_t)(row0 + ai * HALF + m * 16) * ldc + col0;
                float r[8];
#pragma unroll
                for (int n = 0; n < 2; ++n)
#pragma unroll
                    for (int j = 0; j < 4; ++j) { const float a = acc[ai][0][m][n][j], g = acc[ai][1][m][n][j];
                        r[n * 4 + j] = (ACT == 0) ? a * fast_sigmoid(a) * g : a * fast_sigmoid(g); }
                u32x4 w; w.x = cvt_pk_bf16(r[0], r[1]); w.y = cvt_pk_bf16(r[2], r[3]); w.z = cvt_pk_bf16(r[4], r[5]); w.w = cvt_pk_bf16(r[6], r[7]);
                *(u32x4*)rowp = w; }
    }
};
struct EpiResid {
    static constexpr bool PERM = false, AFTER_DRAIN = false;
    float* X; const float* gate0; int gstride; float s;
    __device__ __forceinline__ void operator()(const f32x4 (&acc)[2][2][4][2], const Unit& u, int wr, int wc, int fr, int fq) const {
        const int row0 = u.pm * BM + wr * 64 + fr, col0 = u.pn * BM + wc * 32 + 4 * fq;
        const int var = u.pm < 16 ? 0 : (u.pm < 20 ? 1 : 2);
        const float* gp = gate0 + (size_t)var * gstride + col0;
        f32x4 gv[2][2];
#pragma unroll
        for (int bj = 0; bj < 2; ++bj)
#pragma unroll
            for (int n = 0; n < 2; ++n) gv[bj][n] = *(const f32x4*)(gp + bj * HALF + n * 16) * s;
#pragma unroll
        for (int ai = 0; ai < 2; ++ai)
#pragma unroll
            for (int m = 0; m < 4; ++m) { float* rowp = X + (size_t)(row0 + ai * HALF + m * 16) * DM + col0;
#pragma unroll
                for (int bj = 0; bj < 2; ++bj)
#pragma unroll
                    for (int n = 0; n < 2; ++n) { float* p = rowp + bj * HALF + n * 16; const f32x4 x = *(const f32x4*)p; *(f32x4*)p = x + gv[bj][n] * acc[ai][bj][m][n]; } }
    }
};

template <class Epi, class Sched, bool ALIGN_EPI = false, bool SP2 = false>
__device__ __forceinline__ void gemm_phase(PG8_LAS unsigned char* lds, const Gemm g, const Sched& S, const Epi& E) {
    int tid_ = threadIdx.x; asm volatile("" : "+v"(tid_));
    const int tid = tid_, wid = __builtin_amdgcn_readfirstlane(tid >> 6), lane = tid & 63, wr = wid >> 2, wc = wid & 3, fr = lane & 15, fq = lane >> 4;
    const int K = g.K, nt = K / BK;
    unsigned voffA[2], voffB[2];
#pragma unroll
    for (int i = 0; i < 2; ++i) { int R, C; stage_rc(tid * 16 + i * 8192, R, C); const int Rb = Epi::PERM ? ((R & ~31) + perm32(R & 31)) : R;
        voffA[i] = (unsigned)(R * K + C) * 2u; voffB[i] = (unsigned)(Rb * K + C) * 2u; }
    const size_t kstep = (size_t)(BK * 2);
    const size_t hstep = (size_t)HALF * K * 2;
    const size_t tstep = 2 * hstep;
    const unsigned ldsw = (unsigned)wid * 1024u;
    const int aoff = lds_byte(wr * 64 + fr, fq * 8), boff = lds_byte(wc * 32 + fr, fq * 8);
#define PG8_SA(b, h) (((b) * 2 + (h)) * HTB)
#define PG8_SB(b, h) ((4 + (b) * 2 + (h)) * HTB)
#define PG8_STAGE(bufoff, gbase, voff) do { _Pragma("unroll") for (int _i = 0; _i < 2; ++_i) \
        __builtin_amdgcn_global_load_lds((const unsigned*)((const char*)(gbase) + (voff)[_i]), (PG8_LAS unsigned*)(lds + (bufoff) + ldsw + _i * 8192), 16, 0, 0); } while (0)
#define PG8_LDA(dst, b, h) do { _Pragma("unroll") for (int m = 0; m < 4; ++m) _Pragma("unroll") for (int k = 0; k < 2; ++k) dst[m][k] = *(const PG8_LAS bf16x8*)(lds + PG8_SA(b, h) + aoff + m * 2048 + k * 1024); } while (0)
#define PG8_LDB(dst, b, h) do { _Pragma("unroll") for (int n = 0; n < 2; ++n) _Pragma("unroll") for (int k = 0; k < 2; ++k) dst[n][k] = *(const PG8_LAS bf16x8*)(lds + PG8_SB(b, h) + boff + n * 2048 + k * 1024); } while (0)
#define PG8_MMA(ai, bj, At, Bt) do { __builtin_amdgcn_s_setprio(1); _Pragma("unroll") for (int m = 0; m < 4; ++m) _Pragma("unroll") for (int n = 0; n < 2; ++n) _Pragma("unroll") for (int k = 0; k < 2; ++k) \
        acc[ai][bj][m][n] = __builtin_amdgcn_mfma_f32_16x16x32_bf16(Bt[n][k], At[m][k], acc[ai][bj][m][n], 0, 0, 0); __builtin_amdgcn_s_setprio(0); } while (0)
#define PG8_WAIT_V(n) asm volatile("s_waitcnt vmcnt(" #n ")" ::: "memory")
#define PG8_WAIT_L(n) asm volatile("s_waitcnt lgkmcnt(" #n ")" ::: "memory")
#define PG8_BAR __builtin_amdgcn_s_barrier()
#define PG8_SCHED __builtin_amdgcn_sched_barrier(0)
    Unit cur, nxt; int ui = 0;
    if (!S.next(0, cur)) return;
    f32x4 acc[2][2][4][2];
#pragma unroll
    for (int a = 0; a < 2; ++a)
#pragma unroll
        for (int b = 0; b < 2; ++b)
#pragma unroll
            for (int m = 0; m < 4; ++m)
#pragma unroll
                for (int n = 0; n < 2; ++n) acc[a][b][m][n] = (f32x4){0.f, 0.f, 0.f, 0.f};
    bf16x8 At[4][2], B0[2][2], B1[2][2];
    const char* cA = (const char*)g.A + (size_t)cur.pm * tstep; const char* cB = (const char*)g.Bt + (size_t)cur.pn * tstep;
    S.a_ready(cur);
    if constexpr (SP2) {
        PG8_STAGE(PG8_SB(0, 0), cB, voffB); PG8_STAGE(PG8_SB(0, 1), cB + hstep, voffB); PG8_STAGE(PG8_SA(0, 0), cA, voffA); PG8_STAGE(PG8_SA(0, 1), cA + hstep, voffA);
        if (wr == 1) PG8_BAR;
        PG8_WAIT_V(2); PG8_BAR;
        PG8_STAGE(PG8_SB(1, 0), cB + kstep, voffB); PG8_STAGE(PG8_SA(1, 0), cA + kstep, voffA); PG8_STAGE(PG8_SB(1, 1), cB + hstep + kstep, voffB);
        PG8_WAIT_V(6); PG8_BAR;
    } else {
        PG8_STAGE(PG8_SB(0, 0), cB, voffB); PG8_STAGE(PG8_SA(0, 0), cA, voffA); PG8_STAGE(PG8_SB(0, 1), cB + hstep, voffB); PG8_STAGE(PG8_SA(0, 1), cA + hstep, voffA);
        if (wr == 1) PG8_BAR;
        PG8_WAIT_V(4); PG8_BAR;
        PG8_STAGE(PG8_SB(1, 0), cB + kstep, voffB); PG8_STAGE(PG8_SA(1, 0), cA + kstep, voffA); PG8_STAGE(PG8_SB(1, 1), cB + hstep + kstep, voffB);
        PG8_WAIT_V(6); PG8_BAR;
    }
    for (;;) {
        const bool has_next = S.next(ui + 1, nxt);
        const char* nA = has_next ? (const char*)g.A + (size_t)nxt.pm * tstep : cA; const char* nB = has_next ? (const char*)g.Bt + (size_t)nxt.pn * tstep : cB;
        for (int t = 0; t < nt; t += 2) {
            const bool last = (t == nt - 2);
            const char* a1 = cA + (size_t)(t + 1) * kstep;
            const char* a2 = last ? nA : cA + (size_t)(t + 2) * kstep; const char* b2 = last ? nB : cB + (size_t)(t + 2) * kstep;
            const char* a3 = a2 + kstep; const char* b3 = b2 + kstep;
            if (last && has_next) S.a_ready(nxt);
            if constexpr (SP2) {
            PG8_LDB(B0, 0, 0); PG8_LDB(B1, 0, 1); PG8_SCHED; PG8_LDA(At, 0, 0); PG8_STAGE(PG8_SA(1, 1), a1 + hstep, voffA);
            PG8_WAIT_V(8); PG8_WAIT_L(0); PG8_BAR; PG8_MMA(0, 0, At, B0); PG8_MMA(0, 1, At, B1); PG8_BAR; PG8_SCHED;
            PG8_LDA(At, 0, 1); PG8_STAGE(PG8_SB(0, 0), b2, voffB); PG8_STAGE(PG8_SB(0, 1), b2 + hstep, voffB); PG8_STAGE(PG8_SA(0, 0), a2, voffA);
            PG8_WAIT_V(8); PG8_WAIT_L(0); PG8_BAR; PG8_MMA(1, 0, At, B0); PG8_MMA(1, 1, At, B1); PG8_BAR; PG8_SCHED;
            PG8_LDB(B0, 1, 0); PG8_LDB(B1, 1, 1); PG8_SCHED; PG8_LDA(At, 1, 0); PG8_STAGE(PG8_SA(0, 1), a2 + hstep, voffA);
            PG8_WAIT_V(8); PG8_WAIT_L(0); PG8_BAR; PG8_MMA(0, 0, At, B0); PG8_MMA(0, 1, At, B1); PG8_BAR; PG8_SCHED;
            PG8_LDA(At, 1, 1); PG8_STAGE(PG8_SB(1, 0), b3, voffB); PG8_STAGE(PG8_SB(1, 1), b3 + hstep, voffB); PG8_STAGE(PG8_SA(1, 0), a3, voffA);
            PG8_WAIT_V(8); PG8_WAIT_L(0); PG8_BAR; PG8_MMA(1, 0, At, B0); PG8_MMA(1, 1, At, B1); PG8_BAR; PG8_SCHED;
            } else {
            PG8_LDB(B0, 0, 0); PG8_SCHED; PG8_LDA(At, 0, 0); PG8_STAGE(PG8_SA(1, 1), a1 + hstep, voffA);
            PG8_WAIT_L(8); PG8_BAR; PG8_WAIT_L(0); PG8_MMA(0, 0, At, B0); PG8_BAR; PG8_SCHED;
            PG8_LDB(B1, 0, 1); PG8_STAGE(PG8_SB(0, 0), b2, voffB);
            PG8_BAR; PG8_WAIT_L(0); PG8_MMA(0, 1, At, B1); PG8_BAR;
            PG8_LDA(At, 0, 1); PG8_STAGE(PG8_SA(0, 0), a2, voffA);
            PG8_BAR; PG8_WAIT_L(0); PG8_MMA(1, 0, At, B0); PG8_BAR; PG8_SCHED;
            PG8_STAGE(PG8_SB(0, 1), b2 + hstep, voffB);
            PG8_WAIT_V(6); PG8_BAR; PG8_MMA(1, 1, At, B1); PG8_BAR;
            PG8_LDB(B0, 1, 0); PG8_SCHED; PG8_LDA(At, 1, 0); PG8_STAGE(PG8_SA(0, 1), a2 + hstep, voffA);
            PG8_WAIT_L(8); PG8_BAR; PG8_WAIT_L(0); PG8_MMA(0, 0, At, B0); PG8_BAR; PG8_SCHED;
            PG8_LDB(B1, 1, 1); PG8_STAGE(PG8_SB(1, 0), b3, voffB);
            PG8_BAR; PG8_WAIT_L(0); PG8_MMA(0, 1, At, B1); PG8_BAR;
            PG8_LDA(At, 1, 1); PG8_STAGE(PG8_SA(1, 0), a3, voffA);
            PG8_BAR; PG8_WAIT_L(0); PG8_MMA(1, 0, At, B0); PG8_BAR; PG8_SCHED;
            PG8_STAGE(PG8_SB(1, 1), b3 + hstep, voffB);
            PG8_WAIT_V(6); PG8_BAR; PG8_MMA(1, 1, At, B1); PG8_BAR;
            }
        }
        if constexpr (ALIGN_EPI) { if (wr == 0) PG8_BAR; }
        if constexpr (!Epi::AFTER_DRAIN) { E(acc, cur, wr, wc, fr, fq); S.done(cur); }
        if (!has_next) break;
#pragma unroll
        for (int a = 0; a < 2; ++a)
#pragma unroll
            for (int b = 0; b < 2; ++b)
#pragma unroll
                for (int m = 0; m < 4; ++m)
#pragma unroll
                    for (int n = 0; n < 2; ++n) acc[a][b][m][n] = (f32x4){0.f, 0.f, 0.f, 0.f};
        cur = nxt; cA = nA; cB = nB; ++ui;
        if constexpr (ALIGN_EPI) { if (wr == 1) PG8_BAR; }
    }
    PG8_WAIT_V(0);
    if constexpr (!ALIGN_EPI) { if (wr == 0) PG8_BAR; }
    PG8_BAR;
    if constexpr (Epi::AFTER_DRAIN) { E.fused(acc, cur, wr, wc, fr, fq, lds, wid, lane); S.done(cur); }
#undef PG8_SA
#undef PG8_SB
#undef PG8_STAGE
#undef PG8_LDA
#undef PG8_LDB
#undef PG8_MMA
#undef PG8_WAIT_V
#undef PG8_WAIT_L
#undef PG8_BAR
#undef PG8_SCHED
}
}

typedef unsigned short bf16;
typedef unsigned v4u __attribute__((ext_vector_type(4)));
typedef float f32x4 __attribute__((ext_vector_type(4)));
#define GAS __attribute__((address_space(1)))
#define LAS __attribute__((address_space(3)))
typedef GAS unsigned gu32;
#define RLX_AGENT __ATOMIC_RELAXED, __HIP_MEMORY_SCOPE_AGENT
#define LDS_WAIT() asm volatile("s_waitcnt lgkmcnt(0)" ::: "memory")
#define VM_WAIT() asm volatile("s_waitcnt vmcnt(0)" ::: "memory")

constexpr int NWAVES = 8;
#ifndef MK_ONE_LAUNCH
#define MK_ONE_LAUNCH 0
#endif
constexpr size_t MiB = 1u << 20;
constexpr size_t WS_CTL = 0, CTL_ZERO_BYTES = 2 * MiB;
constexpr size_t WS_MOD = 1 * MiB;
constexpr size_t WS_COS = 2 * MiB, WS_SIN = 2 * MiB + 256 * 1024, WS_LAM = 2 * MiB + 512 * 1024, WS_BBAR = 3 * MiB;
constexpr size_t WS_WFI = 8 * MiB, WS_WFO = 184 * MiB, WS_WIN = 272 * MiB, WS_WOUT = 304 * MiB, WS_WGLU = 320 * MiB;
constexpr size_t WS_XR = 322 * MiB, WS_H = 370 * MiB, WS_ACT = 394 * MiB, WS_PROJ = 460 * MiB, WS_QB = 508 * MiB;
constexpr size_t WS_KP = 520 * MiB, WS_VP = 522 * MiB, WS_KS = 524 * MiB, WS_VS = 526 * MiB, WS_QR = 528 * MiB, WS_KR = 534 * MiB;
constexpr size_t WS_MIX = 540 * MiB, WS_YS = 564 * MiB, WS_YSB = 576 * MiB, WS_END = 582 * MiB;
constexpr int CW_BAR = 4096;
constexpr int RING_BYTES = 131072, LDSCTL_OFF = RING_BYTES, MISC_OFF = LDSCTL_OFF + 320, LDS_BYTES = 147456;

__device__ __forceinline__ unsigned f2bf(float f) { unsigned u = __builtin_bit_cast(unsigned, f); return (u + 0x7fffu + ((u >> 16) & 1u)) >> 16; }
__device__ __forceinline__ unsigned pk2(float lo, float hi) { return f2bf(lo) | (f2bf(hi) << 16); }
__device__ __forceinline__ float bf2f(unsigned short h) { return __builtin_bit_cast(float, (unsigned)h << 16); }
__device__ __forceinline__ float bflo(unsigned w) { return __builtin_bit_cast(float, w << 16); }
__device__ __forceinline__ float bfhi(unsigned w) { return __builtin_bit_cast(float, w & 0xffff0000u); }

#define XB_TMO      128
#define XB_XCNT(j)  (256  + 64 * (j))
#define XB_XSUB(j)  (1280 + 64 * (j))
#define XB_XGEN(j)  (2304 + 64 * (j))
#define XB_TOP      3328
#define XB_TOPGEN   3392
#define XCD_BAR_WORDS 3456
#define XB_SPIN_CAP (1u << 18)
__device__ __forceinline__ unsigned xb_ld(unsigned* p)              { return __hip_atomic_load(p, __ATOMIC_RELAXED, __HIP_MEMORY_SCOPE_AGENT); }
__device__ __forceinline__ unsigned xb_add(unsigned* p, unsigned v) { return __hip_atomic_fetch_add(p, v, __ATOMIC_RELAXED, __HIP_MEMORY_SCOPE_AGENT); }
__device__ __forceinline__ unsigned xb_xcc_id() { return (unsigned)__builtin_amdgcn_s_getreg((3 << 11) | 20) & 0xFu; }
#define XB_SPIN(cond, bar) do { unsigned _sp = 0; while (cond) { __builtin_amdgcn_s_sleep(1); \
    if ((++_sp & 255u) == 0u) { if (xb_ld(&(bar)[XB_TMO])) break; if (_sp > XB_SPIN_CAP) { atomicAdd(&(bar)[XB_TMO], 1u); break; } } } } while (0)
struct XcdBarrier { unsigned* bar; unsigned x; volatile LAS unsigned* st; };
__device__ __forceinline__ XcdBarrier xcd_barrier_post(unsigned* bar, volatile LAS unsigned* st) {
    XcdBarrier b; b.bar = bar; b.x = xb_xcc_id(); b.st = st;
    if (threadIdx.x == 0) (void)xb_add(&bar[XB_XCNT(b.x)], 1u);
    return b;
}
__device__ __forceinline__ void xcd_barrier_complete(unsigned* bar, unsigned x, unsigned& nloc, unsigned& nx) {
    const unsigned G = gridDim.x * gridDim.y * gridDim.z;
    unsigned sum, cnt, mine, sp = 0u;
    for (;;) {
        sum = 0u; cnt = 0u; mine = 0u;
#pragma unroll
        for (unsigned j = 0; j < 16; ++j) { const unsigned c = xb_ld(&bar[XB_XCNT(j)]); sum += c; cnt += (c > 0u) ? 1u : 0u; mine = (j == x) ? c : mine; }
        if (sum == G) break;
        __builtin_amdgcn_s_sleep(1);
        if ((++sp & 255u) == 0u) { if (xb_ld(&bar[XB_TMO])) break; if (sp > XB_SPIN_CAP) { atomicAdd(&bar[XB_TMO], 1u); break; } }
    }
    nloc = mine > 0u ? mine : 1u; nx = cnt > 0u ? cnt : 1u;
}
__device__ __forceinline__ void xcd_barrier(const XcdBarrier& b) {
    asm volatile("s_waitcnt vmcnt(0)" ::: "memory");
    __syncthreads();
    if (threadIdx.x == 0) {
        unsigned* bar = b.bar;
        __builtin_amdgcn_s_waitcnt(0);
        unsigned nloc = b.st[0], nx = b.st[1];
        if (nloc == 0u) { xcd_barrier_complete(bar, b.x, nloc, nx); b.st[0] = nloc; b.st[1] = nx; }
        const unsigned old = xb_add(&bar[XB_XSUB(b.x)], 1u);
        const unsigned gen = old / nloc;
        if (old + 1u == (gen + 1u) * nloc) {
            __builtin_amdgcn_fence(__ATOMIC_RELEASE, "agent");
            asm volatile("s_waitcnt vmcnt(0)" ::: "memory");
            const unsigned og = xb_add(&bar[XB_TOP], 1u);
            const unsigned tg = og / nx;
            if (og + 1u == (tg + 1u) * nx) xb_add(&bar[XB_TOPGEN], 1u);
            else XB_SPIN(xb_ld(&bar[XB_TOPGEN]) == tg, bar);
            __builtin_amdgcn_fence(__ATOMIC_ACQUIRE, "agent");
            xb_add(&bar[XB_XGEN(b.x)], 1u);
            asm volatile("s_waitcnt vmcnt(0)" ::: "memory");
        } else {
            XB_SPIN(xb_ld(&bar[XB_XGEN(b.x)]) == gen, bar);
            __builtin_amdgcn_fence(__ATOMIC_ACQUIRE, "agent");
            asm volatile("s_waitcnt vmcnt(0)" ::: "memory");
        }
    }
    __syncthreads();
}

struct KArgs { const float* in[28]; float* out; unsigned char* ws; int ph_lo, ph_hi, li, pad; };
typedef const __attribute__((address_space(4))) KArgs* KA;
enum { I_XP = 0, I_XS, I_CK, I_CV, I_SSSM, I_SRET, I_C, I_CCTX, I_WMOD, I_BMOD, I_NORMG, I_WFI, I_WFO, I_WIN, I_WOUT, I_QNG, I_KNG,
       I_ARE, I_AIM, I_LOGDT, I_BRE, I_BIM, I_CRE, I_CIM, I_SSMD, I_WGLU, I_DECAY, I_FNG };

struct Frame {
    LAS unsigned char* lds;
    int tid, lane, wave, G, gw, NGW;
};

__device__ __forceinline__ float wave_sum(float v) {
#pragma unroll
    for (int o = 1; o < 64; o <<= 1) v += __shfl_xor(v, o);
    return v;
}
__device__ __forceinline__ float wave_max(float v) {
#pragma unroll
    for (int o = 1; o < 64; o <<= 1) v = fmaxf(v, __shfl_xor(v, o));
    return v;
}
__device__ __forceinline__ float silu_f(float x) { return x / (1.0f + __expf(-x)); }
__device__ __forceinline__ float gelu_tanh(float x) { const float u = 0.7978845608028654f * (x + 0.044715f * x * x * x); return 0.5f * x * (1.0f + tanhf(u)); }

__device__ __forceinline__ void p0_transpose_item(const float* W, int K, int N, bf16* WT, int halfN, LAS float* scr, int item, int lane) {
    const int nblk = N / 32, kb = item / nblk, nb = item % nblk, k0 = 64 * kb, n0 = 32 * nb;
    int R0 = n0;
    if (halfN) { if (n0 < halfN) R0 = 256 * (n0 >> 7) + (n0 & 127); else { const int n1 = n0 - halfN; R0 = 256 * (n1 >> 7) + 128 + (n1 & 127); } }
#pragma unroll 8
    for (int i = 0; i < 32; ++i) { const int kk = 2 * i + (lane >> 5); scr[kk * 33 + (lane & 31)] = W[(size_t)(k0 + kk) * N + n0 + (lane & 31)]; }
    LDS_WAIT(); asm volatile("" ::: "memory");
    const int c = lane & 7;
#pragma unroll
    for (int j = 0; j < 4; ++j) { const int n = (lane >> 3) + 8 * j; const LAS float* s = scr + (8 * c) * 33 + n;
        v4u o; o.x = pk2(s[0 * 33], s[1 * 33]); o.y = pk2(s[2 * 33], s[3 * 33]); o.z = pk2(s[4 * 33], s[5 * 33]); o.w = pk2(s[6 * 33], s[7 * 33]);
        *(GAS v4u*)(WT + (size_t)(R0 + n) * K + k0 + 8 * c) = o; }
    LDS_WAIT(); asm volatile("" ::: "memory");
}

__device__ __forceinline__ void phase_prologue(const Frame& F, KA a) {
    unsigned char* ws = a->ws;
    LAS float* cs = (LAS float*)(F.lds);
    LAS float* red = (LAS float*)(F.lds + 24576);
    for (int i = F.tid; i < 3 * DM; i += 512) { const int v = i / DM, k = i % DM; const float c = v == 0 ? a->in[I_CCTX][k] : a->in[I_C][(v - 1) * DM + k]; cs[i] = silu_f(c); }
    __syncthreads();
    float* modb = (float*)(ws + WS_MOD);
    for (int task = blockIdx.x; task < 2 * 72 * 8; task += F.G) {
        const int l = task / 576, r = task % 576, cb = r / 8, kc = r % 8;
        const int kbase = kc * 256 + F.wave * 32, col = cb * 256 + F.lane * 4;
        const float* wp = a->in[I_WMOD] + ((size_t)l * DM + kbase) * MODW + col;
        f32x4 s0 = {0, 0, 0, 0}, s1 = s0, s2 = s0;
#pragma unroll 8
        for (int k = 0; k < 32; ++k) { const f32x4 w = *(const GAS f32x4*)(wp + (size_t)k * MODW);
            s0 += w * cs[kbase + k]; s1 += w * cs[DM + kbase + k]; s2 += w * cs[2 * DM + kbase + k]; }
        LAS float* rp = red + (F.wave * 64 + F.lane) * 12;
#pragma unroll
        for (int j = 0; j < 4; ++j) { rp[j] = s0[j]; rp[4 + j] = s1[j]; rp[8 + j] = s2[j]; }
        __syncthreads();
        for (int o = F.tid; o < 768; o += 512) { const int v = o >> 8, c = o & 255; float s = 0.f;
#pragma unroll
            for (int w = 0; w < 8; ++w) s += red[(w * 64 + (c >> 2)) * 12 + v * 4 + (c & 3)];
            if (kc == 0) s += a->in[I_BMOD][l * MODW + cb * 256 + c];
            unsafeAtomicAdd(modb + ((size_t)l * 3 + v) * MODW + cb * 256 + c, s); }
        __syncthreads();
    }
    {
        float* cosT = (float*)(ws + WS_COS); float* sinT = (float*)(ws + WS_SIN);
        for (int i = blockIdx.x * 512 + F.tid; i < DSEQ * 64; i += F.G * 512) { const int t = i >> 6, j = i & 63, ax = j >> 5, f = j & 31;
            const float pos = (float)(ax == 0 ? (t >> 6) : (t & 63)); const float inv = powf(10000.0f, -(float)f / 32.0f); const float ang = pos * inv;
            float sn, cn; sincosf(ang, &sn, &cn); cosT[i] = cn; sinT[i] = sn; }
        float* lamT = (float*)(ws + WS_LAM); float* bbT = (float*)(ws + WS_BBAR);
        for (int i = blockIdx.x * 512 + F.tid; i < NLAYER * 2 * 32 * 64; i += F.G * 512) {
            const int ldg = i >> 6;
            const float dt = expf(a->in[I_LOGDT][ldg]); const float ar = a->in[I_ARE][i], ai = a->in[I_AIM][i];
            const float x = ar * dt, y = ai * dt; float sn, cn; sincosf(y, &sn, &cn); const float ex = expf(x);
            lamT[2 * i] = ex * cn; lamT[2 * i + 1] = ex * sn;
            const float sh = sinf(0.5f * y); const float nr = expm1f(x) * cn - 2.0f * sh * sh, ni = ex * sn;
            const float d2 = ar * ar + ai * ai; const float cr = (nr * ar + ni * ai) / d2, ci = (ni * ar - nr * ai) / d2;
#pragma unroll
            for (int j = 0; j < 16; ++j) { const float br = a->in[I_BRE][(size_t)i * 16 + j], bi = a->in[I_BIM][(size_t)i * 16 + j];
                bbT[((size_t)i * 16 + j) * 2] = cr * br - ci * bi; bbT[((size_t)i * 16 + j) * 2 + 1] = cr * bi + ci * br; }
        }
    }
    {
        GAS f32x4* xr = (GAS f32x4*)(ws + WS_XR);
        const GAS f32x4* xp = (const GAS f32x4*)a->in[I_XP]; const GAS f32x4* xs = (const GAS f32x4*)a->in[I_XS];
        const int NP4 = NPR * DM / 4, NT4 = MT * DM / 4;
        for (int i = blockIdx.x * 512 + F.tid; i < NT4; i += F.G * 512) xr[i] = i < NP4 ? xp[i] : xs[i - NP4];
    }
    {
        LAS float* scr = (LAS float*)(F.lds + 49152 + F.wave * 8704);
        constexpr int I_FI = (DM / 64) * (2 * DFF / 32), I_FO = (DFF / 64) * (DM / 32), I_IN = (DM / 64) * (INW / 32), I_OUT = (DM / 64) * (DM / 32), I_GL = (512 / 64) * (1024 / 32);
        constexpr int NITEMS = 4 * I_FI + 4 * I_FO + 2 * I_IN + 2 * I_OUT + 2 * I_GL;
        for (int it = F.gw; it < NITEMS; it += F.NGW) {
            int r = it;
            if (r < 4 * I_FI) { const int m = r / I_FI; p0_transpose_item(a->in[I_WFI] + (size_t)m * DM * 2 * DFF, DM, 2 * DFF, (bf16*)(ws + WS_WFI) + (size_t)m * 2 * DFF * DM, DFF, scr, r % I_FI, F.lane); continue; } r -= 4 * I_FI;
            if (r < 4 * I_FO) { const int m = r / I_FO; p0_transpose_item(a->in[I_WFO] + (size_t)m * DFF * DM, DFF, DM, (bf16*)(ws + WS_WFO) + (size_t)m * DM * DFF, 0, scr, r % I_FO, F.lane); continue; } r -= 4 * I_FO;
            if (r < 2 * I_IN) { const int m = r / I_IN; p0_transpose_item(a->in[I_WIN] + (size_t)m * DM * INW, DM, INW, (bf16*)(ws + WS_WIN) + (size_t)m * INW * DM, 0, scr, r % I_IN, F.lane); continue; } r -= 2 * I_IN;
            if (r < 2 * I_OUT) { const int m = r / I_OUT; p0_transpose_item(a->in[I_WOUT] + (size_t)m * DM * DM, DM, DM, (bf16*)(ws + WS_WOUT) + (size_t)m * DM * DM, 0, scr, r % I_OUT, F.lane); continue; } r -= 2 * I_OUT;
            { const int m = r / I_GL; p0_transpose_item(a->in[I_WGLU] + (size_t)m * 512 * 1024, 512, 1024, (bf16*)(ws + WS_WGLU) + (size_t)m * 1024 * 512, 512, scr, r % I_GL, F.lane); }
        }
    }
}

__device__ __forceinline__ void phase_prenorm(const Frame& F, KA a, int l, int sub) {
    unsigned char* ws = a->ws;
    const float* xr = (const float*)(ws + WS_XR);
    for (int m = F.gw; m < MT; m += F.NGW) {
        const GAS f32x4* xp = (const GAS f32x4*)(xr + (size_t)m * DM) + F.lane;
        f32x4 v[8]; float s = 0.f;
#pragma unroll
        for (int j = 0; j < 8; ++j) { v[j] = xp[64 * j]; s += (v[j].x * v[j].x + v[j].y * v[j].y) + (v[j].z * v[j].z + v[j].w * v[j].w); }
        const float rstd = 1.0f / sqrtf(wave_sum(s) * (1.0f / DM) + EPS);
        if (sub == 3) {
            const GAS f32x4* gp = (const GAS f32x4*)a->in[I_FNG] + F.lane; GAS f32x4* op = (GAS f32x4*)(a->out + O_Y + (size_t)m * DM) + F.lane;
#pragma unroll
            for (int j = 0; j < 8; ++j) op[64 * j] = v[j] * rstd * gp[64 * j];
        } else {
            const int var = m < NPR ? 0 : 1 + (m - NPR) / DSEQ;
            const float* mod = (const float*)(ws + WS_MOD) + ((size_t)l * 3 + var) * MODW + sub * 3 * DM;
            const GAS f32x4* gp = (const GAS f32x4*)(a->in[I_NORMG] + ((size_t)l * 3 + sub) * DM) + F.lane;
            const GAS f32x4* shp = (const GAS f32x4*)mod + F.lane; const GAS f32x4* scp = (const GAS f32x4*)(mod + DM) + F.lane;
            GAS unsigned long long* o8 = (GAS unsigned long long*)((bf16*)(ws + WS_H) + (size_t)m * DM) + F.lane;
#pragma unroll
            for (int j = 0; j < 8; ++j) { const f32x4 y = v[j] * rstd * gp[64 * j] * (scp[64 * j] + 1.0f) + shp[64 * j];
                o8[64 * j] = (unsigned long long)pk2(y.x, y.y) | ((unsigned long long)pk2(y.z, y.w) << 32); }
        }
    }
}

__device__ __forceinline__ void phase_qkvpost(const Frame& F, KA a, int l) {
    unsigned char* ws = a->ws;
    const bf16* proj = (const bf16*)(ws + WS_PROJ);
    const float* cosT = (const float*)(ws + WS_COS); const float* sinT = (const float*)(ws + WS_SIN);
    const int i = F.lane, e0 = (i & 31) + 64 * (i >> 5), e1 = e0 + 32;
    const int NT1 = MT * 20, NT2 = NBS * PAST * 2 * 2;
    for (int task = F.gw; task < NT1 + NT2; task += F.NGW) {
        if (task >= NT1) {
            const int r = task - NT1; const int isv = r & 1, kvh = (r >> 1) & 1, t = (r >> 2) % PAST, b = (r >> 2) / PAST;
            const float* src = a->in[isv ? I_CV : I_CK] + ((((size_t)b * NLAYER + l) * PAST + t) * 2 + kvh) * 128;
            bf16* dst = (bf16*)(ws + (isv ? WS_VS : WS_KS)) + ((size_t)b * KALL + t) * 256 + kvh * 128;
            dst[e0] = (bf16)f2bf(src[e0]); dst[e1] = (bf16)f2bf(src[e1]);
            continue;
        }
        const int m = task / 20, ch = task % 20;
        const bool lat = m >= NPR; const int b = lat ? (m - NPR) / DSEQ : m / SEQ, t = lat ? (m - NPR) % DSEQ : m % SEQ;
        int scol; if (ch < 8) scol = C_QA + ch * 128; else if (ch < 10) scol = C_KA + (ch - 8) * 128; else if (ch < 12) scol = C_VA + (ch - 10) * 128; else if (ch < 16) scol = C_QR + (ch - 12) * 128; else scol = C_KR + (ch - 16) * 128;
        const bf16* src = proj + (size_t)m * INW + scol;
        float x0 = bf2f(src[e0]), x1 = bf2f(src[e1]);
        if (ch < 10) {
            const float ss = wave_sum(x0 * x0 + x1 * x1); const float r = 1.0f / sqrtf(ss * (1.0f / 128.0f) + EPS);
            const float* g = a->in[ch < 8 ? I_QNG : I_KNG] + l * 128;
            x0 *= r * g[e0]; x1 *= r * g[e1];
        }
        if (ch >= 16) { x0 *= 0.08838834764831845f; x1 *= 0.08838834764831845f; }
        if (lat && (ch < 10 || ch >= 12)) {
            const float c = cosT[t * 64 + i], s = sinT[t * 64 + i];
            const float y0 = x0 * c - x1 * s, y1 = x1 * c + x0 * s; x0 = y0; x1 = y1;
        }
        if (ch < 8) { bf16* d = (bf16*)(ws + WS_QB) + (size_t)m * 1024 + ch * 128; d[e0] = (bf16)f2bf(x0); d[e1] = (bf16)f2bf(x1); }
        else if (ch < 12) {
            const int isv = ch >= 10, kvh = (ch - 8) & 1;
            if (!lat) {
                float* o = a->out + (isv ? O_CV : O_CK) + ((((size_t)b * NLAYER + l) * SEQ + t) * 2 + kvh) * 128; o[e0] = x0; o[e1] = x1;
                bf16* d = (bf16*)(ws + (isv ? WS_VP : WS_KP)) + (size_t)m * 256 + kvh * 128; d[e0] = (bf16)f2bf(x0); d[e1] = (bf16)f2bf(x1);
            } else {
                bf16* d = (bf16*)(ws + (isv ? WS_VS : WS_KS)) + ((size_t)b * KALL + PAST + t) * 256 + kvh * 128; d[e0] = (bf16)f2bf(x0); d[e1] = (bf16)f2bf(x1);
            }
        }
        else if (ch < 16) { bf16* d = (bf16*)(ws + WS_QR) + (size_t)m * 512 + (ch - 12) * 128; d[e0] = (bf16)f2bf(x0); d[e1] = (bf16)f2bf(x1); }
        else { bf16* d = (bf16*)(ws + WS_KR) + (size_t)m * 512 + (ch - 16) * 128; d[e0] = (bf16)f2bf(x0); d[e1] = (bf16)f2bf(x1); }
    }
}

constexpr int NV_WAVE_LDS = 7168;

__device__ __forceinline__ void nv_attn_row(const bf16* qrow, const bf16* Kb, const bf16* Vb, int nkeys, bf16* out, LAS float* qs, LAS float* ps, int lane) {
    qs[lane] = bf2f(qrow[lane]); qs[lane + 64] = bf2f(qrow[lane + 64]);
    LDS_WAIT(); asm volatile("" ::: "memory");
    float mx = -3.0e38f;
    for (int j = lane; j < nkeys; j += 64) {
        const GAS v4u* kr = (const GAS v4u*)(Kb + (size_t)j * 256); float s = 0.f;
#pragma unroll 4
        for (int c = 0; c < 16; ++c) { const v4u w = kr[c]; const LAS float* q = qs + 8 * c;
            s += q[0] * bflo(w.x) + q[1] * bfhi(w.x) + q[2] * bflo(w.y) + q[3] * bfhi(w.y) + q[4] * bflo(w.z) + q[5] * bfhi(w.z) + q[6] * bflo(w.w) + q[7] * bfhi(w.w); }
        s *= 0.08838834764831845f; ps[j] = s; mx = fmaxf(mx, s);
    }
    mx = wave_max(mx);
    float sum = 0.f;
    for (int j = lane; j < nkeys; j += 64) { const float p = __expf(ps[j] - mx); ps[j] = p; sum += p; }
    sum = wave_sum(sum);
    LDS_WAIT(); asm volatile("" ::: "memory");
    float o0 = 0.f, o1 = 0.f;
#pragma unroll 4
    for (int j = 0; j < nkeys; ++j) { const float p = ps[j]; const bf16* vr = Vb + (size_t)j * 256; o0 += p * bf2f(vr[lane]); o1 += p * bf2f(vr[lane + 64]); }
    const float inv = 1.0f / sum;
    out[lane] = (bf16)f2bf(o0 * inv); out[lane + 64] = (bf16)f2bf(o1 * inv);
    LDS_WAIT(); asm volatile("" ::: "memory");
}

__device__ __forceinline__ void nv_ret_row(KA a, int l, int m0, int L, int t, int h, int bl  , float lgf, float lgb, LAS float* qs, LAS float* ps, int lane) {
    unsigned char* ws = a->ws;
    const bf16* QR = (const bf16*)(ws + WS_QR); const bf16* KR = (const bf16*)(ws + WS_KR); const bf16* proj = (const bf16*)(ws + WS_PROJ);
    const int m = m0 + t;
    const bf16* qrow = QR + (size_t)m * 512 + h * 128;
    qs[lane] = bf2f(qrow[lane]); qs[lane + 64] = bf2f(qrow[lane + 64]);
    LDS_WAIT(); asm volatile("" ::: "memory");
    for (int j = lane; j < L; j += 64) {
        const GAS v4u* kr = (const GAS v4u*)(KR + (size_t)(m0 + j) * 512 + h * 128); float s = 0.f;
#pragma unroll 4
        for (int c = 0; c < 16; ++c) { const v4u w = kr[c]; const LAS float* q = qs + 8 * c;
            s += q[0] * bflo(w.x) + q[1] * bfhi(w.x) + q[2] * bflo(w.y) + q[3] * bfhi(w.y) + q[4] * bflo(w.z) + q[5] * bfhi(w.z) + q[6] * bflo(w.w) + q[7] * bfhi(w.w); }
        const float d = j < t ? exp2f((float)(t - j) * lgf) : (j > t ? exp2f((float)(j - t) * lgb) : 2.0f);
        ps[j] = s * d;
    }
    LDS_WAIT(); asm volatile("" ::: "memory");
    float o0 = 0.f, o1 = 0.f;
#pragma unroll 4
    for (int j = 0; j < L; ++j) { const float p = ps[j]; const bf16* vr = proj + (size_t)(m0 + j) * INW + C_VR + h * 128; o0 += p * bf2f(vr[lane]); o1 += p * bf2f(vr[lane + 64]); }
    if (bl >= 0) {
        const float* S0f = a->in[I_SRET] + ((((size_t)bl * NLAYER + l) * 2 + 0) * 4 + h) * 16384;
        const float* S0b = a->in[I_SRET] + ((((size_t)bl * NLAYER + l) * 2 + 1) * 4 + h) * 16384;
        float f0 = 0.f, f1 = 0.f, b0 = 0.f, b1 = 0.f;
#pragma unroll 4
        for (int d = 0; d < 128; ++d) { const float q = qs[d]; f0 += q * S0f[d * 128 + lane]; f1 += q * S0f[d * 128 + 64 + lane]; b0 += q * S0b[d * 128 + lane]; b1 += q * S0b[d * 128 + 64 + lane]; }
        const float wf = exp2f((float)(t + 1) * lgf), wb = exp2f((float)(L - t) * lgb);
        o0 += wf * f0 + wb * b0; o1 += wf * f1 + wb * b1;
    }
    const float mean = wave_sum(o0 + o1) * (1.0f / 128.0f); o0 -= mean; o1 -= mean;
    const float var = wave_sum(o0 * o0 + o1 * o1) * (1.0f / 128.0f); const float r = 1.0f / sqrtf(var + EPS);
    const bf16* gr = proj + (size_t)m * INW + C_GR + h * 128;
    const float g0 = bf2f(gr[lane]), g1 = bf2f(gr[lane + 64]);
    bf16* out = (bf16*)(ws + WS_MIX) + (size_t)m * DM + 1536 + h * 128;
    out[lane] = (bf16)f2bf(o0 * r * silu_f(g0)); out[lane + 64] = (bf16)f2bf(o1 * r * silu_f(g1));
    LDS_WAIT(); asm volatile("" ::: "memory");
}

__device__ __forceinline__ void nv_ret_state(KA a, int l, int b, int h, int dir, int d, float lg, int lane) {
    unsigned char* ws = a->ws;
    const bf16* KR = (const bf16*)(ws + WS_KR); const bf16* proj = (const bf16*)(ws + WS_PROJ);
    float o0 = 0.f, o1 = 0.f;
#pragma unroll 4
    for (int s = 0; s < SEQ; ++s) { const int m = b * SEQ + s; const float w = exp2f((float)(dir == 0 ? SEQ - 1 - s : s) * lg) * bf2f(KR[(size_t)m * 512 + h * 128 + d]);
        const bf16* vr = proj + (size_t)m * INW + C_VR + h * 128; o0 += w * bf2f(vr[lane]); o1 += w * bf2f(vr[lane + 64]); }
    float* o = a->out + O_RET + (((((size_t)b * NLAYER + l) * 2 + dir) * 4 + h) * 128 + d) * 128;
    o[lane] = o0; o[lane + 64] = o1;
}

__device__ __forceinline__ void nv_s5(KA a, int l, int m0, int L, int g, int bl, int bp, LAS float* hb, int lane) {
    unsigned char* ws = a->ws;
    const bf16* proj = (const bf16*)(ws + WS_PROJ);
    float* YS = (float*)(ws + WS_YS); bf16* YSB = (bf16*)(ws + WS_YSB);
    const int ch = lane & 15, q4 = lane >> 4;
    const float dcoef = a->in[I_SSMD][l * 512 + g * 16 + ch];
    for (int dir = 1; dir >= 0; --dir) {
        const int ldg = (l * 2 + dir) * 32 + g;
        const float* lamT = (const float*)(ws + WS_LAM) + ((size_t)ldg * 64 + lane) * 2;
        const float lr = lamT[0], li = lamT[1];
        const float* bbp = (const float*)(ws + WS_BBAR) + ((size_t)ldg * 64 + lane) * 32;
        float bre[16], bim[16], cre[16], cim[16];
#pragma unroll
        for (int j = 0; j < 16; ++j) { bre[j] = bbp[2 * j]; bim[j] = bbp[2 * j + 1]; }
        const float* crp = a->in[I_CRE] + ((size_t)ldg * 16 + ch) * 64 + q4 * 16; const float* cip = a->in[I_CIM] + ((size_t)ldg * 16 + ch) * 64 + q4 * 16;
#pragma unroll
        for (int j = 0; j < 16; ++j) { cre[j] = crp[j]; cim[j] = cip[j]; }
        float hr = 0.f, hi = 0.f;
        if (bl >= 0) { const float* h0 = a->in[I_SSSM] + (((((size_t)bl * NLAYER + l) * 2 + dir) * 32 + g) * 64 + lane) * 2; hr = h0[0]; hi = h0[1]; }
        for (int step = 0; step < L; ++step) {
            const int t = dir == 0 ? step : L - 1 - step; const int m = m0 + t;
            const GAS v4u* up = (const GAS v4u*)(proj + (size_t)m * INW + C_US + g * 16);
            const v4u u0 = up[0], u1 = up[1];
            float u[16] = {bflo(u0.x), bfhi(u0.x), bflo(u0.y), bfhi(u0.y), bflo(u0.z), bfhi(u0.z), bflo(u0.w), bfhi(u0.w),
                           bflo(u1.x), bfhi(u1.x), bflo(u1.y), bfhi(u1.y), bflo(u1.z), bfhi(u1.z), bflo(u1.w), bfhi(u1.w)};
            float br_ = 0.f, bi_ = 0.f;
#pragma unroll
            for (int j = 0; j < 16; ++j) { br_ += bre[j] * u[j]; bi_ += bim[j] * u[j]; }
            const float nr = lr * hr - li * hi + br_, ni = lr * hi + li * hr + bi_; hr = nr; hi = ni;
            hb[2 * lane] = hr; hb[2 * lane + 1] = hi;
            LDS_WAIT(); asm volatile("" ::: "memory");
            float y = 0.f;
#pragma unroll
            for (int j = 0; j < 16; ++j) { y += cre[j] * hb[2 * (q4 * 16 + j)] - cim[j] * hb[2 * (q4 * 16 + j) + 1]; }
            y += __shfl_xor(y, 16); y += __shfl_xor(y, 32);
            LDS_WAIT(); asm volatile("" ::: "memory");
            if (q4 == 0) {
                if (dir == 1) YS[(size_t)m * 512 + g * 16 + ch] = y;
                else { float uch = 0.f;
#pragma unroll
                    for (int j = 0; j < 16; ++j) uch = (ch == j) ? u[j] : uch;
                    const float yt = y + YS[(size_t)m * 512 + g * 16 + ch] + dcoef * uch;
                    YSB[(size_t)m * 512 + g * 16 + ch] = (bf16)f2bf(gelu_tanh(yt)); }
            }
        }
        if (bp >= 0) { float* o = a->out + O_SSM + (((((size_t)bp * NLAYER + l) * 2 + dir) * 32 + g) * 64 + lane) * 2; o[0] = hr; o[1] = hi; }
    }
}

__device__ __forceinline__ void decay_log2(KA a, int l, int h, float& lgf, float& lgb) {
    const float xf = a->in[I_DECAY][(l * 2 + 0) * 4 + h], xb = a->in[I_DECAY][(l * 2 + 1) * 4 + h];
    lgf = -log1pf(expf(-xf)) * 1.4426950408889634f; lgb = -log1pf(expf(-xb)) * 1.4426950408889634f;
}

__device__ __forceinline__ void phase_mixer_naive(const Frame& F, KA a, int l) {
    unsigned char* ws = a->ws;
    LAS float* qs = (LAS float*)(F.lds + F.wave * NV_WAVE_LDS); LAS float* ps = qs + 128; LAS float* hb = ps + 1536;
    const bf16* QB = (const bf16*)(ws + WS_QB); bf16* MIX = (bf16*)(ws + WS_MIX);
    constexpr int T_S5S = NBS * 32, T_S5P = NBP * 32, T_AS = NBS * 8 * DSEQ, T_RS = NBS * 4 * DSEQ, T_AP = NBP * 8 * SEQ, T_RP = NBP * 4 * SEQ, T_ST = NBP * 4 * 2 * 128;
    constexpr int TOT = T_S5S + T_S5P + T_AS + T_RS + T_AP + T_RP + T_ST;
    for (int task = F.gw; task < TOT; task += F.NGW) {
        int r = task;
        if (r < T_S5S) { const int b = r / 32, g = r % 32; nv_s5(a, l, NPR + b * DSEQ, DSEQ, g, b, -1, hb, F.lane); continue; } r -= T_S5S;
        if (r < T_S5P) { const int b = r / 32, g = r % 32; nv_s5(a, l, b * SEQ, SEQ, g, -1, b, hb, F.lane); continue; } r -= T_S5P;
        if (r < T_AS) { const int t = r % DSEQ, h = (r / DSEQ) % 8, b = r / (DSEQ * 8); const int m = NPR + b * DSEQ + t;
            nv_attn_row(QB + (size_t)m * 1024 + h * 128, (const bf16*)(ws + WS_KS) + (size_t)b * KALL * 256 + (h >> 2) * 128, (const bf16*)(ws + WS_VS) + (size_t)b * KALL * 256 + (h >> 2) * 128, KALL,
                        MIX + (size_t)m * DM + h * 128, qs, ps, F.lane); continue; } r -= T_AS;
        if (r < T_RS) { const int t = r % DSEQ, h = (r / DSEQ) % 4, b = r / (DSEQ * 4); float lgf, lgb; decay_log2(a, l, h, lgf, lgb);
            nv_ret_row(a, l, NPR + b * DSEQ, DSEQ, t, h, b, lgf, lgb, qs, ps, F.lane); continue; } r -= T_RS;
        if (r < T_AP) { const int t = r % SEQ, h = (r / SEQ) % 8, b = r / (SEQ * 8); const int m = b * SEQ + t;
            nv_attn_row(QB + (size_t)m * 1024 + h * 128, (const bf16*)(ws + WS_KP) + (size_t)b * SEQ * 256 + (h >> 2) * 128, (const bf16*)(ws + WS_VP) + (size_t)b * SEQ * 256 + (h >> 2) * 128, SEQ,
                        MIX + (size_t)m * DM + h * 128, qs, ps, F.lane); continue; } r -= T_AP;
        if (r < T_RP) { const int t = r % SEQ, h = (r / SEQ) % 4, b = r / (SEQ * 4); float lgf, lgb; decay_log2(a, l, h, lgf, lgb);
            nv_ret_row(a, l, b * SEQ, SEQ, t, h, -1, lgf, lgb, qs, ps, F.lane); continue; } r -= T_RP;
        { const int d = r % 128, dir = (r / 128) % 2, h = (r / 256) % 4, b = r / 1024; float lgf, lgb; decay_log2(a, l, h, lgf, lgb);
          nv_ret_state(a, l, b, h, dir, d, dir == 0 ? lgf : lgb, F.lane); }
    }
}

constexpr int N_PHASES = 26;

template <class Epi> __device__ __forceinline__ void run_gemm(const Frame& F, const bf16* A, const bf16* Bt, int N, int K, const Epi& E) {
    pg8::Gemm g{A, Bt, MT, N, K}; pg8::StaticOrder S; S.init(MT, N, F.G, (int)blockIdx.x);
    pg8::gemm_phase<Epi, pg8::StaticOrder, true, true>(F.lds, g, S, E);
}

__global__ void __launch_bounds__(NWAVES * 64, 2) trunk_fwd(KArgs args) {
    extern __shared__ __attribute__((aligned(16))) unsigned char lds[];
    volatile LAS unsigned* MISC = (volatile LAS unsigned*)((LAS unsigned char*)lds + MISC_OFF);
    for (int u = threadIdx.x; u < (LDS_BYTES - LDSCTL_OFF) / 4; u += NWAVES * 64) ((LAS unsigned*)((LAS unsigned char*)lds + LDSCTL_OFF))[u] = 0u;
    __syncthreads();
    unsigned* ctl = (unsigned*)(args.ws + WS_CTL);
    XcdBarrier bar; bar.bar = ctl + CW_BAR; bar.x = 0; bar.st = nullptr;
    const bool multi = (args.ph_hi - args.ph_lo) > 1;
    if (multi) bar = xcd_barrier_post(ctl + CW_BAR, MISC + 8);

    for (int ph = args.ph_lo; ph < args.ph_hi; ++ph) {
        Frame F;
        { int t_ = threadIdx.x; asm volatile("" : "+v"(t_)); F.tid = t_; }
        F.lds = (LAS unsigned char*)lds; F.lane = F.tid & 63; F.wave = __builtin_amdgcn_readfirstlane(F.tid >> 6);
        F.G = gridDim.x; F.gw = blockIdx.x * NWAVES + F.wave; F.NGW = F.G * NWAVES;
        KA ap; { unsigned long long p_ = (unsigned long long)__builtin_amdgcn_kernarg_segment_ptr(); asm volatile("" : "+s"(p_)); ap = (KA)p_; }
        unsigned char* ws = ap->ws;
#ifndef PH_MASK
#define PH_MASK 0xFFFF
#endif
        if (ph == 0) { if (PH_MASK & 1) phase_prologue(F, ap); }
        else if (ph == N_PHASES - 1) phase_prenorm(F, ap, 0, 3);
        else {
            const int l = (ph - 1) / 12, s = (ph - 1) % 12;
            const float* modl = (const float*)(ws + WS_MOD) + (size_t)l * 3 * MODW;
            switch (s) {
                case 0: if (PH_MASK & 2) phase_prenorm(F, ap, l, 0); break;
                case 3: if (PH_MASK & 2) phase_prenorm(F, ap, l, 1); break;
                case 9: if (PH_MASK & 2) phase_prenorm(F, ap, l, 2); break;
                case 1: case 10: {
                    const int i = s == 1 ? 0 : 1;
                    pg8::EpiPair<0> E{(bf16*)(ws + WS_ACT), DFF, 0};
                    if (PH_MASK & 4) run_gemm(F, (const bf16*)(ws + WS_H), (const bf16*)(ws + WS_WFI) + (size_t)(l * 2 + i) * 2 * DFF * DM, 2 * DFF, DM, E); break; }
                case 2: case 11: {
                    const int i = s == 2 ? 0 : 1, sub = s == 2 ? 0 : 2;
                    pg8::EpiResid E{(float*)(ws + WS_XR), modl + sub * 3 * DM + 2 * DM, MODW, 0.5f};
                    if (PH_MASK & 8) run_gemm(F, (const bf16*)(ws + WS_ACT), (const bf16*)(ws + WS_WFO) + (size_t)(l * 2 + i) * DM * DFF, DM, DFF, E); break; }
                case 4: {
                    pg8::EpiBf16 E{(bf16*)(ws + WS_PROJ), INW};
                    if (PH_MASK & 16) run_gemm(F, (const bf16*)(ws + WS_H), (const bf16*)(ws + WS_WIN) + (size_t)l * INW * DM, INW, DM, E); break; }
                case 5: if (PH_MASK & 32) phase_qkvpost(F, ap, l); break;
                case 6: if (PH_MASK & 64) phase_mixer_naive(F, ap, l); break;
                case 7: {
                    pg8::EpiPair<1> E{(bf16*)(ws + WS_MIX), DM, 1024};
                    if (PH_MASK & 128) run_gemm(F, (const bf16*)(ws + WS_YSB), (const bf16*)(ws + WS_WGLU) + (size_t)l * 1024 * 512, 1024, 512, E); break; }
                case 8: {
                    pg8::EpiResid E{(float*)(ws + WS_XR), modl + 1 * 3 * DM + 2 * DM, MODW, 1.0f};
                    if (PH_MASK & 256) run_gemm(F, (const bf16*)(ws + WS_MIX), (const bf16*)(ws + WS_WOUT) + (size_t)l * DM * DM, DM, DM, E); break; }
                default: break;
            }
        }
        if (ph + 1 < args.ph_hi) xcd_barrier(bar);
    }
}

extern "C" void kernel_launch(void* const* d_in, const int* in_sizes, int n_in, void* d_out, int out_size, void* d_ws, size_t ws_size, hipStream_t stream) {
    static int grid = 0;
    if (grid == 0) {
        if (n_in != 28 || out_size != (int)O_END || ws_size < WS_END) { fprintf(stderr, "kernel_launch: unexpected shapes: n_in %d out %d ws %zu (need >= %zu)\n", n_in, out_size, ws_size, (size_t)WS_END); grid = -1; return; }
        int dev = 0, cus = 0, per_cu = 0;
        if (hipGetDevice(&dev) != hipSuccess || hipDeviceGetAttribute(&cus, hipDeviceAttributeMultiprocessorCount, dev) != hipSuccess) { fprintf(stderr, "kernel_launch: device query failed\n"); grid = -1; return; }
        if (hipFuncSetAttribute((const void*)trunk_fwd, hipFuncAttributeMaxDynamicSharedMemorySize, LDS_BYTES) != hipSuccess) { fprintf(stderr, "kernel_launch: hipFuncSetAttribute failed\n"); grid = -1; return; }
        if (hipOccupancyMaxActiveBlocksPerMultiprocessor(&per_cu, (const void*)trunk_fwd, NWAVES * 64, LDS_BYTES) != hipSuccess || per_cu < 1) { fprintf(stderr, "kernel_launch: occupancy query says %d blocks per CU\n", per_cu); (void)hipGetLastError(); grid = -1; return; }
        grid = cus;
        if (grid > 256) grid = 256;
    }
    if (grid < 0) return;
    (void)hipMemsetAsync((char*)d_ws + WS_CTL, 0, CTL_ZERO_BYTES, stream);
    KArgs a{};
    for (int i = 0; i < 28; ++i) a.in[i] = (const float*)d_in[i];
    a.out = (float*)d_out; a.ws = (unsigned char*)d_ws;
#if MK_ONE_LAUNCH
    a.ph_lo = 0; a.ph_hi = N_PHASES; a.li = 0;
    hipLaunchKernelGGL(trunk_fwd, dim3(grid), dim3(NWAVES * 64), LDS_BYTES, stream, a);
#else
    for (int ph = 0; ph < N_PHASES; ++ph) { a.ph_lo = ph; a.ph_hi = ph + 1; a.li = ph;
        hipLaunchKernelGGL(trunk_fwd, dim3(grid), dim3(NWAVES * 64), LDS_BYTES, stream, a); }
#endif
    const hipError_t le = hipPeekAtLastError();
    if (le != hipSuccess) fprintf(stderr, "kernel_launch: launch failed: %s\n", hipGetErrorName(le));
}
```

```cpp
#define MK_ONE_LAUNCH 1
#include <hip/hip_runtime.h>
#include <cstdio>
#include <cstdint>
#include <cmath>

constexpr int DM = 2048, NPR = 4096, NSR = 2048, MT = 6144, DFF = 5632, INW = 4096;
constexpr int SEQ = 256, DSEQ = 1024, PAST = 512, NBP = 16, NBS = 2, NLAYER = 2;
constexpr int KALL = PAST + DSEQ;
constexpr int MODW = 9 * DM;
constexpr float EPS = 1e-6f;
constexpr int C_QA = 0, C_KA = 1024, C_VA = 1280, C_US = 1536, C_QR = 2048, C_KR = 2560, C_VR = 3072, C_GR = 3584;
constexpr size_t O_Y = 0, O_CK = 12582912, O_CV = 14680064, O_SSM = 16777216, O_RET = 17039360, O_END = 21233664;

namespace pg8 {
#define PG8_LAS __attribute__((address_space(3)))
typedef unsigned short bf16_t;
typedef short bf16x8 __attribute__((ext_vector_type(8)));
typedef float f32x4 __attribute__((ext_vector_type(4)));
typedef unsigned u32x4 __attribute__((ext_vector_type(4)));
constexpr int BM = 256, BK = 64, HALF = 128, HTB = HALF * BK * 2, STAGE_BYTES = 8 * HTB, NXCD = 8, WGM = 8;

__host__ __device__ __forceinline__ int lds_byte(int r, int c) { const int st = (r >> 4) * 2 + (c >> 5), rr = r & 15, cc = c & 31, ob = rr * 64 + cc * 2; return st * 1024 + (ob ^ (((ob >> 9) & 1) << 5)); }
__host__ __device__ __forceinline__ void stage_rc(int b, int& R, int& C) { const int st = b / 1024, sb = b % 1024, swz = sb ^ (((sb >> 9) & 1) << 5); R = (st >> 1) * 16 + swz / 64; C = (st & 1) * 32 + (swz % 64) / 2; }
__host__ __device__ __forceinline__ int perm32(int rho) { const int n = rho >> 4, i = rho & 15; return 8 * (i >> 2) + 4 * n + (i & 3); }

struct Unit { int pm, pn; };
struct Gemm { const bf16_t* A; const bf16_t* Bt; int M, N, K; };

struct StaticOrder {
    int nM, nN, nwg, G, c;
    __host__ __device__ void init(int M, int N, int G_, int c_) { nM = M / BM; nN = N / BM; nwg = nM * nN; G = G_; c = c_; }
    __host__ __device__ bool next(int i, Unit& u) const {
        const long L = (long)i * G + c; if (L >= nwg) return false;
        int wgid = (int)L; { const int q = nwg / NXCD, r = nwg % NXCD, xcd = wgid % NXCD, off = wgid / NXCD; wgid = (xcd < r ? xcd * (q + 1) : r * (q + 1) + (xcd - r) * q) + off; }
        const int nig = WGM * nN, gid = wgid / nig, fm = gid * WGM, gsz = (nM - fm) < WGM ? (nM - fm) : WGM;
        u.pm = fm + ((wgid % nig) % gsz); u.pn = (wgid % nig) / gsz; return true;
    }
    __device__ __forceinline__ void a_ready(const Unit&) const {}
    __device__ __forceinline__ void done(const Unit&) const {}
};

__device__ __forceinline__ unsigned cvt_pk_bf16(float lo, float hi) { unsigned r; asm volatile("v_cvt_pk_bf16_f32 %0, %1, %2" : "=v"(r) : "v"(lo), "v"(hi)); return r; }
__device__ __forceinline__ float fast_sigmoid(float x) { return __builtin_amdgcn_rcpf(1.0f + __builtin_amdgcn_exp2f(-1.4426950408889634f * x)); }

struct EpiBf16 {
    static constexpr bool PERM = true, AFTER_DRAIN = false;
    bf16_t* O; int ldc;
    __device__ __forceinline__ void operator()(const f32x4 (&acc)[2][2][4][2], const Unit& u, int wr, int wc, int fr, int fq) const {
        const int row0 = u.pm * BM + wr * 64 + fr; const int col0 = u.pn * BM + wc * 32 + 8 * fq;
#pragma unroll
        for (int ai = 0; ai < 2; ++ai)
#pragma unroll
            for (int m = 0; m < 4; ++m) { bf16_t* rowp = O + (size_t)(row0 + ai * HALF + m * 16) * ldc + col0;
#pragma unroll
                for (int bj = 0; bj < 2; ++bj) { const f32x4 v0 = acc[ai][bj][m][0], v1 = acc[ai][bj][m][1];
                    u32x4 w; w.x = cvt_pk_bf16(v0[0], v0[1]); w.y = cvt_pk_bf16(v0[2], v0[3]); w.z = cvt_pk_bf16(v1[0], v1[1]); w.w = cvt_pk_bf16(v1[2], v1[3]);
                    *(u32x4*)(rowp + bj * HALF) = w; } }
    }
};
template <int ACT> struct EpiPair {
    static constexpr bool PERM = true, AFTER_DRAIN = false;
    bf16_t* O; int ldc; int coff;
    __device__ __forceinline__ void operator()(const f32x4 (&acc)[2][2][4][2], const Unit& u, int wr, int wc, int fr, int fq) const {
        const int row0 = u.pm * BM + wr * 64 + fr; const int col0 = coff + u.pn * HALF + wc * 32 + 8 * fq;
#pragma unroll
        for (int ai = 0; ai < 2; ++ai)
#pragma unroll
            for (int m = 0; m < 4; ++m) { bf16_t* rowp = O + (size_t)(row0 + ai * HALF + m * 16) * ldc + col0;
                float r[8];
#pragma unroll
                for (int n = 0; n < 2; ++n)
#pragma unroll
                    for (int j = 0; j < 4; ++j) { const float a = acc[ai][0][m][n][j], g = acc[ai][1][m][n][j];
                        r[n * 4 + j] = (ACT == 0) ? a * fast_sigmoid(a) * g : a * fast_sigmoid(g); }
                u32x4 w; w.x = cvt_pk_bf16(r[0], r[1]); w.y = cvt_pk_bf16(r[2], r[3]); w.z = cvt_pk_bf16(r[4], r[5]); w.w = cvt_pk_bf16(r[6], r[7]);
                *(u32x4*)rowp = w; }
    }
};
struct EpiResid {
    static constexpr bool PERM = false, AFTER_DRAIN = false;
    float* X; const float* gate0; int gstride; float s;
    __device__ __forceinline__ void operator()(const f32x4 (&acc)[2][2][4][2], const Unit& u, int wr, int wc, int fr, int fq) const {
        const int row0 = u.pm * BM + wr * 64 + fr, col0 = u.pn * BM + wc * 32 + 4 * fq;
        const int var = u.pm < 16 ? 0 : (u.pm < 20 ? 1 : 2);
        const float* gp = gate0 + (size_t)var * gstride + col0;
        f32x4 gv[2][2];
#pragma unroll
        for (int bj = 0; bj < 2; ++bj)
#pragma unroll
            for (int n = 0; n < 2; ++n) gv[bj][n] = *(const f32x4*)(gp + bj * HALF + n * 16) * s;
#pragma unroll
        for (int ai = 0; ai < 2; ++ai)
#pragma unroll
            for (int m = 0; m < 4; ++m) { float* rowp = X + (size_t)(row0 + ai * HALF + m * 16) * DM + col0;
#pragma unroll
                for (int bj = 0; bj < 2; ++bj)
#pragma unroll
                    for (int n = 0; n < 2; ++n) { float* p = rowp + bj * HALF + n * 16; const f32x4 x = *(const f32x4*)p; *(f32x4*)p = x + gv[bj][n] * acc[ai][bj][m][n]; } }
    }
};

template <class Epi, class Sched, bool ALIGN_EPI = false, bool SP2 = false>
__device__ __forceinline__ void gemm_phase(PG8_LAS unsigned char* lds, const Gemm g, const Sched& S, const Epi& E) {
    int tid_ = threadIdx.x; asm volatile("" : "+v"(tid_));
    const int tid = tid_, wid = __builtin_amdgcn_readfirstlane(tid >> 6), lane = tid & 63, wr = wid >> 2, wc = wid & 3, fr = lane & 15, fq = lane >> 4;
    const int K = g.K, nt = K / BK;
    unsigned voffA[2], voffB[2];
#pragma unroll
    for (int i = 0; i < 2; ++i) { int R, C; stage_rc(tid * 16 + i * 8192, R, C); const int Rb = Epi::PERM ? ((R & ~31) + perm32(R & 31)) : R;
        voffA[i] = (unsigned)(R * K + C) * 2u; voffB[i] = (unsigned)(Rb * K + C) * 2u; }
    const size_t kstep = (size_t)(BK * 2);
    const size_t hstep = (size_t)HALF * K * 2;
    const size_t tstep = 2 * hstep;
    const unsigned ldsw = (unsigned)wid * 1024u;
    const int aoff = lds_byte(wr * 64 + fr, fq * 8), boff = lds_byte(wc * 32 + fr, fq * 8);
#define PG8_SA(b, h) (((b) * 2 + (h)) * HTB)
#define PG8_SB(b, h) ((4 + (b) * 2 + (h)) * HTB)
#define PG8_STAGE(bufoff, gbase, voff) do { _Pragma("unroll") for (int _i = 0; _i < 2; ++_i) \
        __builtin_amdgcn_global_load_lds((const unsigned*)((const char*)(gbase) + (voff)[_i]), (PG8_LAS unsigned*)(lds + (bufoff) + ldsw + _i * 8192), 16, 0, 0); } while (0)
#define PG8_LDA(dst, b, h) do { _Pragma("unroll") for (int m = 0; m < 4; ++m) _Pragma("unroll") for (int k = 0; k < 2; ++k) dst[m][k] = *(const PG8_LAS bf16x8*)(lds + PG8_SA(b, h) + aoff + m * 2048 + k * 1024); } while (0)
#define PG8_LDB(dst, b, h) do { _Pragma("unroll") for (int n = 0; n < 2; ++n) _Pragma("unroll") for (int k = 0; k < 2; ++k) dst[n][k] = *(const PG8_LAS bf16x8*)(lds + PG8_SB(b, h) + boff + n * 2048 + k * 1024); } while (0)
#define PG8_MMA(ai, bj, At, Bt) do { __builtin_amdgcn_s_setprio(1); _Pragma("unroll") for (int m = 0; m < 4; ++m) _Pragma("unroll") for (int n = 0; n < 2; ++n) _Pragma("unroll") for (int k = 0; k < 2; ++k) \
        acc[ai][bj][m][n] = __builtin_amdgcn_mfma_f32_16x16x32_bf16(Bt[n][k], At[m][k], acc[ai][bj][m][n], 0, 0, 0); __builtin_amdgcn_s_setprio(0); } while (0)
#define PG8_WAIT_V(n) asm volatile("s_waitcnt vmcnt(" #n ")" ::: "memory")
#define PG8_WAIT_L(n) asm volatile("s_waitcnt lgkmcnt(" #n ")" ::: "memory")
#define PG8_BAR __builtin_amdgcn_s_barrier()
#define PG8_SCHED __builtin_amdgcn_sched_barrier(0)
    Unit cur, nxt; int ui = 0;
    if (!S.next(0, cur)) return;
    f32x4 acc[2][2][4][2];
#pragma unroll
    for (int a = 0; a < 2; ++a)
#pragma unroll
        for (int b = 0; b < 2; ++b)
#pragma unroll
            for (int m = 0; m < 4; ++m)
#pragma unroll
                for (int n = 0; n < 2; ++n) acc[a][b][m][n] = (f32x4){0.f, 0.f, 0.f, 0.f};
    bf16x8 At[4][2], B0[2][2], B1[2][2];
    const char* cA = (const char*)g.A + (size_t)cur.pm * tstep; const char* cB = (const char*)g.Bt + (size_t)cur.pn * tstep;
    S.a_ready(cur);
    if constexpr (SP2) {
        PG8_STAGE(PG8_SB(0, 0), cB, voffB); PG8_STAGE(PG8_SB(0, 1), cB + hstep, voffB); PG8_STAGE(PG8_SA(0, 0), cA, voffA); PG8_STAGE(PG8_SA(0, 1), cA + hstep, voffA);
        if (wr == 1) PG8_BAR;
        PG8_WAIT_V(2); PG8_BAR;
        PG8_STAGE(PG8_SB(1, 0), cB + kstep, voffB); PG8_STAGE(PG8_SA(1, 0), cA + kstep, voffA); PG8_STAGE(PG8_SB(1, 1), cB + hstep + kstep, voffB);
        PG8_WAIT_V(6); PG8_BAR;
    } else {
        PG8_STAGE(PG8_SB(0, 0), cB, voffB); PG8_STAGE(PG8_SA(0, 0), cA, voffA); PG8_STAGE(PG8_SB(0, 1), cB + hstep, voffB); PG8_STAGE(PG8_SA(0, 1), cA + hstep, voffA);
        if (wr == 1) PG8_BAR;
        PG8_WAIT_V(4); PG8_BAR;
        PG8_STAGE(PG8_SB(1, 0), cB + kstep, voffB); PG8_STAGE(PG8_SA(1, 0), cA + kstep, voffA); PG8_STAGE(PG8_SB(1, 1), cB + hstep + kstep, voffB);
        PG8_WAIT_V(6); PG8_BAR;
    }
    for (;;) {
        const bool has_next = S.next(ui + 1, nxt);
        const char* nA = has_next ? (const char*)g.A + (size_t)nxt.pm * tstep : cA; const char* nB = has_next ? (const char*)g.Bt + (size_t)nxt.pn * tstep : cB;
        for (int t = 0; t < nt; t += 2) {
            const bool last = (t == nt - 2);
            const char* a1 = cA + (size_t)(t + 1) * kstep;
            const char* a2 = last ? nA : cA + (size_t)(t + 2) * kstep; const char* b2 = last ? nB : cB + (size_t)(t + 2) * kstep;
            const char* a3 = a2 + kstep; const char* b3 = b2 + kstep;
            if (last && has_next) S.a_ready(nxt);
            if constexpr (SP2) {
            PG8_LDB(B0, 0, 0); PG8_LDB(B1, 0, 1); PG8_SCHED; PG8_LDA(At, 0, 0); PG8_STAGE(PG8_SA(1, 1), a1 + hstep, voffA);
            PG8_WAIT_V(8); PG8_WAIT_L(0); PG8_BAR; PG8_MMA(0, 0, At, B0); PG8_MMA(0, 1, At, B1); PG8_BAR; PG8_SCHED;
            PG8_LDA(At, 0, 1); PG8_STAGE(PG8_SB(0, 0), b2, voffB); PG8_STAGE(PG8_SB(0, 1), b2 + hstep, voffB); PG8_STAGE(PG8_SA(0, 0), a2, voffA);
            PG8_WAIT_V(8); PG8_WAIT_L(0); PG8_BAR; PG8_MMA(1, 0, At, B0); PG8_MMA(1, 1, At, B1); PG8_BAR; PG8_SCHED;
            PG8_LDB(B0, 1, 0); PG8_LDB(B1, 1, 1); PG8_SCHED; PG8_LDA(At, 1, 0); PG8_STAGE(PG8_SA(0, 1), a2 + hstep, voffA);
            PG8_WAIT_V(8); PG8_WAIT_L(0); PG8_BAR; PG8_MMA(0, 0, At, B0); PG8_MMA(0, 1, At, B1); PG8_BAR; PG8_SCHED;
            PG8_LDA(At, 1, 1); PG8_STAGE(PG8_SB(1, 0), b3, voffB); PG8_STAGE(PG8_SB(1, 1), b3 + hstep, voffB); PG8_STAGE(PG8_SA(1, 0), a3, voffA);
            PG8_WAIT_V(8); PG8_WAIT_L(0); PG8_BAR; PG8_MMA(1, 0, At, B0); PG8_MMA(1, 1, At, B1); PG8_BAR; PG8_SCHED;
            } else {
            PG8_LDB(B0, 0, 0); PG8_SCHED; PG8_LDA(At, 0, 0); PG8_STAGE(PG8_SA(1, 1), a1 + hstep, voffA);
            PG8_WAIT_L(8); PG8_BAR; PG8_WAIT_L(0); PG8_MMA(0, 0, At, B0); PG8_BAR; PG8_SCHED;
            PG8_LDB(B1, 0, 1); PG8_STAGE(PG8_SB(0, 0), b2, voffB);
            PG8_BAR; PG8_WAIT_L(0); PG8_MMA(0, 1, At, B1); PG8_BAR;
            PG8_LDA(At, 0, 1); PG8_STAGE(PG8_SA(0, 0), a2, voffA);
            PG8_BAR; PG8_WAIT_L(0); PG8_MMA(1, 0, At, B0); PG8_BAR; PG8_SCHED;
            PG8_STAGE(PG8_SB(0, 1), b2 + hstep, voffB);
            PG8_WAIT_V(6); PG8_BAR; PG8_MMA(1, 1, At, B1); PG8_BAR;
            PG8_LDB(B0, 1, 0); PG8_SCHED; PG8_LDA(At, 1, 0); PG8_STAGE(PG8_SA(0, 1), a2 + hstep, voffA);
            PG8_WAIT_L(8); PG8_BAR; PG8_WAIT_L(0); PG8_MMA(0, 0, At, B0); PG8_BAR; PG8_SCHED;
            PG8_LDB(B1, 1, 1); PG8_STAGE(PG8_SB(1, 0), b3, voffB);
            PG8_BAR; PG8_WAIT_L(0); PG8_MMA(0, 1, At, B1); PG8_BAR;
            PG8_LDA(At, 1, 1); PG8_STAGE(PG8_SA(1, 0), a3, voffA);
            PG8_BAR; PG8_WAIT_L(0); PG8_MMA(1, 0, At, B0); PG8_BAR; PG8_SCHED;
            PG8_STAGE(PG8_SB(1, 1), b3 + hstep, voffB);
            PG8_WAIT_V(6); PG8_BAR; PG8_MMA(1, 1, At, B1); PG8_BAR;
            }
        }
        if constexpr (ALIGN_EPI) { if (wr == 0) PG8_BAR; }
        if constexpr (!Epi::AFTER_DRAIN) { E(acc, cur, wr, wc, fr, fq); S.done(cur); }
        if (!has_next) break;
#pragma unroll
        for (int a = 0; a < 2; ++a)
#pragma unroll
            for (int b = 0; b < 2; ++b)
#pragma unroll
                for (int m = 0; m < 4; ++m)
#pragma unroll
                    for (int n = 0; n < 2; ++n) acc[a][b][m][n] = (f32x4){0.f, 0.f, 0.f, 0.f};
        cur = nxt; cA = nA; cB = nB; ++ui;
        if constexpr (ALIGN_EPI) { if (wr == 1) PG8_BAR; }
    }
    PG8_WAIT_V(0);
    if constexpr (!ALIGN_EPI) { if (wr == 0) PG8_BAR; }
    PG8_BAR;
    if constexpr (Epi::AFTER_DRAIN) { E.fused(acc, cur, wr, wc, fr, fq, lds, wid, lane); S.done(cur); }
#undef PG8_SA
#undef PG8_SB
#undef PG8_STAGE
#undef PG8_LDA
#undef PG8_LDB
#undef PG8_MMA
#undef PG8_WAIT_V
#undef PG8_WAIT_L
#undef PG8_BAR
#undef PG8_SCHED
}
}

typedef unsigned short bf16;
typedef unsigned v4u __attribute__((ext_vector_type(4)));
typedef float f32x4 __attribute__((ext_vector_type(4)));
#define GAS __attribute__((address_space(1)))
#define LAS __attribute__((address_space(3)))
typedef GAS unsigned gu32;
#define RLX_AGENT __ATOMIC_RELAXED, __HIP_MEMORY_SCOPE_AGENT
#define LDS_WAIT() asm volatile("s_waitcnt lgkmcnt(0)" ::: "memory")
#define VM_WAIT() asm volatile("s_waitcnt vmcnt(0)" ::: "memory")

constexpr int NWAVES = 8;
#ifndef MIXER_NAIVE
#define MIXER_NAIVE 0
#endif
#ifndef MK_ONE_LAUNCH
#define MK_ONE_LAUNCH 0
#endif
constexpr size_t MiB = 1u << 20;
constexpr size_t WS_CTL = 0, CTL_ZERO_BYTES = 2 * MiB;
constexpr size_t WS_MOD = 1 * MiB;
constexpr size_t WS_COS = 2 * MiB, WS_SIN = 2 * MiB + 256 * 1024, WS_LAM = 2 * MiB + 512 * 1024, WS_BBAR = 3 * MiB;
constexpr size_t WS_WFI = 8 * MiB, WS_WFO = 184 * MiB, WS_WIN = 272 * MiB, WS_WOUT = 304 * MiB, WS_WGLU = 320 * MiB;
constexpr size_t WS_XR = 322 * MiB, WS_H = 370 * MiB, WS_ACT = 394 * MiB, WS_PROJ = 460 * MiB, WS_QB = 508 * MiB;
constexpr size_t WS_KP = 520 * MiB, WS_VP = 522 * MiB, WS_KS = 524 * MiB, WS_VS = 526 * MiB, WS_QR = 528 * MiB, WS_KR = 534 * MiB;
constexpr size_t WS_MIX = 540 * MiB, WS_YS = 564 * MiB, WS_YSB = 576 * MiB, WS_END = 582 * MiB;
constexpr int CW_BAR = 4096;
constexpr int RING_BYTES = 131072, LDSCTL_OFF = RING_BYTES, MISC_OFF = LDSCTL_OFF + 320, LDS_BYTES = 147456;

__device__ __forceinline__ unsigned f2bf(float f) { unsigned u = __builtin_bit_cast(unsigned, f); return (u + 0x7fffu + ((u >> 16) & 1u)) >> 16; }
__device__ __forceinline__ unsigned pk2(float lo, float hi) { return f2bf(lo) | (f2bf(hi) << 16); }
__device__ __forceinline__ float bf2f(unsigned short h) { return __builtin_bit_cast(float, (unsigned)h << 16); }
__device__ __forceinline__ float bflo(unsigned w) { return __builtin_bit_cast(float, w << 16); }
__device__ __forceinline__ float bfhi(unsigned w) { return __builtin_bit_cast(float, w & 0xffff0000u); }

#define XB_TMO      128
#define XB_XCNT(j)  (256  + 64 * (j))
#define XB_XSUB(j)  (1280 + 64 * (j))
#define XB_XGEN(j)  (2304 + 64 * (j))
#define XB_TOP      3328
#define XB_TOPGEN   3392
#define XCD_BAR_WORDS 3456
#define XB_SPIN_CAP (1u << 18)
__device__ __forceinline__ unsigned xb_ld(unsigned* p)              { return __hip_atomic_load(p, __ATOMIC_RELAXED, __HIP_MEMORY_SCOPE_AGENT); }
__device__ __forceinline__ unsigned xb_add(unsigned* p, unsigned v) { return __hip_atomic_fetch_add(p, v, __ATOMIC_RELAXED, __HIP_MEMORY_SCOPE_AGENT); }
__device__ __forceinline__ unsigned xb_xcc_id() { return (unsigned)__builtin_amdgcn_s_getreg((3 << 11) | 20) & 0xFu; }
#define XB_SPIN(cond, bar) do { unsigned _sp = 0; while (cond) { __builtin_amdgcn_s_sleep(1); \
    if ((++_sp & 255u) == 0u) { if (xb_ld(&(bar)[XB_TMO])) break; if (_sp > XB_SPIN_CAP) { atomicAdd(&(bar)[XB_TMO], 1u); break; } } } } while (0)
struct XcdBarrier { unsigned* bar; unsigned x; volatile LAS unsigned* st; };
__device__ __forceinline__ XcdBarrier xcd_barrier_post(unsigned* bar, volatile LAS unsigned* st) {
    XcdBarrier b; b.bar = bar; b.x = xb_xcc_id(); b.st = st;
    if (threadIdx.x == 0) (void)xb_add(&bar[XB_XCNT(b.x)], 1u);
    return b;
}
__device__ __forceinline__ void xcd_barrier_complete(unsigned* bar, unsigned x, unsigned& nloc, unsigned& nx) {
    const unsigned G = gridDim.x * gridDim.y * gridDim.z;
    unsigned sum, cnt, mine, sp = 0u;
    for (;;) {
        sum = 0u; cnt = 0u; mine = 0u;
#pragma unroll
        for (unsigned j = 0; j < 16; ++j) { const unsigned c = xb_ld(&bar[XB_XCNT(j)]); sum += c; cnt += (c > 0u) ? 1u : 0u; mine = (j == x) ? c : mine; }
        if (sum == G) break;
        __builtin_amdgcn_s_sleep(1);
        if ((++sp & 255u) == 0u) { if (xb_ld(&bar[XB_TMO])) break; if (sp > XB_SPIN_CAP) { atomicAdd(&bar[XB_TMO], 1u); break; } }
    }
    nloc = mine > 0u ? mine : 1u; nx = cnt > 0u ? cnt : 1u;
}
__device__ __forceinline__ void xcd_barrier(const XcdBarrier& b) {
    asm volatile("s_waitcnt vmcnt(0)" ::: "memory");
    __syncthreads();
    if (threadIdx.x == 0) {
        unsigned* bar = b.bar;
        __builtin_amdgcn_s_waitcnt(0);
        unsigned nloc = b.st[0], nx = b.st[1];
        if (nloc == 0u) { xcd_barrier_complete(bar, b.x, nloc, nx); b.st[0] = nloc; b.st[1] = nx; }
        const unsigned old = xb_add(&bar[XB_XSUB(b.x)], 1u);
        const unsigned gen = old / nloc;
        if (old + 1u == (gen + 1u) * nloc) {
            __builtin_amdgcn_fence(__ATOMIC_RELEASE, "agent");
            asm volatile("s_waitcnt vmcnt(0)" ::: "memory");
            const unsigned og = xb_add(&bar[XB_TOP], 1u);
            const unsigned tg = og / nx;
            if (og + 1u == (tg + 1u) * nx) xb_add(&bar[XB_TOPGEN], 1u);
            else XB_SPIN(xb_ld(&bar[XB_TOPGEN]) == tg, bar);
            __builtin_amdgcn_fence(__ATOMIC_ACQUIRE, "agent");
            xb_add(&bar[XB_XGEN(b.x)], 1u);
            asm volatile("s_waitcnt vmcnt(0)" ::: "memory");
        } else {
            XB_SPIN(xb_ld(&bar[XB_XGEN(b.x)]) == gen, bar);
            __builtin_amdgcn_fence(__ATOMIC_ACQUIRE, "agent");
            asm volatile("s_waitcnt vmcnt(0)" ::: "memory");
        }
    }
    __syncthreads();
}

struct KArgs { const float* in[28]; float* out; unsigned char* ws; int ph_lo, ph_hi, li, pad; };
typedef const __attribute__((address_space(4))) KArgs* KA;
enum { I_XP = 0, I_XS, I_CK, I_CV, I_SSSM, I_SRET, I_C, I_CCTX, I_WMOD, I_BMOD, I_NORMG, I_WFI, I_WFO, I_WIN, I_WOUT, I_QNG, I_KNG,
       I_ARE, I_AIM, I_LOGDT, I_BRE, I_BIM, I_CRE, I_CIM, I_SSMD, I_WGLU, I_DECAY, I_FNG };

struct Frame {
    LAS unsigned char* lds;
    int tid, lane, wave, G, gw, NGW;
};

__device__ __forceinline__ float wave_sum(float v) {
#pragma unroll
    for (int o = 1; o < 64; o <<= 1) v += __shfl_xor(v, o);
    return v;
}
__device__ __forceinline__ float wave_max(float v) {
#pragma unroll
    for (int o = 1; o < 64; o <<= 1) v = fmaxf(v, __shfl_xor(v, o));
    return v;
}
__device__ __forceinline__ float silu_f(float x) { return x / (1.0f + __expf(-x)); }
__device__ __forceinline__ float gelu_tanh(float x) { const float u = 0.7978845608028654f * (x + 0.044715f * x * x * x); return 0.5f * x * (1.0f + tanhf(u)); }

__device__ __forceinline__ void p0_transpose_item(const float* W, int K, int N, bf16* WT, int halfN, LAS float* scr, int item, int lane) {
    const int nblk = N / 32, kb = item / nblk, nb = item % nblk, k0 = 64 * kb, n0 = 32 * nb;
    int R0 = n0;
    if (halfN) { if (n0 < halfN) R0 = 256 * (n0 >> 7) + (n0 & 127); else { const int n1 = n0 - halfN; R0 = 256 * (n1 >> 7) + 128 + (n1 & 127); } }
#pragma unroll 8
    for (int i = 0; i < 32; ++i) { const int kk = 2 * i + (lane >> 5); scr[kk * 33 + (lane & 31)] = W[(size_t)(k0 + kk) * N + n0 + (lane & 31)]; }
    LDS_WAIT(); asm volatile("" ::: "memory");
    const int c = lane & 7;
#pragma unroll
    for (int j = 0; j < 4; ++j) { const int n = (lane >> 3) + 8 * j; const LAS float* s = scr + (8 * c) * 33 + n;
        v4u o; o.x = pk2(s[0 * 33], s[1 * 33]); o.y = pk2(s[2 * 33], s[3 * 33]); o.z = pk2(s[4 * 33], s[5 * 33]); o.w = pk2(s[6 * 33], s[7 * 33]);
        *(GAS v4u*)(WT + (size_t)(R0 + n) * K + k0 + 8 * c) = o; }
    LDS_WAIT(); asm volatile("" ::: "memory");
}

__device__ __forceinline__ void phase_prologue(const Frame& F, KA a) {
    unsigned char* ws = a->ws;
    LAS float* cs = (LAS float*)(F.lds);
    LAS float* red = (LAS float*)(F.lds + 24576);
    for (int i = F.tid; i < 3 * DM; i += 512) { const int v = i / DM, k = i % DM; const float c = v == 0 ? a->in[I_CCTX][k] : a->in[I_C][(v - 1) * DM + k]; cs[i] = silu_f(c); }
    __syncthreads();
    float* modb = (float*)(ws + WS_MOD);
    for (int task = blockIdx.x; task < 2 * 72 * 8; task += F.G) {
        const int l = task / 576, r = task % 576, cb = r / 8, kc = r % 8;
        const int kbase = kc * 256 + F.wave * 32, col = cb * 256 + F.lane * 4;
        const float* wp = a->in[I_WMOD] + ((size_t)l * DM + kbase) * MODW + col;
        f32x4 s0 = {0, 0, 0, 0}, s1 = s0, s2 = s0;
#pragma unroll 8
        for (int k = 0; k < 32; ++k) { const f32x4 w = *(const GAS f32x4*)(wp + (size_t)k * MODW);
            s0 += w * cs[kbase + k]; s1 += w * cs[DM + kbase + k]; s2 += w * cs[2 * DM + kbase + k]; }
        LAS float* rp = red + (F.wave * 64 + F.lane) * 12;
#pragma unroll
        for (int j = 0; j < 4; ++j) { rp[j] = s0[j]; rp[4 + j] = s1[j]; rp[8 + j] = s2[j]; }
        __syncthreads();
        for (int o = F.tid; o < 768; o += 512) { const int v = o >> 8, c = o & 255; float s = 0.f;
#pragma unroll
            for (int w = 0; w < 8; ++w) s += red[(w * 64 + (c >> 2)) * 12 + v * 4 + (c & 3)];
            if (kc == 0) s += a->in[I_BMOD][l * MODW + cb * 256 + c];
            unsafeAtomicAdd(modb + ((size_t)l * 3 + v) * MODW + cb * 256 + c, s); }
        __syncthreads();
    }
    {
        float* cosT = (float*)(ws + WS_COS); float* sinT = (float*)(ws + WS_SIN);
        for (int i = blockIdx.x * 512 + F.tid; i < DSEQ * 64; i += F.G * 512) { const int t = i >> 6, j = i & 63, ax = j >> 5, f = j & 31;
            const float pos = (float)(ax == 0 ? (t >> 6) : (t & 63)); const float inv = powf(10000.0f, -(float)f / 32.0f); const float ang = pos * inv;
            float sn, cn; sincosf(ang, &sn, &cn); cosT[i] = cn; sinT[i] = sn; }
        float* lamT = (float*)(ws + WS_LAM); float* bbT = (float*)(ws + WS_BBAR);
        for (int i = blockIdx.x * 512 + F.tid; i < NLAYER * 2 * 32 * 64; i += F.G * 512) {
            const int ldg = i >> 6;
            const float dt = expf(a->in[I_LOGDT][ldg]); const float ar = a->in[I_ARE][i], ai = a->in[I_AIM][i];
            const float x = ar * dt, y = ai * dt; float sn, cn; sincosf(y, &sn, &cn); const float ex = expf(x);
            lamT[2 * i] = ex * cn; lamT[2 * i + 1] = ex * sn;
            const float sh = sinf(0.5f * y); const float nr = expm1f(x) * cn - 2.0f * sh * sh, ni = ex * sn;
            const float d2 = ar * ar + ai * ai; const float cr = (nr * ar + ni * ai) / d2, ci = (ni * ar - nr * ai) / d2;
#pragma unroll
            for (int j = 0; j < 16; ++j) { const float br = a->in[I_BRE][(size_t)i * 16 + j], bi = a->in[I_BIM][(size_t)i * 16 + j];
                bbT[((size_t)i * 16 + j) * 2] = cr * br - ci * bi; bbT[((size_t)i * 16 + j) * 2 + 1] = cr * bi + ci * br; }
        }
    }
    {
        GAS f32x4* xr = (GAS f32x4*)(ws + WS_XR);
        const GAS f32x4* xp = (const GAS f32x4*)a->in[I_XP]; const GAS f32x4* xs = (const GAS f32x4*)a->in[I_XS];
        const int NP4 = NPR * DM / 4, NT4 = MT * DM / 4;
        for (int i = blockIdx.x * 512 + F.tid; i < NT4; i += F.G * 512) xr[i] = i < NP4 ? xp[i] : xs[i - NP4];
    }
    {
        LAS float* scr = (LAS float*)(F.lds + 49152 + F.wave * 8704);
        constexpr int I_FI = (DM / 64) * (2 * DFF / 32), I_FO = (DFF / 64) * (DM / 32), I_IN = (DM / 64) * (INW / 32), I_OUT = (DM / 64) * (DM / 32), I_GL = (512 / 64) * (1024 / 32);
        constexpr int NITEMS = 4 * I_FI + 4 * I_FO + 2 * I_IN + 2 * I_OUT + 2 * I_GL;
        for (int it = F.gw; it < NITEMS; it += F.NGW) {
            int r = it;
            if (r < 4 * I_FI) { const int m = r / I_FI; p0_transpose_item(a->in[I_WFI] + (size_t)m * DM * 2 * DFF, DM, 2 * DFF, (bf16*)(ws + WS_WFI) + (size_t)m * 2 * DFF * DM, DFF, scr, r % I_FI, F.lane); continue; } r -= 4 * I_FI;
            if (r < 4 * I_FO) { const int m = r / I_FO; p0_transpose_item(a->in[I_WFO] + (size_t)m * DFF * DM, DFF, DM, (bf16*)(ws + WS_WFO) + (size_t)m * DM * DFF, 0, scr, r % I_FO, F.lane); continue; } r -= 4 * I_FO;
            if (r < 2 * I_IN) { const int m = r / I_IN; p0_transpose_item(a->in[I_WIN] + (size_t)m * DM * INW, DM, INW, (bf16*)(ws + WS_WIN) + (size_t)m * INW * DM, 0, scr, r % I_IN, F.lane); continue; } r -= 2 * I_IN;
            if (r < 2 * I_OUT) { const int m = r / I_OUT; p0_transpose_item(a->in[I_WOUT] + (size_t)m * DM * DM, DM, DM, (bf16*)(ws + WS_WOUT) + (size_t)m * DM * DM, 0, scr, r % I_OUT, F.lane); continue; } r -= 2 * I_OUT;
            { const int m = r / I_GL; p0_transpose_item(a->in[I_WGLU] + (size_t)m * 512 * 1024, 512, 1024, (bf16*)(ws + WS_WGLU) + (size_t)m * 1024 * 512, 512, scr, r % I_GL, F.lane); }
        }
    }
}

__device__ __forceinline__ void phase_prenorm(const Frame& F, KA a, int l, int sub) {
    unsigned char* ws = a->ws;
    const float* xr = (const float*)(ws + WS_XR);
    for (int m = F.gw; m < MT; m += F.NGW) {
        const GAS f32x4* xp = (const GAS f32x4*)(xr + (size_t)m * DM) + F.lane;
        f32x4 v[8]; float s = 0.f;
#pragma unroll
        for (int j = 0; j < 8; ++j) { v[j] = xp[64 * j]; s += (v[j].x * v[j].x + v[j].y * v[j].y) + (v[j].z * v[j].z + v[j].w * v[j].w); }
        const float rstd = 1.0f / sqrtf(wave_sum(s) * (1.0f / DM) + EPS);
        if (sub == 3) {
            const GAS f32x4* gp = (const GAS f32x4*)a->in[I_FNG] + F.lane; GAS f32x4* op = (GAS f32x4*)(a->out + O_Y + (size_t)m * DM) + F.lane;
#pragma unroll
            for (int j = 0; j < 8; ++j) op[64 * j] = v[j] * rstd * gp[64 * j];
        } else {
            const int var = m < NPR ? 0 : 1 + (m - NPR) / DSEQ;
            const float* mod = (const float*)(ws + WS_MOD) + ((size_t)l * 3 + var) * MODW + sub * 3 * DM;
            const GAS f32x4* gp = (const GAS f32x4*)(a->in[I_NORMG] + ((size_t)l * 3 + sub) * DM) + F.lane;
            const GAS f32x4* shp = (const GAS f32x4*)mod + F.lane; const GAS f32x4* scp = (const GAS f32x4*)(mod + DM) + F.lane;
            GAS unsigned long long* o8 = (GAS unsigned long long*)((bf16*)(ws + WS_H) + (size_t)m * DM) + F.lane;
#pragma unroll
            for (int j = 0; j < 8; ++j) { const f32x4 y = v[j] * rstd * gp[64 * j] * (scp[64 * j] + 1.0f) + shp[64 * j];
                o8[64 * j] = (unsigned long long)pk2(y.x, y.y) | ((unsigned long long)pk2(y.z, y.w) << 32); }
        }
    }
}

__device__ __forceinline__ void phase_qkvpost(const Frame& F, KA a, int l) {
    unsigned char* ws = a->ws;
    const bf16* proj = (const bf16*)(ws + WS_PROJ);
    const float* cosT = (const float*)(ws + WS_COS); const float* sinT = (const float*)(ws + WS_SIN);
    const int i = F.lane, e0 = (i & 31) + 64 * (i >> 5), e1 = e0 + 32;
    const int NT1 = MT * 20, NT2 = NBS * PAST * 2 * 2;
    for (int task = F.gw; task < NT1 + NT2; task += F.NGW) {
        if (task >= NT1) {
            const int r = task - NT1; const int isv = r & 1, kvh = (r >> 1) & 1, t = (r >> 2) % PAST, b = (r >> 2) / PAST;
            const float* src = a->in[isv ? I_CV : I_CK] + ((((size_t)b * NLAYER + l) * PAST + t) * 2 + kvh) * 128;
            bf16* dst = (bf16*)(ws + (isv ? WS_VS : WS_KS)) + ((size_t)b * KALL + t) * 256 + kvh * 128;
            dst[e0] = (bf16)f2bf(src[e0]); dst[e1] = (bf16)f2bf(src[e1]);
            continue;
        }
        const int m = task / 20, ch = task % 20;
        const bool lat = m >= NPR; const int b = lat ? (m - NPR) / DSEQ : m / SEQ, t = lat ? (m - NPR) % DSEQ : m % SEQ;
        int scol; if (ch < 8) scol = C_QA + ch * 128; else if (ch < 10) scol = C_KA + (ch - 8) * 128; else if (ch < 12) scol = C_VA + (ch - 10) * 128; else if (ch < 16) scol = C_QR + (ch - 12) * 128; else scol = C_KR + (ch - 16) * 128;
        const bf16* src = proj + (size_t)m * INW + scol;
        float x0 = bf2f(src[e0]), x1 = bf2f(src[e1]);
        if (ch < 10) {
            const float ss = wave_sum(x0 * x0 + x1 * x1); const float r = 1.0f / sqrtf(ss * (1.0f / 128.0f) + EPS);
            const float* g = a->in[ch < 8 ? I_QNG : I_KNG] + l * 128;
            x0 *= r * g[e0]; x1 *= r * g[e1];
        }
        if (ch >= 16) { x0 *= 0.08838834764831845f; x1 *= 0.08838834764831845f; }
        if (lat && (ch < 10 || ch >= 12)) {
            const float c = cosT[t * 64 + i], s = sinT[t * 64 + i];
            const float y0 = x0 * c - x1 * s, y1 = x1 * c + x0 * s; x0 = y0; x1 = y1;
        }
        if (ch < 8) { bf16* d = (bf16*)(ws + WS_QB) + (size_t)m * 1024 + ch * 128; d[e0] = (bf16)f2bf(x0); d[e1] = (bf16)f2bf(x1); }
        else if (ch < 12) {
            const int isv = ch >= 10, kvh = (ch - 8) & 1;
            if (!lat) {
                float* o = a->out + (isv ? O_CV : O_CK) + ((((size_t)b * NLAYER + l) * SEQ + t) * 2 + kvh) * 128; o[e0] = x0; o[e1] = x1;
                bf16* d = (bf16*)(ws + (isv ? WS_VP : WS_KP)) + (size_t)m * 256 + kvh * 128; d[e0] = (bf16)f2bf(x0); d[e1] = (bf16)f2bf(x1);
            } else {
                bf16* d = (bf16*)(ws + (isv ? WS_VS : WS_KS)) + ((size_t)b * KALL + PAST + t) * 256 + kvh * 128; d[e0] = (bf16)f2bf(x0); d[e1] = (bf16)f2bf(x1);
            }
        }
        else if (ch < 16) { bf16* d = (bf16*)(ws + WS_QR) + (size_t)m * 512 + (ch - 12) * 128; d[e0] = (bf16)f2bf(x0); d[e1] = (bf16)f2bf(x1); }
        else { bf16* d = (bf16*)(ws + WS_KR) + (size_t)m * 512 + (ch - 16) * 128; d[e0] = (bf16)f2bf(x0); d[e1] = (bf16)f2bf(x1); }
    }
}

constexpr int NV_WAVE_LDS = 7168;

__device__ __forceinline__ void nv_attn_row(const bf16* qrow, const bf16* Kb, const bf16* Vb, int nkeys, bf16* out, LAS float* qs, LAS float* ps, int lane) {
    qs[lane] = bf2f(qrow[lane]); qs[lane + 64] = bf2f(qrow[lane + 64]);
    LDS_WAIT(); asm volatile("" ::: "memory");
    float mx = -3.0e38f;
    for (int j = lane; j < nkeys; j += 64) {
        const GAS v4u* kr = (const GAS v4u*)(Kb + (size_t)j * 256); float s = 0.f;
#pragma unroll 4
        for (int c = 0; c < 16; ++c) { const v4u w = kr[c]; const LAS float* q = qs + 8 * c;
            s += q[0] * bflo(w.x) + q[1] * bfhi(w.x) + q[2] * bflo(w.y) + q[3] * bfhi(w.y) + q[4] * bflo(w.z) + q[5] * bfhi(w.z) + q[6] * bflo(w.w) + q[7] * bfhi(w.w); }
        s *= 0.08838834764831845f; ps[j] = s; mx = fmaxf(mx, s);
    }
    mx = wave_max(mx);
    float sum = 0.f;
    for (int j = lane; j < nkeys; j += 64) { const float p = __expf(ps[j] - mx); ps[j] = p; sum += p; }
    sum = wave_sum(sum);
    LDS_WAIT(); asm volatile("" ::: "memory");
    float o0 = 0.f, o1 = 0.f;
#pragma unroll 4
    for (int j = 0; j < nkeys; ++j) { const float p = ps[j]; const bf16* vr = Vb + (size_t)j * 256; o0 += p * bf2f(vr[lane]); o1 += p * bf2f(vr[lane + 64]); }
    const float inv = 1.0f / sum;
    out[lane] = (bf16)f2bf(o0 * inv); out[lane + 64] = (bf16)f2bf(o1 * inv);
    LDS_WAIT(); asm volatile("" ::: "memory");
}

__device__ __forceinline__ void nv_ret_row(KA a, int l, int m0, int L, int t, int h, int bl  , float lgf, float lgb, LAS float* qs, LAS float* ps, int lane) {
    unsigned char* ws = a->ws;
    const bf16* QR = (const bf16*)(ws + WS_QR); const bf16* KR = (const bf16*)(ws + WS_KR); const bf16* proj = (const bf16*)(ws + WS_PROJ);
    const int m = m0 + t;
    const bf16* qrow = QR + (size_t)m * 512 + h * 128;
    qs[lane] = bf2f(qrow[lane]); qs[lane + 64] = bf2f(qrow[lane + 64]);
    LDS_WAIT(); asm volatile("" ::: "memory");
    for (int j = lane; j < L; j += 64) {
        const GAS v4u* kr = (const GAS v4u*)(KR + (size_t)(m0 + j) * 512 + h * 128); float s = 0.f;
#pragma unroll 4
        for (int c = 0; c < 16; ++c) { const v4u w = kr[c]; const LAS float* q = qs + 8 * c;
            s += q[0] * bflo(w.x) + q[1] * bfhi(w.x) + q[2] * bflo(w.y) + q[3] * bfhi(w.y) + q[4] * bflo(w.z) + q[5] * bfhi(w.z) + q[6] * bflo(w.w) + q[7] * bfhi(w.w); }
        const float d = j < t ? exp2f((float)(t - j) * lgf) : (j > t ? exp2f((float)(j - t) * lgb) : 2.0f);
        ps[j] = s * d;
    }
    LDS_WAIT(); asm volatile("" ::: "memory");
    float o0 = 0.f, o1 = 0.f;
#pragma unroll 4
    for (int j = 0; j < L; ++j) { const float p = ps[j]; const bf16* vr = proj + (size_t)(m0 + j) * INW + C_VR + h * 128; o0 += p * bf2f(vr[lane]); o1 += p * bf2f(vr[lane + 64]); }
    if (bl >= 0) {
        const float* S0f = a->in[I_SRET] + ((((size_t)bl * NLAYER + l) * 2 + 0) * 4 + h) * 16384;
        const float* S0b = a->in[I_SRET] + ((((size_t)bl * NLAYER + l) * 2 + 1) * 4 + h) * 16384;
        float f0 = 0.f, f1 = 0.f, b0 = 0.f, b1 = 0.f;
#pragma unroll 4
        for (int d = 0; d < 128; ++d) { const float q = qs[d]; f0 += q * S0f[d * 128 + lane]; f1 += q * S0f[d * 128 + 64 + lane]; b0 += q * S0b[d * 128 + lane]; b1 += q * S0b[d * 128 + 64 + lane]; }
        const float wf = exp2f((float)(t + 1) * lgf), wb = exp2f((float)(L - t) * lgb);
        o0 += wf * f0 + wb * b0; o1 += wf * f1 + wb * b1;
    }
    const float mean = wave_sum(o0 + o1) * (1.0f / 128.0f); o0 -= mean; o1 -= mean;
    const float var = wave_sum(o0 * o0 + o1 * o1) * (1.0f / 128.0f); const float r = 1.0f / sqrtf(var + EPS);
    const bf16* gr = proj + (size_t)m * INW + C_GR + h * 128;
    const float g0 = bf2f(gr[lane]), g1 = bf2f(gr[lane + 64]);
    bf16* out = (bf16*)(ws + WS_MIX) + (size_t)m * DM + 1536 + h * 128;
    out[lane] = (bf16)f2bf(o0 * r * silu_f(g0)); out[lane + 64] = (bf16)f2bf(o1 * r * silu_f(g1));
    LDS_WAIT(); asm volatile("" ::: "memory");
}

__device__ __forceinline__ void nv_ret_state(KA a, int l, int b, int h, int dir, int d, float lg, int lane) {
    unsigned char* ws = a->ws;
    const bf16* KR = (const bf16*)(ws + WS_KR); const bf16* proj = (const bf16*)(ws + WS_PROJ);
    float o0 = 0.f, o1 = 0.f;
#pragma unroll 4
    for (int s = 0; s < SEQ; ++s) { const int m = b * SEQ + s; const float w = exp2f((float)(dir == 0 ? SEQ - 1 - s : s) * lg) * bf2f(KR[(size_t)m * 512 + h * 128 + d]);
        const bf16* vr = proj + (size_t)m * INW + C_VR + h * 128; o0 += w * bf2f(vr[lane]); o1 += w * bf2f(vr[lane + 64]); }
    float* o = a->out + O_RET + (((((size_t)b * NLAYER + l) * 2 + dir) * 4 + h) * 128 + d) * 128;
    o[lane] = o0; o[lane + 64] = o1;
}

__device__ __forceinline__ void nv_s5(KA a, int l, int m0, int L, int g, int bl, int bp, LAS float* hb, int lane) {
    unsigned char* ws = a->ws;
    const bf16* proj = (const bf16*)(ws + WS_PROJ);
    float* YS = (float*)(ws + WS_YS); bf16* YSB = (bf16*)(ws + WS_YSB);
    const int ch = lane & 15, q4 = lane >> 4;
    const float dcoef = a->in[I_SSMD][l * 512 + g * 16 + ch];
    for (int dir = 1; dir >= 0; --dir) {
        const int ldg = (l * 2 + dir) * 32 + g;
        const float* lamT = (const float*)(ws + WS_LAM) + ((size_t)ldg * 64 + lane) * 2;
        const float lr = lamT[0], li = lamT[1];
        const float* bbp = (const float*)(ws + WS_BBAR) + ((size_t)ldg * 64 + lane) * 32;
        float bre[16], bim[16], cre[16], cim[16];
#pragma unroll
        for (int j = 0; j < 16; ++j) { bre[j] = bbp[2 * j]; bim[j] = bbp[2 * j + 1]; }
        const float* crp = a->in[I_CRE] + ((size_t)ldg * 16 + ch) * 64 + q4 * 16; const float* cip = a->in[I_CIM] + ((size_t)ldg * 16 + ch) * 64 + q4 * 16;
#pragma unroll
        for (int j = 0; j < 16; ++j) { cre[j] = crp[j]; cim[j] = cip[j]; }
        float hr = 0.f, hi = 0.f;
        if (bl >= 0) { const float* h0 = a->in[I_SSSM] + (((((size_t)bl * NLAYER + l) * 2 + dir) * 32 + g) * 64 + lane) * 2; hr = h0[0]; hi = h0[1]; }
        for (int step = 0; step < L; ++step) {
            const int t = dir == 0 ? step : L - 1 - step; const int m = m0 + t;
            const GAS v4u* up = (const GAS v4u*)(proj + (size_t)m * INW + C_US + g * 16);
            const v4u u0 = up[0], u1 = up[1];
            float u[16] = {bflo(u0.x), bfhi(u0.x), bflo(u0.y), bfhi(u0.y), bflo(u0.z), bfhi(u0.z), bflo(u0.w), bfhi(u0.w),
                           bflo(u1.x), bfhi(u1.x), bflo(u1.y), bfhi(u1.y), bflo(u1.z), bfhi(u1.z), bflo(u1.w), bfhi(u1.w)};
            float br_ = 0.f, bi_ = 0.f;
#pragma unroll
            for (int j = 0; j < 16; ++j) { br_ += bre[j] * u[j]; bi_ += bim[j] * u[j]; }
            const float nr = lr * hr - li * hi + br_, ni = lr * hi + li * hr + bi_; hr = nr; hi = ni;
            hb[2 * lane] = hr; hb[2 * lane + 1] = hi;
            LDS_WAIT(); asm volatile("" ::: "memory");
            float y = 0.f;
#pragma unroll
            for (int j = 0; j < 16; ++j) { y += cre[j] * hb[2 * (q4 * 16 + j)] - cim[j] * hb[2 * (q4 * 16 + j) + 1]; }
            y += __shfl_xor(y, 16); y += __shfl_xor(y, 32);
            LDS_WAIT(); asm volatile("" ::: "memory");
            if (q4 == 0) {
                if (dir == 1) YS[(size_t)m * 512 + g * 16 + ch] = y;
                else { float uch = 0.f;
#pragma unroll
                    for (int j = 0; j < 16; ++j) uch = (ch == j) ? u[j] : uch;
                    const float yt = y + YS[(size_t)m * 512 + g * 16 + ch] + dcoef * uch;
                    YSB[(size_t)m * 512 + g * 16 + ch] = (bf16)f2bf(gelu_tanh(yt)); }
            }
        }
        if (bp >= 0) { float* o = a->out + O_SSM + (((((size_t)bp * NLAYER + l) * 2 + dir) * 32 + g) * 64 + lane) * 2; o[0] = hr; o[1] = hi; }
    }
}

__device__ __forceinline__ void decay_log2(KA a, int l, int h, float& lgf, float& lgb) {
    const float xf = a->in[I_DECAY][(l * 2 + 0) * 4 + h], xb = a->in[I_DECAY][(l * 2 + 1) * 4 + h];
    lgf = -log1pf(expf(-xf)) * 1.4426950408889634f; lgb = -log1pf(expf(-xb)) * 1.4426950408889634f;
}

__device__ __forceinline__ void phase_mixer_naive(const Frame& F, KA a, int l) {
    unsigned char* ws = a->ws;
    LAS float* qs = (LAS float*)(F.lds + F.wave * NV_WAVE_LDS); LAS float* ps = qs + 128; LAS float* hb = ps + 1536;
    const bf16* QB = (const bf16*)(ws + WS_QB); bf16* MIX = (bf16*)(ws + WS_MIX);
    constexpr int T_S5S = NBS * 32, T_S5P = NBP * 32, T_AS = NBS * 8 * DSEQ, T_RS = NBS * 4 * DSEQ, T_AP = NBP * 8 * SEQ, T_RP = NBP * 4 * SEQ, T_ST = NBP * 4 * 2 * 128;
    constexpr int TOT = T_S5S + T_S5P + T_AS + T_RS + T_AP + T_RP + T_ST;
    for (int task = F.gw; task < TOT; task += F.NGW) {
        int r = task;
        if (r < T_S5S) { const int b = r / 32, g = r % 32; nv_s5(a, l, NPR + b * DSEQ, DSEQ, g, b, -1, hb, F.lane); continue; } r -= T_S5S;
        if (r < T_S5P) { const int b = r / 32, g = r % 32; nv_s5(a, l, b * SEQ, SEQ, g, -1, b, hb, F.lane); continue; } r -= T_S5P;
        if (r < T_AS) { const int t = r % DSEQ, h = (r / DSEQ) % 8, b = r / (DSEQ * 8); const int m = NPR + b * DSEQ + t;
            nv_attn_row(QB + (size_t)m * 1024 + h * 128, (const bf16*)(ws + WS_KS) + (size_t)b * KALL * 256 + (h >> 2) * 128, (const bf16*)(ws + WS_VS) + (size_t)b * KALL * 256 + (h >> 2) * 128, KALL,
                        MIX + (size_t)m * DM + h * 128, qs, ps, F.lane); continue; } r -= T_AS;
        if (r < T_RS) { const int t = r % DSEQ, h = (r / DSEQ) % 4, b = r / (DSEQ * 4); float lgf, lgb; decay_log2(a, l, h, lgf, lgb);
            nv_ret_row(a, l, NPR + b * DSEQ, DSEQ, t, h, b, lgf, lgb, qs, ps, F.lane); continue; } r -= T_RS;
        if (r < T_AP) { const int t = r % SEQ, h = (r / SEQ) % 8, b = r / (SEQ * 8); const int m = b * SEQ + t;
            nv_attn_row(QB + (size_t)m * 1024 + h * 128, (const bf16*)(ws + WS_KP) + (size_t)b * SEQ * 256 + (h >> 2) * 128, (const bf16*)(ws + WS_VP) + (size_t)b * SEQ * 256 + (h >> 2) * 128, SEQ,
                        MIX + (size_t)m * DM + h * 128, qs, ps, F.lane); continue; } r -= T_AP;
        if (r < T_RP) { const int t = r % SEQ, h = (r / SEQ) % 4, b = r / (SEQ * 4); float lgf, lgb; decay_log2(a, l, h, lgf, lgb);
            nv_ret_row(a, l, b * SEQ, SEQ, t, h, -1, lgf, lgb, qs, ps, F.lane); continue; } r -= T_RP;
        { const int d = r % 128, dir = (r / 128) % 2, h = (r / 256) % 4, b = r / 1024; float lgf, lgb; decay_log2(a, l, h, lgf, lgb);
          nv_ret_state(a, l, b, h, dir, d, dir == 0 ? lgf : lgb, F.lane); }
    }
}

namespace mx {
using bf16x8 = __attribute__((ext_vector_type(8))) short;
using s16x4  = __attribute__((ext_vector_type(4))) short;
using f32x16 = __attribute__((ext_vector_type(16))) float;
using f32x8  = __attribute__((ext_vector_type(8))) float;
using u32x4  = __attribute__((ext_vector_type(4))) unsigned;
constexpr int D = 128, NW = 8, QBLK = 32, KVBLK = 64;
constexpr float SCALE = 0.088388347648318440f;
constexpr float THR = 8.f;
constexpr int SHM_V = KVBLK * D * 2, SHM_K = KVBLK * D * 2;
#define KSWZ(row, colB) ((row) * 256 + ((colB) ^ (((row) & 7) << 4)))
#define SBAR() __builtin_amdgcn_sched_barrier(0)
__device__ __forceinline__ int crow(int r, int hi) { return (r & 3) + 8 * (r >> 2) + 4 * hi; }
__device__ __forceinline__ unsigned cvtpk(float lo, float hi) { unsigned r; asm volatile("v_cvt_pk_bf16_f32 %0, %1, %2" : "=v"(r) : "v"(lo), "v"(hi)); return r; }
__device__ __forceinline__ bf16x8 ld8(const bf16* p) { return *reinterpret_cast<const bf16x8*>(p); }
__device__ __forceinline__ bf16x8 cvt8(f32x8 x) { u32x4 w = {cvtpk(x[0], x[1]), cvtpk(x[2], x[3]), cvtpk(x[4], x[5]), cvtpk(x[6], x[7])}; return *reinterpret_cast<bf16x8*>(&w); }

__device__ __forceinline__ void partialSM(f32x16& p0, f32x16& p1, float& m_reg, float& mn, float& alpha) {
  constexpr float C = SCALE * 1.4426950408889634f;
  float pmax = p0[0]; for (int r = 1; r < 16; ++r) pmax = fmaxf(pmax, p0[r]); for (int r = 0; r < 16; ++r) pmax = fmaxf(pmax, p1[r]);
  { auto rr = __builtin_amdgcn_permlane32_swap(__float_as_uint(pmax), __float_as_uint(pmax), false, false);
    pmax = fmaxf(__uint_as_float(rr[0]), __uint_as_float(rr[1])); }
  if (__builtin_expect(__all(pmax - m_reg <= THR / SCALE), 1)) { mn = m_reg; alpha = 1.f; }
  else { mn = fmaxf(m_reg, pmax); alpha = __builtin_amdgcn_exp2f((m_reg - mn) * C); m_reg = mn; }
  float mnC = -mn * C;
  for (int r = 0; r < 16; ++r) p0[r] = fmaf(p0[r], C, mnC); for (int r = 0; r < 16; ++r) p1[r] = fmaf(p1[r], C, mnC);
  for (int r = 0; r < 16; ++r) p0[r] = __builtin_amdgcn_exp2f(p0[r]);
}
#define PK4(P, BASE, OUT) do { unsigned a0 = cvtpk(P[BASE + 0], P[BASE + 1]), a1 = cvtpk(P[BASE + 2], P[BASE + 3]);   \
    unsigned b0 = cvtpk(P[BASE + 4], P[BASE + 5]), b1 = cvtpk(P[BASE + 6], P[BASE + 7]);                              \
    auto r0 = __builtin_amdgcn_permlane32_swap(a0, b0, false, false); auto r1 = __builtin_amdgcn_permlane32_swap(a1, b1, false, false); \
    u32x4 w = {r0[0], r1[0], r0[1], r1[1]}; OUT = *reinterpret_cast<bf16x8*>(&w); } while (0)
__device__ __forceinline__ void finishSM(f32x16& p0, f32x16& p1, float alpha, float& l_reg, bf16x8& pa0, bf16x8& pa1, bf16x8& pa2, bf16x8& pa3) {
  for (int r = 0; r < 16; ++r) p1[r] = __builtin_amdgcn_exp2f(p1[r]);
  float ps = 0; for (int r = 0; r < 16; ++r) ps += p0[r]; for (int r = 0; r < 16; ++r) ps += p1[r];
  { auto rr = __builtin_amdgcn_permlane32_swap(__float_as_uint(ps), __float_as_uint(ps), false, false);
    ps = __uint_as_float(rr[0]) + __uint_as_float(rr[1]); }
  l_reg = l_reg * alpha + ps;
  PK4(p0, 0, pa0); PK4(p0, 8, pa1); PK4(p1, 0, pa2); PK4(p1, 8, pa3);
}
__device__ __forceinline__ void packP(f32x16& p0, f32x16& p1, bf16x8& pa0, bf16x8& pa1, bf16x8& pa2, bf16x8& pa3) {
  PK4(p0, 0, pa0); PK4(p0, 8, pa1); PK4(p1, 0, pa2); PK4(p1, 8, pa3);
}
__device__ __forceinline__ void decayP(f32x16& p0, f32x16& p1, int e0  , float lgf, float nlgb, bool diag) {
  const float eb = (float)e0;
#pragma unroll
  for (int r = 0; r < 16; ++r) { const float c = (float)((r & 3) + 8 * (r >> 2));
    const float ea = eb - c, ec = eb - 32.f - c;
    float da = __builtin_amdgcn_exp2f(fminf(ea * lgf, ea * nlgb)), dc = __builtin_amdgcn_exp2f(fminf(ec * lgf, ec * nlgb));
    if (diag) { da = ea == 0.f ? 2.f : da; dc = ec == 0.f ? 2.f : dc; }
    p0[r] *= da; p1[r] *= dc; }
}
__device__ __forceinline__ void qkt(f32x16& p0, f32x16& p1, const LAS char* Ks, const bf16x8* qr, int r32, int hi) {
  p0 = f32x16{}; p1 = f32x16{};
#pragma unroll
  for (int d0 = 0; d0 < 8; ++d0) { int cb = (d0 * 16 + hi * 8) * 2;
    bf16x8 b0 = *reinterpret_cast<const LAS bf16x8*>(Ks + KSWZ(r32, cb));
    bf16x8 b1 = *reinterpret_cast<const LAS bf16x8*>(Ks + KSWZ(32 + r32, cb));
    p0 = __builtin_amdgcn_mfma_f32_32x32x16_bf16(b0, qr[d0], p0, 0, 0, 0);
    p1 = __builtin_amdgcn_mfma_f32_32x32x16_bf16(b1, qr[d0], p1, 0, 0, 0); }
}
__device__ __forceinline__ int v_st(int k, int c) { const int kk = (k & ~0xC) | ((k & 4) << 1) | ((k & 8) >> 1); return ((kk >> 3) * 4 + (c >> 5)) * 512 + ((kk & 7) * 32 + (c & 31)) * 2; }
__device__ __forceinline__ int v_rd_base(int lane) { return ((lane & 3) << 3) | (((lane >> 2) & 3) << 6) | (((lane >> 4) & 1) << 5) | (((lane >> 5) & 1) << 8); }
constexpr int v_rd_off(int d0, int ks, int half) { return d0 * 512 + ks * 4096 + half * 2048; }
template <int OFF> __device__ __forceinline__ s16x4 tr_read(int vb) {
  s16x4 r; asm volatile("ds_read_b64_tr_b16 %0, %1 offset:%2" : "=&v"(r) : "v"(vb), "i"(OFF) : "memory"); return r;
}
#define PKLH(L, H) (bf16x8){L[0], L[1], L[2], L[3], H[0], H[1], H[2], H[3]}
template <int D0> __device__ __forceinline__ void pv_one(f32x16& od, int vb, bf16x8 pa0, bf16x8 pa1, bf16x8 pa2, bf16x8 pa3) {
  const s16x4 l0 = tr_read<v_rd_off(D0, 0, 0)>(vb), h0 = tr_read<v_rd_off(D0, 0, 1)>(vb), l1 = tr_read<v_rd_off(D0, 1, 0)>(vb), h1 = tr_read<v_rd_off(D0, 1, 1)>(vb);
  const s16x4 l2 = tr_read<v_rd_off(D0, 2, 0)>(vb), h2 = tr_read<v_rd_off(D0, 2, 1)>(vb), l3 = tr_read<v_rd_off(D0, 3, 0)>(vb), h3 = tr_read<v_rd_off(D0, 3, 1)>(vb);
  asm volatile("s_waitcnt lgkmcnt(0)" ::: "memory"); SBAR();
  od = __builtin_amdgcn_mfma_f32_32x32x16_bf16(pa0, PKLH(l0, h0), od, 0, 0, 0);
  od = __builtin_amdgcn_mfma_f32_32x32x16_bf16(pa1, PKLH(l1, h1), od, 0, 0, 0);
  od = __builtin_amdgcn_mfma_f32_32x32x16_bf16(pa2, PKLH(l2, h2), od, 0, 0, 0);
  od = __builtin_amdgcn_mfma_f32_32x32x16_bf16(pa3, PKLH(l3, h3), od, 0, 0, 0);
}
__device__ __forceinline__ void pv_d0(f32x16* o, int vb, bf16x8 pa0, bf16x8 pa1, bf16x8 pa2, bf16x8 pa3) {
  pv_one<0>(o[0], vb, pa0, pa1, pa2, pa3); pv_one<1>(o[1], vb, pa0, pa1, pa2, pa3); pv_one<2>(o[2], vb, pa0, pa1, pa2, pa3); pv_one<3>(o[3], vb, pa0, pa1, pa2, pa3);
}

template <bool GN> __device__ __forceinline__ void store_tile(const f32x16* o, const float* rowscale  , LAS float* stg, bf16* Ow, int ldo, const bf16* Gw, int ldg, int lane) {
  const int r32 = lane & 31, hi = lane >> 5;
#pragma unroll
  for (int r = 0; r < 16; ++r) { const int orow = crow(r, hi);
#pragma unroll
    for (int d0 = 0; d0 < 4; ++d0) stg[orow * 128 + d0 * 32 + r32] = rowscale ? o[d0][r] * rowscale[r] : o[d0][r]; }
  asm volatile("s_waitcnt lgkmcnt(0)" ::: "memory");
  const int ch = lane & 15;
#pragma unroll
  for (int i = 0; i < 8; ++i) { const int row = (lane >> 4) + 4 * i;
    f32x4 a = *(const LAS f32x4*)(stg + row * 128 + ch * 8), b = *(const LAS f32x4*)(stg + row * 128 + ch * 8 + 4);
    if (GN) {
      float s = (a[0] + a[1]) + (a[2] + a[3]) + (b[0] + b[1]) + (b[2] + b[3]);
      s += __shfl_xor(s, 1); s += __shfl_xor(s, 2); s += __shfl_xor(s, 4); s += __shfl_xor(s, 8);
      const float mean = s * (1.f / 128.f); a = a - mean; b = b - mean;
      float q = (a[0] * a[0] + a[1] * a[1]) + (a[2] * a[2] + a[3] * a[3]) + (b[0] * b[0] + b[1] * b[1]) + (b[2] * b[2] + b[3] * b[3]);
      q += __shfl_xor(q, 1); q += __shfl_xor(q, 2); q += __shfl_xor(q, 4); q += __shfl_xor(q, 8);
      const float rs = 1.0f / sqrtf(q * (1.f / 128.f) + EPS);
      const v4u gw = *(const GAS v4u*)(Gw + (size_t)row * ldg + ch * 8);
      const float g0 = bflo(gw.x), g1 = bfhi(gw.x), g2 = bflo(gw.y), g3 = bfhi(gw.y), g4 = bflo(gw.z), g5 = bfhi(gw.z), g6 = bflo(gw.w), g7 = bfhi(gw.w);
      a[0] *= rs * g0 * pg8::fast_sigmoid(g0); a[1] *= rs * g1 * pg8::fast_sigmoid(g1); a[2] *= rs * g2 * pg8::fast_sigmoid(g2); a[3] *= rs * g3 * pg8::fast_sigmoid(g3);
      b[0] *= rs * g4 * pg8::fast_sigmoid(g4); b[1] *= rs * g5 * pg8::fast_sigmoid(g5); b[2] *= rs * g6 * pg8::fast_sigmoid(g6); b[3] *= rs * g7 * pg8::fast_sigmoid(g7);
    }
    u32x4 w = {cvtpk(a[0], a[1]), cvtpk(a[2], a[3]), cvtpk(b[0], b[1]), cvtpk(b[2], b[3])};
    *(GAS u32x4*)(Ow + (size_t)row * ldo + ch * 8) = w; }
  asm volatile("s_waitcnt lgkmcnt(0)" ::: "memory");
}

template <bool RET, int LDQ, int LDK, int LDV, int LDO>
__device__ __forceinline__ void unit_body(const bf16* __restrict__ Qb, const bf16* __restrict__ Kh, const bf16* __restrict__ Vh, bf16* __restrict__ Ob, int seq, LAS char* lds,
                                          int q0  , float lgf, float lgb, const float* S0f, const float* S0b, const bf16* Gb  ) {
  int tid_ = threadIdx.x; asm volatile("" : "+v"(tid_));
  const int tid = tid_, wid = __builtin_amdgcn_readfirstlane(tid >> 6), lane = tid & 63, r32 = lane & 31, hi = lane >> 5;
  LAS char* V_lds = lds; LAS char* K_lds = lds + 2 * SHM_V;
  LAS float* wsf = (LAS float*)(lds + 2 * SHM_V + 2 * SHM_K) + wid * 64; LAS float* li_l = wsf; LAS float* al_l = wsf + 32;
  float m_reg = -1e30f, l_reg = 0; f32x16 o[4] = {}; bf16x8 qr[8];
  const bf16* Qw = Qb + (long)(wid * QBLK + r32) * LDQ + hi * 8;
#pragma unroll
  for (int d0 = 0; d0 < 8; ++d0) qr[d0] = ld8(Qw + d0 * 16);
  const int sr = tid >> 4, sc = (tid & 15) * 8, vst0 = v_st(sr, sc), vst1 = v_st(32 + sr, sc);
  const int vb0 = (int)(unsigned)(size_t)V_lds + v_rd_base(lane);
  const float nlgb = -lgb;
  const int trow = q0 + wid * QBLK + r32;

  if (RET && S0f != nullptr) {
    f32x16 o2[4];
#pragma unroll
    for (int pass = 0; pass < 2; ++pass) {
      const float* S0 = pass == 0 ? S0f : S0b;
#pragma unroll
      for (int half = 0; half < 2; ++half) {
        const f32x8 x0 = *reinterpret_cast<const f32x8*>(S0 + (size_t)(half * 64 + sr) * 128 + sc), x1 = *reinterpret_cast<const f32x8*>(S0 + (size_t)(half * 64 + 32 + sr) * 128 + sc);
        *(LAS bf16x8*)(V_lds + half * SHM_V + vst0) = cvt8(x0); *(LAS bf16x8*)(V_lds + half * SHM_V + vst1) = cvt8(x1);
      }
      __syncthreads();
      if (pass == 0) { pv_d0(o, vb0, qr[0], qr[1], qr[2], qr[3]); pv_d0(o, vb0 + SHM_V, qr[4], qr[5], qr[6], qr[7]); }
      else { for (int d = 0; d < 4; ++d) o2[d] = f32x16{}; pv_d0(o2, vb0, qr[0], qr[1], qr[2], qr[3]); pv_d0(o2, vb0 + SHM_V, qr[4], qr[5], qr[6], qr[7]); }
      __syncthreads();
    }
#pragma unroll
    for (int r = 0; r < 16; ++r) { const int t = q0 + wid * QBLK + crow(r, hi);
      const float wf = __builtin_amdgcn_exp2f((float)(t + 1) * lgf), wb = __builtin_amdgcn_exp2f((float)(seq - t) * lgb);
#pragma unroll
      for (int d = 0; d < 4; ++d) o[d][r] = o[d][r] * wf + o2[d][r] * wb; }
  }

  struct { bf16x8 vs0, vs1, ks0, ks1; } sr_[2];
#define SLOAD(i, k0) do { sr_[i].vs0 = ld8(&Vh[(long)((k0) + sr) * LDV + sc]); sr_[i].vs1 = ld8(&Vh[(long)((k0) + 32 + sr) * LDV + sc]); \
    sr_[i].ks0 = ld8(&Kh[(long)((k0) + sr) * LDK + sc]); sr_[i].ks1 = ld8(&Kh[(long)((k0) + 32 + sr) * LDK + sc]); } while (0)
#define SWRITE(b, i) do { *(LAS bf16x8*)(V_lds + (b) * SHM_V + vst0) = sr_[i].vs0;          \
    *(LAS bf16x8*)(V_lds + (b) * SHM_V + vst1) = sr_[i].vs1; int kc = sc * 2;               \
    *(LAS bf16x8*)(K_lds + (b) * SHM_K + KSWZ(sr, kc)) = sr_[i].ks0;                       \
    *(LAS bf16x8*)(K_lds + (b) * SHM_K + KSWZ(32 + sr, kc)) = sr_[i].ks1; } while (0)
#define SWAIT() asm volatile("s_waitcnt vmcnt(4)" ::: "memory")
#define RESC(a) do { if (!RET) { if (__any((a) < 1.f)) { if (hi == 0) al_l[r32] = (a); asm volatile("s_waitcnt lgkmcnt(0)" ::: "memory"); \
    for (int d = 0; d < 4; ++d) for (int r = 0; r < 16; ++r) o[d][r] *= al_l[crow(r, hi)]; } } } while (0)
#define SM1(P0, P1, MN, AL, TILE) do { if (RET) { const int k0_ = (TILE) * KVBLK; const bool dg_ = (k0_ <= q0 + wid * QBLK + 31) && (k0_ + 63 >= q0 + wid * QBLK); \
      decayP(P0, P1, trow - k0_ - 4 * hi, lgf, nlgb, dg_); } else partialSM(P0, P1, m_reg, MN, AL); } while (0)
#define SM2(P0, P1, AL) do { if (RET) packP(P0, P1, pa0, pa1, pa2, pa3); else finishSM(P0, P1, AL, l_reg, pa0, pa1, pa2, pa3); } while (0)
  f32x16 pA0, pA1, pB0, pB1; float mnA = 0.f, mnB = 0.f, alA = 1.f, alB = 1.f; bf16x8 pa0, pa1, pa2, pa3; const int NT = seq / KVBLK;
  constexpr int SE = 0, SO = 1;
  SLOAD(SE, 0); asm volatile("s_waitcnt vmcnt(0)" ::: "memory"); SWRITE(0, SE); __syncthreads();
  qkt(pA0, pA1, K_lds, qr, r32, hi); SM1(pA0, pA1, mnA, alA, 0);
  SLOAD(SO, KVBLK); if (2 < NT) SLOAD(SE, 2 * KVBLK);
  SWAIT(); SWRITE(1, SO); __syncthreads();
  for (int j = 1; j + 1 < NT; j += 2) {
    SBAR(); qkt(pB0, pB1, K_lds + SHM_K, qr, r32, hi);
    SM2(pA0, pA1, alA); SBAR();
    SLOAD(SO, (j + 2) * KVBLK); SBAR();
    pv_d0(o, vb0, pa0, pa1, pa2, pa3); SM1(pB0, pB1, mnB, alB, j);
    __syncthreads(); SWAIT(); SWRITE(0, SE);
    RESC(alB); __syncthreads();
    SBAR(); qkt(pA0, pA1, K_lds, qr, r32, hi);
    SM2(pB0, pB1, alB); SBAR();
    if (j + 3 < NT) SLOAD(SE, (j + 3) * KVBLK); SBAR();
    pv_d0(o, vb0 + (int)SHM_V, pa0, pa1, pa2, pa3); SM1(pA0, pA1, mnA, alA, j + 1);
    __syncthreads(); SWAIT(); SWRITE(1, SO);
    RESC(alA); __syncthreads();
  }
  SBAR(); qkt(pB0, pB1, K_lds + SHM_K, qr, r32, hi);
  SM2(pA0, pA1, alA); SBAR();
  pv_d0(o, vb0, pa0, pa1, pa2, pa3); SM1(pB0, pB1, mnB, alB, NT - 1);
  __syncthreads(); RESC(alB);
  SM2(pB0, pB1, alB); SBAR();
  pv_d0(o, vb0 + (int)SHM_V, pa0, pa1, pa2, pa3);
  float rli[16];
  if (!RET) {
    if (hi == 0) li_l[r32] = l_reg; asm volatile("s_waitcnt lgkmcnt(0)" ::: "memory");
#pragma unroll
    for (int r = 0; r < 16; ++r) rli[r] = __builtin_amdgcn_rcpf(li_l[crow(r, hi)]);
  }
  __syncthreads();
  LAS float* stg = (LAS float*)(lds + wid * 16384);
  store_tile<RET>(o, RET ? nullptr : rli, stg, Ob + (size_t)(wid * QBLK) * LDO, LDO, RET ? Gb + (size_t)(wid * QBLK) * INW : nullptr, INW, lane);
  __syncthreads();
#undef SLOAD
#undef SWRITE
#undef SWAIT
#undef RESC
#undef SM1
#undef SM2
}

__device__ __forceinline__ void ret_state_unit(const bf16* __restrict__ Kh  , const bf16* __restrict__ Vh  , float* __restrict__ outF, float* __restrict__ outB, float lgf, float lgb, LAS char* lds) {
  int tid_ = threadIdx.x; asm volatile("" : "+v"(tid_));
  const int tid = tid_, wid = __builtin_amdgcn_readfirstlane(tid >> 6), lane = tid & 63, r32 = lane & 31, hi = lane >> 5;
  const int sr = tid >> 4, sc = (tid & 15) * 8, vst0 = v_st(sr, sc), vst1 = v_st(32 + sr, sc);
  LAS char* KF = lds; LAS char* KB = lds + 16384; LAS char* VV = lds + 32768;
  const int dir = wid >> 2, Dd = wid & 3;
  const int ab = (int)(unsigned)(size_t)(dir ? KB : KF) + v_rd_base(lane) + Dd * 512;
  const int bb = (int)(unsigned)(size_t)VV + v_rd_base(lane);
  f32x16 acc[4] = {};
  for (int tile = 0; tile < SEQ / 64; ++tile) {
    const int s0 = tile * 64 + sr, s1 = s0 + 32;
    const bf16x8 k0 = ld8(Kh + (size_t)s0 * 512 + sc), k1 = ld8(Kh + (size_t)s1 * 512 + sc), v0 = ld8(Vh + (size_t)s0 * INW + sc), v1 = ld8(Vh + (size_t)s1 * INW + sc);
    const float wf0 = exp2f((float)(SEQ - 1 - s0) * lgf), wf1 = exp2f((float)(SEQ - 1 - s1) * lgf), wb0 = exp2f((float)s0 * lgb), wb1 = exp2f((float)s1 * lgb);
    f32x8 x0, x1;
#pragma unroll
    for (int j = 0; j < 8; ++j) { x0[j] = bf2f((unsigned short)k0[j]); x1[j] = bf2f((unsigned short)k1[j]); }
    *(LAS bf16x8*)(KF + vst0) = cvt8(x0 * wf0); *(LAS bf16x8*)(KF + vst1) = cvt8(x1 * wf1);
    *(LAS bf16x8*)(KB + vst0) = cvt8(x0 * wb0); *(LAS bf16x8*)(KB + vst1) = cvt8(x1 * wb1);
    *(LAS bf16x8*)(VV + vst0) = v0; *(LAS bf16x8*)(VV + vst1) = v1;
    __syncthreads();
#define RS_STEP(KS) do { const s16x4 al = tr_read<v_rd_off(0, KS, 0)>(ab), ah = tr_read<v_rd_off(0, KS, 1)>(ab); \
      const s16x4 l0 = tr_read<v_rd_off(0, KS, 0)>(bb), h0 = tr_read<v_rd_off(0, KS, 1)>(bb), l1 = tr_read<v_rd_off(1, KS, 0)>(bb), h1 = tr_read<v_rd_off(1, KS, 1)>(bb); \
      const s16x4 l2 = tr_read<v_rd_off(2, KS, 0)>(bb), h2 = tr_read<v_rd_off(2, KS, 1)>(bb), l3 = tr_read<v_rd_off(3, KS, 0)>(bb), h3 = tr_read<v_rd_off(3, KS, 1)>(bb); \
      asm volatile("s_waitcnt lgkmcnt(0)" ::: "memory"); SBAR(); const bf16x8 af = PKLH(al, ah); \
      acc[0] = __builtin_amdgcn_mfma_f32_32x32x16_bf16(af, PKLH(l0, h0), acc[0], 0, 0, 0); acc[1] = __builtin_amdgcn_mfma_f32_32x32x16_bf16(af, PKLH(l1, h1), acc[1], 0, 0, 0); \
      acc[2] = __builtin_amdgcn_mfma_f32_32x32x16_bf16(af, PKLH(l2, h2), acc[2], 0, 0, 0); acc[3] = __builtin_amdgcn_mfma_f32_32x32x16_bf16(af, PKLH(l3, h3), acc[3], 0, 0, 0); } while (0)
    RS_STEP(0); RS_STEP(1); RS_STEP(2); RS_STEP(3);
#undef RS_STEP
    __syncthreads();
  }
  float* out = dir ? outB : outF;
#pragma unroll
  for (int r = 0; r < 16; ++r) { const int d = Dd * 32 + crow(r, hi);
#pragma unroll
    for (int e = 0; e < 4; ++e) out[(size_t)d * 128 + e * 32 + r32] = acc[e][r]; }
}

using f32x4m = __attribute__((ext_vector_type(4))) float;
__device__ __forceinline__ void s5_wave(KA a, int l, int m0, int L, int g, int bl, int bp, LAS char* lds) {
  int tid_ = threadIdx.x; asm volatile("" : "+v"(tid_));
  const int lane = tid_ & 63; LAS char* wl = lds + __builtin_amdgcn_readfirstlane(tid_ >> 6) * 16384;
  unsigned char* ws = a->ws;
  const bf16* proj = (const bf16*)(ws + WS_PROJ);
  float* YS = (float*)(ws + WS_YS); bf16* YSB = (bf16*)(ws + WS_YSB);
  const int r32 = lane & 31, hi = lane >> 5, fr = lane & 15, q = lane >> 4;
  const float dcoef = a->in[I_SSMD][l * 512 + g * 16 + fr];
  LAS float* BU = (LAS float*)wl;
  for (int dir = 1; dir >= 0; --dir) {
    const int ldg = (l * 2 + dir) * 32 + g;
    const float* lamT = (const float*)(ws + WS_LAM) + ((size_t)ldg * 64 + lane) * 2;
    const float lr = lamT[0], li = lamT[1];
    bf16x8 bfr[4], cfr[4];
    {
      const float* bbT = (const float*)(ws + WS_BBAR);
#pragma unroll
      for (int tile = 0; tile < 4; ++tile) { const int p = 32 * (tile & 1) + r32, part = tile >> 1; f32x8 x;
#pragma unroll
        for (int j = 0; j < 8; ++j) x[j] = bbT[(((size_t)ldg * 64 + p) * 16 + 8 * hi + j) * 2 + part];
        bfr[tile] = cvt8(x); }
      const float* cre = a->in[I_CRE] + ((size_t)ldg * 16 + fr) * 64; const float* cim = a->in[I_CIM] + ((size_t)ldg * 16 + fr) * 64;
#pragma unroll
      for (int ks = 0; ks < 4; ++ks) { f32x8 x;
#pragma unroll
        for (int j = 0; j < 8; ++j) { const int p = 16 * ks + 4 * q + (j >> 1); x[j] = (j & 1) ? -cim[p] : cre[p]; }
        cfr[ks] = cvt8(x); }
    }
    float hr = 0.f, hi_ = 0.f;
    if (bl >= 0) { const float* h0 = a->in[I_SSSM] + (((((size_t)bl * NLAYER + l) * 2 + dir) * 32 + g) * 64 + lane) * 2; hr = h0[0]; hi_ = h0[1]; }
    const int NC = L / 32;
    for (int c = 0; c < NC; ++c) {
      const int T0 = dir == 0 ? 32 * c : L - 32 * (c + 1);
      const bf16x8 ua = ld8(proj + (size_t)(m0 + T0 + r32) * INW + C_US + g * 16 + 8 * hi);
#pragma unroll
      for (int tile = 0; tile < 4; ++tile) {
        const f32x16 d = __builtin_amdgcn_mfma_f32_32x32x16_bf16(ua, bfr[tile], f32x16{}, 0, 0, 0);
#pragma unroll
        for (int r = 0; r < 16; ++r) BU[crow(r, hi) * 128 + tile * 32 + r32] = d[r];
      }
      asm volatile("s_waitcnt lgkmcnt(0)" ::: "memory");
#pragma unroll
      for (int half = 0; half < 2; ++half) {
        float bre[16], bim[16];
#pragma unroll
        for (int k = 0; k < 16; ++k) { const int i = dir == 0 ? half * 16 + k : 31 - half * 16 - k; bre[k] = BU[i * 128 + lane]; bim[k] = BU[i * 128 + 64 + lane]; }
        asm volatile("s_waitcnt lgkmcnt(0)" ::: "memory");
#pragma unroll
        for (int k = 0; k < 16; ++k) { const int i = dir == 0 ? half * 16 + k : 31 - half * 16 - k;
          const float nr = lr * hr - li * hi_ + bre[k], ni = lr * hi_ + li * hr + bim[k]; hr = nr; hi_ = ni;
          ((LAS unsigned*)BU)[i * 128 + (lane ^ (4 * (i & 15)))] = cvtpk(hr, hi_); }
      }
      asm volatile("s_waitcnt lgkmcnt(0)" ::: "memory");
#pragma unroll
      for (int mt = 0; mt < 2; ++mt) {
        f32x4m y = {0.f, 0.f, 0.f, 0.f};
#pragma unroll
        for (int ks = 0; ks < 4; ++ks) { const int i = 16 * mt + fr;
          const bf16x8 hf = *(const LAS bf16x8*)((LAS unsigned*)BU + i * 128 + ((16 * ks + 4 * q) ^ (4 * (i & 15))));
          y = __builtin_amdgcn_mfma_f32_16x16x32_bf16(hf, cfr[ks], y, 0, 0, 0); }
#pragma unroll
        for (int rg = 0; rg < 4; ++rg) { const int i = 16 * mt + 4 * q + rg; const size_t m = (size_t)(m0 + T0 + i);
          if (dir == 1) YS[m * 512 + g * 16 + fr] = y[rg];
          else { const float yt = y[rg] + YS[m * 512 + g * 16 + fr] + dcoef * bf2f(proj[m * INW + C_US + g * 16 + fr]);
            YSB[m * 512 + g * 16 + fr] = (bf16)f2bf(gelu_tanh(yt)); } }
      }
      asm volatile("s_waitcnt lgkmcnt(0)" ::: "memory");
    }
    if (bp >= 0) { float* o = a->out + O_SSM + (((((size_t)bp * NLAYER + l) * 2 + dir) * 32 + g) * 64 + lane) * 2; o[0] = hr; o[1] = hi_; }
  }
}
#undef KSWZ
#undef SBAR
#undef PK4
#undef PKLH
}

__device__ __forceinline__ void mixer_unit(const Frame& F, KA a, int l, int u) {
  unsigned char* ws = a->ws; LAS char* lds = (LAS char*)F.lds;
  const bf16* proj = (const bf16*)(ws + WS_PROJ);
  int kind, lat, b, h = 0, qb = 0, v;
  int wv_; { int t_ = threadIdx.x; asm volatile("" : "+v"(t_)); wv_ = __builtin_amdgcn_readfirstlane(t_ >> 6); }
  if (u < 64) { kind = 0; lat = 1; qb = u & 3; h = (u >> 2) & 7; b = u >> 5; }
  else if (u < 96) { v = u - 64; kind = 1; lat = 1; qb = v & 3; h = (v >> 2) & 3; b = v >> 4; }
  else if (u < 104) { v = (u - 96) * 8 + wv_; kind = 2; lat = 1; b = v >> 5; h = v & 31; }
  else if (u < 232) { v = u - 104; kind = 0; lat = 0; h = v & 7; b = v >> 3; }
  else if (u < 296) { v = u - 232; kind = 1; lat = 0; h = v & 3; b = v >> 2; }
  else if (u < 360) { v = (u - 296) * 8 + wv_; kind = 2; lat = 0; b = v >> 5; h = v & 31; }
  else { v = u - 360; kind = 3; lat = 0; h = v & 3; b = v >> 2; }
  const size_t m0 = lat ? NPR + (size_t)b * DSEQ : (size_t)b * SEQ;
  const size_t m = m0 + (size_t)qb * 256;
  const int L = lat ? DSEQ : SEQ;
#ifndef MXK
#define MXK 15
#endif
  if (kind == 0) { if (MXK & 1) {
    const bf16* Kb = lat ? (const bf16*)(ws + WS_KS) + (size_t)b * KALL * 256 : (const bf16*)(ws + WS_KP) + m0 * 256;
    const bf16* Vb = lat ? (const bf16*)(ws + WS_VS) + (size_t)b * KALL * 256 : (const bf16*)(ws + WS_VP) + m0 * 256;
    mx::unit_body<false, 1024, 256, 256, DM>((const bf16*)(ws + WS_QB) + m * 1024 + h * 128, Kb + (h >> 2) * 128, Vb + (h >> 2) * 128, (bf16*)(ws + WS_MIX) + m * DM + h * 128,
        lat ? KALL : SEQ, lds, 0, 0.f, 0.f, nullptr, nullptr, nullptr); }
  } else if (kind == 1) { if (MXK & 2) {
    float lgf, lgb; decay_log2(a, l, h, lgf, lgb);
    const float* S0f = lat ? a->in[I_SRET] + ((((size_t)b * NLAYER + l) * 2 + 0) * 4 + h) * 16384 : nullptr;
    const float* S0b = lat ? a->in[I_SRET] + ((((size_t)b * NLAYER + l) * 2 + 1) * 4 + h) * 16384 : nullptr;
    mx::unit_body<true, 512, 512, INW, DM>((const bf16*)(ws + WS_QR) + m * 512 + h * 128, (const bf16*)(ws + WS_KR) + m0 * 512 + h * 128, proj + m0 * INW + C_VR + h * 128,
        (bf16*)(ws + WS_MIX) + m * DM + 1536 + h * 128, L, lds, qb * 256, lgf, lgb, S0f, S0b, proj + m * INW + C_GR + h * 128); }
  } else if (kind == 2) { if (MXK & 4)
    mx::s5_wave(a, l, (int)m0, L, h, lat ? b : -1, lat ? -1 : b, lds);
  } else if (MXK & 8) {
    float lgf, lgb; decay_log2(a, l, h, lgf, lgb);
    float* oF = a->out + O_RET + ((((size_t)b * NLAYER + l) * 2 + 0) * 4 + h) * 16384; float* oB = a->out + O_RET + ((((size_t)b * NLAYER + l) * 2 + 1) * 4 + h) * 16384;
    mx::ret_state_unit((const bf16*)(ws + WS_KR) + m0 * 512 + h * 128, proj + m0 * INW + C_VR + h * 128, oF, oB, lgf, lgb, lds);
  }
}
__device__ __forceinline__ void phase_mixer(const Frame& F, KA a, int l) {
  const int w = blockIdx.x;
  if (F.G == 256) {
    if (w < 104) { mixer_unit(F, a, l, w); __syncthreads(); }
    else { for (int u = w; u < 424; u += 152) { mixer_unit(F, a, l, u); __syncthreads(); } }
  } else { for (int u = w; u < 424; u += F.G) { mixer_unit(F, a, l, u); __syncthreads(); } }
}

constexpr int N_PHASES = 26;

template <class Epi> __device__ __forceinline__ void run_gemm(const Frame& F, const bf16* A, const bf16* Bt, int N, int K, const Epi& E) {
    pg8::Gemm g{A, Bt, MT, N, K}; pg8::StaticOrder S; S.init(MT, N, F.G, (int)blockIdx.x);
    pg8::gemm_phase<Epi, pg8::StaticOrder, true, true>(F.lds, g, S, E);
}

__device__ __forceinline__ Frame mkframe(LAS unsigned char* lds) {
    Frame F; { int t_ = threadIdx.x; asm volatile("" : "+v"(t_)); F.tid = t_; }
    F.lds = lds; F.lane = F.tid & 63; F.wave = __builtin_amdgcn_readfirstlane(F.tid >> 6);
    F.G = gridDim.x; F.gw = blockIdx.x * NWAVES + F.wave; F.NGW = F.G * NWAVES; return F;
}
#define FR mkframe((LAS unsigned char*)lds)
__global__ void __launch_bounds__(NWAVES * 64, 2) trunk_fwd(KArgs args) {
    extern __shared__ __attribute__((aligned(16))) unsigned char lds[];
    volatile LAS unsigned* MISC = (volatile LAS unsigned*)((LAS unsigned char*)lds + MISC_OFF);
    for (int u = threadIdx.x; u < (LDS_BYTES - LDSCTL_OFF) / 4; u += NWAVES * 64) ((LAS unsigned*)((LAS unsigned char*)lds + LDSCTL_OFF))[u] = 0u;
    __syncthreads();
    unsigned* ctl = (unsigned*)(args.ws + WS_CTL);
    XcdBarrier bar; bar.bar = ctl + CW_BAR; bar.x = 0; bar.st = nullptr;
    const bool multi = (args.ph_hi - args.ph_lo) > 1;
    if (multi) bar = xcd_barrier_post(ctl + CW_BAR, MISC + 8);

    for (int ph = args.ph_lo; ph < args.ph_hi; ++ph) {
        KA ap; { unsigned long long p_ = (unsigned long long)__builtin_amdgcn_kernarg_segment_ptr(); asm volatile("" : "+s"(p_)); ap = (KA)p_; }
        unsigned char* ws = ap->ws;
#ifndef PH_MASK
#define PH_MASK 0xFFFF
#endif
        if (ph == 0) { if (PH_MASK & 1) phase_prologue(FR, ap); }
        else if (ph == N_PHASES - 1) phase_prenorm(FR, ap, 0, 3);
        else {
            const int l = (ph - 1) / 12, s = (ph - 1) % 12;
            const float* modl = (const float*)(ws + WS_MOD) + (size_t)l * 3 * MODW;
            switch (s) {
                case 0: if (PH_MASK & 2) phase_prenorm(FR, ap, l, 0); break;
                case 3: if (PH_MASK & 2) phase_prenorm(FR, ap, l, 1); break;
                case 9: if (PH_MASK & 2) phase_prenorm(FR, ap, l, 2); break;
                case 1: case 10: {
                    const int i = s == 1 ? 0 : 1;
                    pg8::EpiPair<0> E{(bf16*)(ws + WS_ACT), DFF, 0};
                    if (PH_MASK & 4) run_gemm(FR, (const bf16*)(ws + WS_H), (const bf16*)(ws + WS_WFI) + (size_t)(l * 2 + i) * 2 * DFF * DM, 2 * DFF, DM, E); break; }
                case 2: case 11: {
                    const int i = s == 2 ? 0 : 1, sub = s == 2 ? 0 : 2;
                    pg8::EpiResid E{(float*)(ws + WS_XR), modl + sub * 3 * DM + 2 * DM, MODW, 0.5f};
                    if (PH_MASK & 8) run_gemm(FR, (const bf16*)(ws + WS_ACT), (const bf16*)(ws + WS_WFO) + (size_t)(l * 2 + i) * DM * DFF, DM, DFF, E); break; }
                case 4: {
                    pg8::EpiBf16 E{(bf16*)(ws + WS_PROJ), INW};
                    if (PH_MASK & 16) run_gemm(FR, (const bf16*)(ws + WS_H), (const bf16*)(ws + WS_WIN) + (size_t)l * INW * DM, INW, DM, E); break; }
                case 5: if (PH_MASK & 32) phase_qkvpost(FR, ap, l); break;
                case 6: if (PH_MASK & 64) {
#if MIXER_NAIVE
                    phase_mixer_naive(FR, ap, l);
#else
                    phase_mixer(FR, ap, l);
#endif
                } break;
                case 7: {
                    pg8::EpiPair<1> E{(bf16*)(ws + WS_MIX), DM, 1024};
                    if (PH_MASK & 128) run_gemm(FR, (const bf16*)(ws + WS_YSB), (const bf16*)(ws + WS_WGLU) + (size_t)l * 1024 * 512, 1024, 512, E); break; }
                case 8: {
                    pg8::EpiResid E{(float*)(ws + WS_XR), modl + 1 * 3 * DM + 2 * DM, MODW, 1.0f};
                    if (PH_MASK & 256) run_gemm(FR, (const bf16*)(ws + WS_MIX), (const bf16*)(ws + WS_WOUT) + (size_t)l * DM * DM, DM, DM, E); break; }
                default: break;
            }
        }
        if (ph + 1 < args.ph_hi) xcd_barrier(bar);
    }
}

extern "C" void kernel_launch(void* const* d_in, const int* in_sizes, int n_in, void* d_out, int out_size, void* d_ws, size_t ws_size, hipStream_t stream) {
    static int grid = 0;
    if (grid == 0) {
        if (n_in != 28 || out_size != (int)O_END || ws_size < WS_END) { fprintf(stderr, "kernel_launch: unexpected shapes: n_in %d out %d ws %zu (need >= %zu)\n", n_in, out_size, ws_size, (size_t)WS_END); grid = -1; return; }
        int dev = 0, cus = 0, per_cu = 0;
        if (hipGetDevice(&dev) != hipSuccess || hipDeviceGetAttribute(&cus, hipDeviceAttributeMultiprocessorCount, dev) != hipSuccess) { fprintf(stderr, "kernel_launch: device query failed\n"); grid = -1; return; }
        if (hipFuncSetAttribute((const void*)trunk_fwd, hipFuncAttributeMaxDynamicSharedMemorySize, LDS_BYTES) != hipSuccess) { fprintf(stderr, "kernel_launch: hipFuncSetAttribute failed\n"); grid = -1; return; }
        if (hipOccupancyMaxActiveBlocksPerMultiprocessor(&per_cu, (const void*)trunk_fwd, NWAVES * 64, LDS_BYTES) != hipSuccess || per_cu < 1) { fprintf(stderr, "kernel_launch: occupancy query says %d blocks per CU\n", per_cu); (void)hipGetLastError(); grid = -1; return; }
        grid = cus;
        if (grid > 256) grid = 256;
    }
    if (grid < 0) return;
    (void)hipMemsetAsync((char*)d_ws + WS_CTL, 0, CTL_ZERO_BYTES, stream);
    KArgs a{};
    for (int i = 0; i < 28; ++i) a.in[i] = (const float*)d_in[i];
    a.out = (float*)d_out; a.ws = (unsigned char*)d_ws;
#if MK_ONE_LAUNCH
    a.ph_lo = 0; a.ph_hi = N_PHASES; a.li = 0;
    hipLaunchKernelGGL(trunk_fwd, dim3(grid), dim3(NWAVES * 64), LDS_BYTES, stream, a);
#else
    for (int ph = 0; ph < N_PHASES; ++ph) { a.ph_lo = ph; a.ph_hi = ph + 1; a.li = ph;
        hipLaunchKernelGGL(trunk_fwd, dim3(grid), dim3(NWAVES * 64), LDS_BYTES, stream, a); }
#endif
    const hipError_t le = hipPeekAtLastError();
    if (le != hipSuccess) fprintf(stderr, "kernel_launch: launch failed: %s\n", hipGetErrorName(le));
}
```

```cpp
#define MK_ONE_LAUNCH 1
#include <hip/hip_runtime.h>
#include <cstdio>
#include <cstdint>
#include <cmath>

constexpr int DM = 2048, NPR = 4096, NSR = 2048, MT = 6144, DFF = 5632, INW = 4096;
constexpr int SEQ = 256, DSEQ = 1024, PAST = 512, NBP = 16, NBS = 2, NLAYER = 2;
constexpr int KALL = PAST + DSEQ;
constexpr int MODW = 9 * DM;
constexpr float EPS = 1e-6f;
constexpr int C_QA = 0, C_KA = 1024, C_VA = 1280, C_US = 1536, C_QR = 2048, C_KR = 2560, C_VR = 3072, C_GR = 3584;
constexpr size_t O_Y = 0, O_CK = 12582912, O_CV = 14680064, O_SSM = 16777216, O_RET = 17039360, O_END = 21233664;

namespace pg8 {
#define PG8_LAS __attribute__((address_space(3)))
typedef unsigned short bf16_t;
typedef short bf16x8 __attribute__((ext_vector_type(8)));
typedef float f32x4 __attribute__((ext_vector_type(4)));
typedef unsigned u32x4 __attribute__((ext_vector_type(4)));
constexpr int BM = 256, BK = 64, HALF = 128, HTB = HALF * BK * 2, STAGE_BYTES = 8 * HTB, NXCD = 8, WGM = 8;

__host__ __device__ __forceinline__ int lds_byte(int r, int c) { const int st = (r >> 4) * 2 + (c >> 5), rr = r & 15, cc = c & 31, ob = rr * 64 + cc * 2; return st * 1024 + (ob ^ (((ob >> 9) & 1) << 5)); }
__host__ __device__ __forceinline__ void stage_rc(int b, int& R, int& C) { const int st = b / 1024, sb = b % 1024, swz = sb ^ (((sb >> 9) & 1) << 5); R = (st >> 1) * 16 + swz / 64; C = (st & 1) * 32 + (swz % 64) / 2; }
__host__ __device__ __forceinline__ int perm32(int rho) { const int n = rho >> 4, i = rho & 15; return 8 * (i >> 2) + 4 * n + (i & 3); }

struct Unit { int pm, pn; };
struct Gemm { const bf16_t* A; const bf16_t* Bt; int M, N, K; };

struct StaticOrder {
    int nM, nN, nwg, G, c;
    __host__ __device__ void init(int M, int N, int G_, int c_) { nM = M / BM; nN = N / BM; nwg = nM * nN; G = G_; c = c_; }
    __host__ __device__ bool next(int i, Unit& u) const {
        const long L = (long)i * G + c; if (L >= nwg) return false;
        int wgid = (int)L; { const int q = nwg / NXCD, r = nwg % NXCD, xcd = wgid % NXCD, off = wgid / NXCD; wgid = (xcd < r ? xcd * (q + 1) : r * (q + 1) + (xcd - r) * q) + off; }
        const int nig = WGM * nN, gid = wgid / nig, fm = gid * WGM, gsz = (nM - fm) < WGM ? (nM - fm) : WGM;
        u.pm = fm + ((wgid % nig) % gsz); u.pn = (wgid % nig) / gsz; return true;
    }
    __device__ __forceinline__ void a_ready(const Unit&) const {}
    __device__ __forceinline__ void done(const Unit&) const {}
};

__device__ __forceinline__ unsigned cvt_pk_bf16(float lo, float hi) { unsigned r; asm volatile("v_cvt_pk_bf16_f32 %0, %1, %2" : "=v"(r) : "v"(lo), "v"(hi)); return r; }
__device__ __forceinline__ float fast_sigmoid(float x) { return __builtin_amdgcn_rcpf(1.0f + __builtin_amdgcn_exp2f(-1.4426950408889634f * x)); }

struct EpiBf16 {
    static constexpr bool PERM = true, AFTER_DRAIN = false;
    bf16_t* O; int ldc;
    __device__ __forceinline__ void operator()(const f32x4 (&acc)[2][2][4][2], const Unit& u, int wr, int wc, int fr, int fq) const {
        const int row0 = u.pm * BM + wr * 64 + fr; const int col0 = u.pn * BM + wc * 32 + 8 * fq;
#pragma unroll
        for (int ai = 0; ai < 2; ++ai)
#pragma unroll
            for (int m = 0; m < 4; ++m) { bf16_t* rowp = O + (size_t)(row0 + ai * HALF + m * 16) * ldc + col0;
#pragma unroll
                for (int bj = 0; bj < 2; ++bj) { const f32x4 v0 = acc[ai][bj][m][0], v1 = acc[ai][bj][m][1];
                    u32x4 w; w.x = cvt_pk_bf16(v0[0], v0[1]); w.y = cvt_pk_bf16(v0[2], v0[3]); w.z = cvt_pk_bf16(v1[0], v1[1]); w.w = cvt_pk_bf16(v1[2], v1[3]);
                    *(u32x4*)(rowp + bj * HALF) = w; } }
    }
};
template <int ACT> struct EpiPair {
    static constexpr bool PERM = true, AFTER_DRAIN = false;
    bf16_t* O; int ldc; int coff;
    __device__ __forceinline__ void operator()(const f32x4 (&acc)[2][2][4][2], const Unit& u, int wr, int wc, int fr, int fq) const {
        const int row0 = u.pm * BM + wr * 64 + fr; const int col0 = coff + u.pn * HALF + wc * 32 + 8 * fq;
#pragma unroll
        for (int ai = 0; ai < 2; ++ai)
#pragma unroll
            for (int m = 0; m < 4; ++m) { bf16_t* rowp = O + (size_t)(row0 + ai * HALF + m * 16) * ldc + col0;
                float r[8];
#pragma unroll
                for (int n = 0; n < 2; ++n)
#pragma unroll
                    for (int j = 0; j < 4; ++j) { const float a = acc[ai][0][m][n][j], g = acc[ai][1][m][n][j];
                        r[n * 4 + j] = (ACT == 0) ? a * fast_sigmoid(a) * g : a * fast_sigmoid(g); }
                u32x4 w; w.x = cvt_pk_bf16(r[0], r[1]); w.y = cvt_pk_bf16(r[2], r[3]); w.z = cvt_pk_bf16(r[4], r[5]); w.w = cvt_pk_bf16(r[6], r[7]);
                *(u32x4*)rowp = w; }
    }
};
struct EpiResid {
    static constexpr bool PERM = false, AFTER_DRAIN = false;
    float* X; const float* gate0; int gstride; float s;
    __device__ __forceinline__ void operator()(const f32x4 (&acc)[2][2][4][2], const Unit& u, int wr, int wc, int fr, int fq) const {
        const int row0 = u.pm * BM + wr * 64 + fr, col0 = u.pn * BM + wc * 32 + 4 * fq;
        const int var = u.pm < 16 ? 0 : (u.pm < 20 ? 1 : 2);
        const float* gp = gate0 + (size_t)var * gstride + col0;
        f32x4 gv[2][2];
#pragma unroll
        for (int bj = 0; bj < 2; ++bj)
#pragma unroll
            for (int n = 0; n < 2; ++n) gv[bj][n] = *(const f32x4*)(gp + bj * HALF + n * 16) * s;
#pragma unroll
        for (int ai = 0; ai < 2; ++ai)
#pragma unroll
            for (int m = 0; m < 4; ++m) { float* rowp = X + (size_t)(row0 + ai * HALF + m * 16) * DM + col0;
#pragma unroll
                for (int bj = 0; bj < 2; ++bj)
#pragma unroll
                    for (int n = 0; n < 2; ++n) { float* p = rowp + bj * HALF + n * 16; const f32x4 x = *(const f32x4*)p; *(f32x4*)p = x + gv[bj][n] * acc[ai][bj][m][n]; } }
    }
};

template <class Epi, class Sched, bool ALIGN_EPI = false, bool SP2 = false>
__device__ __forceinline__ void gemm_phase(PG8_LAS unsigned char* lds, const Gemm g, const Sched& S, const Epi& E, int tid0) {
    int tid_ = tid0; asm volatile("" : "+v"(tid_));
    const int tid = tid_, wid = __builtin_amdgcn_readfirstlane(tid >> 6), lane = tid & 63, wr = wid >> 2, wc = wid & 3, fr = lane & 15, fq = lane >> 4;
    const int K = g.K, nt = K / BK;
    unsigned voffA[2], voffB[2];
#pragma unroll
    for (int i = 0; i < 2; ++i) { int R, C; stage_rc(tid * 16 + i * 8192, R, C); const int Rb = Epi::PERM ? ((R & ~31) + perm32(R & 31)) : R;
        voffA[i] = (unsigned)(R * K + C) * 2u; voffB[i] = (unsigned)(Rb * K + C) * 2u; }
    const size_t kstep = (size_t)(BK * 2);
    const size_t hstep = (size_t)HALF * K * 2;
    const size_t tstep = 2 * hstep;
    const unsigned ldsw = (unsigned)wid * 1024u;
    const int aoff = lds_byte(wr * 64 + fr, fq * 8), boff = lds_byte(wc * 32 + fr, fq * 8);
#define PG8_SA(b, h) (((b) * 2 + (h)) * HTB)
#define PG8_SB(b, h) ((4 + (b) * 2 + (h)) * HTB)
#define PG8_STAGE(bufoff, gbase, voff) do { _Pragma("unroll") for (int _i = 0; _i < 2; ++_i) \
        __builtin_amdgcn_global_load_lds((const unsigned*)((const char*)(gbase) + (voff)[_i]), (PG8_LAS unsigned*)(lds + (bufoff) + ldsw + _i * 8192), 16, 0, 0); } while (0)
#define PG8_LDA(dst, b, h) do { _Pragma("unroll") for (int m = 0; m < 4; ++m) _Pragma("unroll") for (int k = 0; k < 2; ++k) dst[m][k] = *(const PG8_LAS bf16x8*)(lds + PG8_SA(b, h) + aoff + m * 2048 + k * 1024); } while (0)
#define PG8_LDB(dst, b, h) do { _Pragma("unroll") for (int n = 0; n < 2; ++n) _Pragma("unroll") for (int k = 0; k < 2; ++k) dst[n][k] = *(const PG8_LAS bf16x8*)(lds + PG8_SB(b, h) + boff + n * 2048 + k * 1024); } while (0)
#define PG8_MMA(ai, bj, At, Bt) do { __builtin_amdgcn_s_setprio(1); _Pragma("unroll") for (int m = 0; m < 4; ++m) _Pragma("unroll") for (int n = 0; n < 2; ++n) _Pragma("unroll") for (int k = 0; k < 2; ++k) \
        acc[ai][bj][m][n] = __builtin_amdgcn_mfma_f32_16x16x32_bf16(Bt[n][k], At[m][k], acc[ai][bj][m][n], 0, 0, 0); __builtin_amdgcn_s_setprio(0); } while (0)
#define PG8_WAIT_V(n) asm volatile("s_waitcnt vmcnt(" #n ")" ::: "memory")
#define PG8_WAIT_L(n) asm volatile("s_waitcnt lgkmcnt(" #n ")" ::: "memory")
#define PG8_BAR __builtin_amdgcn_s_barrier()
#define PG8_SCHED __builtin_amdgcn_sched_barrier(0)
    Unit cur, nxt; int ui = 0;
    if (!S.next(0, cur)) return;
    f32x4 acc[2][2][4][2];
#pragma unroll
    for (int a = 0; a < 2; ++a)
#pragma unroll
        for (int b = 0; b < 2; ++b)
#pragma unroll
            for (int m = 0; m < 4; ++m)
#pragma unroll
                for (int n = 0; n < 2; ++n) acc[a][b][m][n] = (f32x4){0.f, 0.f, 0.f, 0.f};
    bf16x8 At[4][2], B0[2][2], B1[2][2];
    const char* cA = (const char*)g.A + (size_t)cur.pm * tstep; const char* cB = (const char*)g.Bt + (size_t)cur.pn * tstep;
    S.a_ready(cur);
    if constexpr (SP2) {
        PG8_STAGE(PG8_SB(0, 0), cB, voffB); PG8_STAGE(PG8_SB(0, 1), cB + hstep, voffB); PG8_STAGE(PG8_SA(0, 0), cA, voffA); PG8_STAGE(PG8_SA(0, 1), cA + hstep, voffA);
        if (wr == 1) PG8_BAR;
        PG8_WAIT_V(2); PG8_BAR;
        PG8_STAGE(PG8_SB(1, 0), cB + kstep, voffB); PG8_STAGE(PG8_SA(1, 0), cA + kstep, voffA); PG8_STAGE(PG8_SB(1, 1), cB + hstep + kstep, voffB);
        PG8_WAIT_V(6); PG8_BAR;
    } else {
        PG8_STAGE(PG8_SB(0, 0), cB, voffB); PG8_STAGE(PG8_SA(0, 0), cA, voffA); PG8_STAGE(PG8_SB(0, 1), cB + hstep, voffB); PG8_STAGE(PG8_SA(0, 1), cA + hstep, voffA);
        if (wr == 1) PG8_BAR;
        PG8_WAIT_V(4); PG8_BAR;
        PG8_STAGE(PG8_SB(1, 0), cB + kstep, voffB); PG8_STAGE(PG8_SA(1, 0), cA + kstep, voffA); PG8_STAGE(PG8_SB(1, 1), cB + hstep + kstep, voffB);
        PG8_WAIT_V(6); PG8_BAR;
    }
    for (;;) {
        const bool has_next = S.next(ui + 1, nxt);
        const char* nA = has_next ? (const char*)g.A + (size_t)nxt.pm * tstep : cA; const char* nB = has_next ? (const char*)g.Bt + (size_t)nxt.pn * tstep : cB;
        for (int t = 0; t < nt; t += 2) {
            const bool last = (t == nt - 2);
            const char* a1 = cA + (size_t)(t + 1) * kstep;
            const char* a2 = last ? nA : cA + (size_t)(t + 2) * kstep; const char* b2 = last ? nB : cB + (size_t)(t + 2) * kstep;
            const char* a3 = a2 + kstep; const char* b3 = b2 + kstep;
            if (last && has_next) S.a_ready(nxt);
            if constexpr (SP2) {
            PG8_LDB(B0, 0, 0); PG8_LDB(B1, 0, 1); PG8_SCHED; PG8_LDA(At, 0, 0); PG8_STAGE(PG8_SA(1, 1), a1 + hstep, voffA);
            PG8_WAIT_V(8); PG8_WAIT_L(0); PG8_BAR; PG8_MMA(0, 0, At, B0); PG8_MMA(0, 1, At, B1); PG8_BAR; PG8_SCHED;
            PG8_LDA(At, 0, 1); PG8_STAGE(PG8_SB(0, 0), b2, voffB); PG8_STAGE(PG8_SB(0, 1), b2 + hstep, voffB); PG8_STAGE(PG8_SA(0, 0), a2, voffA);
            PG8_WAIT_V(8); PG8_WAIT_L(0); PG8_BAR; PG8_MMA(1, 0, At, B0); PG8_MMA(1, 1, At, B1); PG8_BAR; PG8_SCHED;
            PG8_LDB(B0, 1, 0); PG8_LDB(B1, 1, 1); PG8_SCHED; PG8_LDA(At, 1, 0); PG8_STAGE(PG8_SA(0, 1), a2 + hstep, voffA);
            PG8_WAIT_V(8); PG8_WAIT_L(0); PG8_BAR; PG8_MMA(0, 0, At, B0); PG8_MMA(0, 1, At, B1); PG8_BAR; PG8_SCHED;
            PG8_LDA(At, 1, 1); PG8_STAGE(PG8_SB(1, 0), b3, voffB); PG8_STAGE(PG8_SB(1, 1), b3 + hstep, voffB); PG8_STAGE(PG8_SA(1, 0), a3, voffA);
            PG8_WAIT_V(8); PG8_WAIT_L(0); PG8_BAR; PG8_MMA(1, 0, At, B0); PG8_MMA(1, 1, At, B1); PG8_BAR; PG8_SCHED;
            } else {
            PG8_LDB(B0, 0, 0); PG8_SCHED; PG8_LDA(At, 0, 0); PG8_STAGE(PG8_SA(1, 1), a1 + hstep, voffA);
            PG8_WAIT_L(8); PG8_BAR; PG8_WAIT_L(0); PG8_MMA(0, 0, At, B0); PG8_BAR; PG8_SCHED;
            PG8_LDB(B1, 0, 1); PG8_STAGE(PG8_SB(0, 0), b2, voffB);
            PG8_BAR; PG8_WAIT_L(0); PG8_MMA(0, 1, At, B1); PG8_BAR;
            PG8_LDA(At, 0, 1); PG8_STAGE(PG8_SA(0, 0), a2, voffA);
            PG8_BAR; PG8_WAIT_L(0); PG8_MMA(1, 0, At, B0); PG8_BAR; PG8_SCHED;
            PG8_STAGE(PG8_SB(0, 1), b2 + hstep, voffB);
            PG8_WAIT_V(6); PG8_BAR; PG8_MMA(1, 1, At, B1); PG8_BAR;
            PG8_LDB(B0, 1, 0); PG8_SCHED; PG8_LDA(At, 1, 0); PG8_STAGE(PG8_SA(0, 1), a2 + hstep, voffA);
            PG8_WAIT_L(8); PG8_BAR; PG8_WAIT_L(0); PG8_MMA(0, 0, At, B0); PG8_BAR; PG8_SCHED;
            PG8_LDB(B1, 1, 1); PG8_STAGE(PG8_SB(1, 0), b3, voffB);
            PG8_BAR; PG8_WAIT_L(0); PG8_MMA(0, 1, At, B1); PG8_BAR;
            PG8_LDA(At, 1, 1); PG8_STAGE(PG8_SA(1, 0), a3, voffA);
            PG8_BAR; PG8_WAIT_L(0); PG8_MMA(1, 0, At, B0); PG8_BAR; PG8_SCHED;
            PG8_STAGE(PG8_SB(1, 1), b3 + hstep, voffB);
            PG8_WAIT_V(6); PG8_BAR; PG8_MMA(1, 1, At, B1); PG8_BAR;
            }
        }
        if constexpr (ALIGN_EPI) { if (wr == 0) PG8_BAR; }
        if constexpr (!Epi::AFTER_DRAIN) { E(acc, cur, wr, wc, fr, fq); S.done(cur); }
        if (!has_next) break;
#pragma unroll
        for (int a = 0; a < 2; ++a)
#pragma unroll
            for (int b = 0; b < 2; ++b)
#pragma unroll
                for (int m = 0; m < 4; ++m)
#pragma unroll
                    for (int n = 0; n < 2; ++n) acc[a][b][m][n] = (f32x4){0.f, 0.f, 0.f, 0.f};
        cur = nxt; cA = nA; cB = nB; ++ui;
        if constexpr (ALIGN_EPI) { if (wr == 1) PG8_BAR; }
    }
    PG8_WAIT_V(0);
    if constexpr (!ALIGN_EPI) { if (wr == 0) PG8_BAR; }
    PG8_BAR;
    if constexpr (Epi::AFTER_DRAIN) { E.fused(acc, cur, wr, wc, fr, fq, lds, wid, lane); S.done(cur); }
#undef PG8_SA
#undef PG8_SB
#undef PG8_STAGE
#undef PG8_LDA
#undef PG8_LDB
#undef PG8_MMA
#undef PG8_WAIT_V
#undef PG8_WAIT_L
#undef PG8_BAR
#undef PG8_SCHED
}
}

typedef unsigned short bf16;
typedef unsigned v4u __attribute__((ext_vector_type(4)));
typedef float f32x4 __attribute__((ext_vector_type(4)));
#define GAS __attribute__((address_space(1)))
#define LAS __attribute__((address_space(3)))
typedef GAS unsigned gu32;
#define RLX_AGENT __ATOMIC_RELAXED, __HIP_MEMORY_SCOPE_AGENT
#define LDS_WAIT() asm volatile("s_waitcnt lgkmcnt(0)" ::: "memory")
#define VM_WAIT() asm volatile("s_waitcnt vmcnt(0)" ::: "memory")

constexpr int NWAVES = 8;
#ifndef MIXER_NAIVE
#define MIXER_NAIVE 0
#endif
#ifndef MK_ONE_LAUNCH
#define MK_ONE_LAUNCH 0
#endif
constexpr size_t MiB = 1u << 20;
constexpr size_t WS_CTL = 0, CTL_ZERO_BYTES = 2 * MiB;
constexpr size_t WS_MOD = 1 * MiB;
constexpr size_t WS_COS = 2 * MiB, WS_SIN = 2 * MiB + 256 * 1024, WS_LAM = 2 * MiB + 512 * 1024, WS_BBAR = 3 * MiB;
constexpr size_t WS_WFI = 8 * MiB, WS_WFO = 184 * MiB, WS_WIN = 272 * MiB, WS_WOUT = 304 * MiB, WS_WGLU = 320 * MiB;
constexpr size_t WS_XR = 322 * MiB, WS_H = 370 * MiB, WS_ACT = 394 * MiB, WS_PROJ = 460 * MiB, WS_QB = 508 * MiB;
constexpr size_t WS_KP = 520 * MiB, WS_VP = 522 * MiB, WS_KS = 524 * MiB, WS_VS = 526 * MiB, WS_QR = 528 * MiB, WS_KR = 534 * MiB;
constexpr size_t WS_MIX = 540 * MiB, WS_YS = 564 * MiB, WS_YSB = 576 * MiB, WS_END = 582 * MiB;
constexpr int CW_BAR = 4096;
constexpr int RING_BYTES = 131072, LDSCTL_OFF = RING_BYTES, MISC_OFF = LDSCTL_OFF + 320, LDS_BYTES = 147456;

__device__ __forceinline__ unsigned f2bf(float f) { unsigned u = __builtin_bit_cast(unsigned, f); return (u + 0x7fffu + ((u >> 16) & 1u)) >> 16; }
__device__ __forceinline__ unsigned pk2(float lo, float hi) { return f2bf(lo) | (f2bf(hi) << 16); }
__device__ __forceinline__ float bf2f(unsigned short h) { return __builtin_bit_cast(float, (unsigned)h << 16); }
__device__ __forceinline__ float bflo(unsigned w) { return __builtin_bit_cast(float, w << 16); }
__device__ __forceinline__ float bfhi(unsigned w) { return __builtin_bit_cast(float, w & 0xffff0000u); }

#define XB_TMO      128
#define XB_XCNT(j)  (256  + 64 * (j))
#define XB_XSUB(j)  (1280 + 64 * (j))
#define XB_XGEN(j)  (2304 + 64 * (j))
#define XB_TOP      3328
#define XB_TOPGEN   3392
#define XCD_BAR_WORDS 3456
#define XB_SPIN_CAP (1u << 18)
__device__ __forceinline__ unsigned xb_ld(unsigned* p)              { return __hip_atomic_load(p, __ATOMIC_RELAXED, __HIP_MEMORY_SCOPE_AGENT); }
__device__ __forceinline__ unsigned xb_add(unsigned* p, unsigned v) { return __hip_atomic_fetch_add(p, v, __ATOMIC_RELAXED, __HIP_MEMORY_SCOPE_AGENT); }
__device__ __forceinline__ unsigned xb_xcc_id() { return (unsigned)__builtin_amdgcn_s_getreg((3 << 11) | 20) & 0xFu; }
#define XB_SPIN(cond, bar) do { unsigned _sp = 0; while (cond) { __builtin_amdgcn_s_sleep(1); \
    if ((++_sp & 255u) == 0u) { if (xb_ld(&(bar)[XB_TMO])) break; if (_sp > XB_SPIN_CAP) { atomicAdd(&(bar)[XB_TMO], 1u); break; } } } } while (0)
struct XcdBarrier { unsigned* bar; unsigned x; volatile LAS unsigned* st; };
__device__ __forceinline__ XcdBarrier xcd_barrier_post(unsigned* bar, volatile LAS unsigned* st) {
    XcdBarrier b; b.bar = bar; b.x = xb_xcc_id(); b.st = st;
    if (threadIdx.x == 0) (void)xb_add(&bar[XB_XCNT(b.x)], 1u);
    return b;
}
__device__ __forceinline__ void xcd_barrier_complete(unsigned* bar, unsigned x, unsigned& nloc, unsigned& nx) {
    const unsigned G = gridDim.x * gridDim.y * gridDim.z;
    unsigned sum, cnt, mine, sp = 0u;
    for (;;) {
        sum = 0u; cnt = 0u; mine = 0u;
#pragma unroll
        for (unsigned j = 0; j < 16; ++j) { const unsigned c = xb_ld(&bar[XB_XCNT(j)]); sum += c; cnt += (c > 0u) ? 1u : 0u; mine = (j == x) ? c : mine; }
        if (sum == G) break;
        __builtin_amdgcn_s_sleep(1);
        if ((++sp & 255u) == 0u) { if (xb_ld(&bar[XB_TMO])) break; if (sp > XB_SPIN_CAP) { atomicAdd(&bar[XB_TMO], 1u); break; } }
    }
    nloc = mine > 0u ? mine : 1u; nx = cnt > 0u ? cnt : 1u;
}
__device__ __forceinline__ void xcd_barrier(const XcdBarrier& b, int tid) {
    asm volatile("s_waitcnt vmcnt(0)" ::: "memory");
    __syncthreads();
    if (tid == 0) {
        unsigned* bar = b.bar; asm volatile("" : "+s"(bar));
        __builtin_amdgcn_s_waitcnt(0);
        unsigned nloc = b.st[0], nx = b.st[1];
        if (nloc == 0u) { xcd_barrier_complete(bar, b.x, nloc, nx); b.st[0] = nloc; b.st[1] = nx; }
        const unsigned old = xb_add(&bar[XB_XSUB(b.x)], 1u);
        const unsigned gen = old / nloc;
        if (old + 1u == (gen + 1u) * nloc) {
            __builtin_amdgcn_fence(__ATOMIC_RELEASE, "agent");
            asm volatile("s_waitcnt vmcnt(0)" ::: "memory");
            const unsigned og = xb_add(&bar[XB_TOP], 1u);
            const unsigned tg = og / nx;
            if (og + 1u == (tg + 1u) * nx) xb_add(&bar[XB_TOPGEN], 1u);
            else XB_SPIN(xb_ld(&bar[XB_TOPGEN]) == tg, bar);
            __builtin_amdgcn_fence(__ATOMIC_ACQUIRE, "agent");
            xb_add(&bar[XB_XGEN(b.x)], 1u);
            asm volatile("s_waitcnt vmcnt(0)" ::: "memory");
        } else {
            XB_SPIN(xb_ld(&bar[XB_XGEN(b.x)]) == gen, bar);
            __builtin_amdgcn_fence(__ATOMIC_ACQUIRE, "agent");
            asm volatile("s_waitcnt vmcnt(0)" ::: "memory");
        }
    }
    __syncthreads();
}

struct KArgs { const float* in[28]; float* out; unsigned char* ws; int ph_lo, ph_hi, li, pad; };
typedef const __attribute__((address_space(4))) KArgs* KA;
enum { I_XP = 0, I_XS, I_CK, I_CV, I_SSSM, I_SRET, I_C, I_CCTX, I_WMOD, I_BMOD, I_NORMG, I_WFI, I_WFO, I_WIN, I_WOUT, I_QNG, I_KNG,
       I_ARE, I_AIM, I_LOGDT, I_BRE, I_BIM, I_CRE, I_CIM, I_SSMD, I_WGLU, I_DECAY, I_FNG };

struct Frame {
    LAS unsigned char* lds;
    int tid, lane, wave, G, gw, NGW;
};

template <int O> __device__ __forceinline__ float shx(float v) { return __builtin_bit_cast(float, __builtin_amdgcn_ds_swizzle(__builtin_bit_cast(int, v), (O << 10) | 0x1f)); }
__device__ __forceinline__ float wave_sum(float v) {
    v += shx<1>(v); v += shx<2>(v); v += shx<4>(v); v += shx<8>(v); v += shx<16>(v);
    const auto rr = __builtin_amdgcn_permlane32_swap(__float_as_uint(v), __float_as_uint(v), false, false);
    return __uint_as_float(rr[0]) + __uint_as_float(rr[1]);
}
__device__ __forceinline__ float wave_max(float v) {
    v = fmaxf(v, shx<1>(v)); v = fmaxf(v, shx<2>(v)); v = fmaxf(v, shx<4>(v)); v = fmaxf(v, shx<8>(v)); v = fmaxf(v, shx<16>(v));
    const auto rr = __builtin_amdgcn_permlane32_swap(__float_as_uint(v), __float_as_uint(v), false, false);
    return fmaxf(__uint_as_float(rr[0]), __uint_as_float(rr[1]));
}
__device__ __forceinline__ float silu_f(float x) { return x / (1.0f + __expf(-x)); }
__device__ __forceinline__ float gelu_tanh(float x) { const float u = 0.7978845608028654f * (x + 0.044715f * x * x * x); return 0.5f * x * (1.0f + tanhf(u)); }

__device__ __forceinline__ void p0_transpose_item(const float* W, int K, int N, bf16* WT, int halfN, LAS float* scr, int item, int lane) {
    const int nblk = N / 32, kb = item / nblk, nb = item % nblk, k0 = 64 * kb, n0 = 32 * nb;
    int R0 = n0;
    if (halfN) { if (n0 < halfN) R0 = 256 * (n0 >> 7) + (n0 & 127); else { const int n1 = n0 - halfN; R0 = 256 * (n1 >> 7) + 128 + (n1 & 127); } }
#pragma unroll 8
    for (int i = 0; i < 32; ++i) { const int kk = 2 * i + (lane >> 5); scr[kk * 33 + (lane & 31)] = W[(size_t)(k0 + kk) * N + n0 + (lane & 31)]; }
    LDS_WAIT(); asm volatile("" ::: "memory");
    const int c = lane & 7;
#pragma unroll
    for (int j = 0; j < 4; ++j) { const int n = (lane >> 3) + 8 * j; const LAS float* s = scr + (8 * c) * 33 + n;
        v4u o; o.x = pk2(s[0 * 33], s[1 * 33]); o.y = pk2(s[2 * 33], s[3 * 33]); o.z = pk2(s[4 * 33], s[5 * 33]); o.w = pk2(s[6 * 33], s[7 * 33]);
        *(GAS v4u*)(WT + (size_t)(R0 + n) * K + k0 + 8 * c) = o; }
    LDS_WAIT(); asm volatile("" ::: "memory");
}

__device__ __forceinline__ void phase_prologue(const Frame& F, KA a, int parts = 15) {
    unsigned char* ws = a->ws;
    LAS float* cs = (LAS float*)(F.lds);
    LAS float* red = (LAS float*)(F.lds + 24576);
    if (parts & 1) {
    for (int i = F.tid; i < 3 * DM; i += 512) { const int v = i / DM, k = i % DM; const float c = v == 0 ? a->in[I_CCTX][k] : a->in[I_C][(v - 1) * DM + k]; cs[i] = silu_f(c); }
    __syncthreads();
    float* modb = (float*)(ws + WS_MOD);
    for (int task = blockIdx.x; task < 2 * 72 * 8; task += F.G) {
        const int l = task / 576, r = task % 576, cb = r / 8, kc = r % 8;
        const int kbase = kc * 256 + F.wave * 32, col = cb * 256 + F.lane * 4;
        const float* wp = a->in[I_WMOD] + ((size_t)l * DM + kbase) * MODW + col;
        f32x4 s0 = {0, 0, 0, 0}, s1 = s0, s2 = s0;
#pragma unroll 8
        for (int k = 0; k < 32; ++k) { const f32x4 w = *(const GAS f32x4*)(wp + (size_t)k * MODW);
            s0 += w * cs[kbase + k]; s1 += w * cs[DM + kbase + k]; s2 += w * cs[2 * DM + kbase + k]; }
        LAS float* rp = red + (F.wave * 64 + F.lane) * 12;
#pragma unroll
        for (int j = 0; j < 4; ++j) { rp[j] = s0[j]; rp[4 + j] = s1[j]; rp[8 + j] = s2[j]; }
        __syncthreads();
        for (int o = F.tid; o < 768; o += 512) { const int v = o >> 8, c = o & 255; float s = 0.f;
#pragma unroll
            for (int w = 0; w < 8; ++w) s += red[(w * 64 + (c >> 2)) * 12 + v * 4 + (c & 3)];
            if (kc == 0) s += a->in[I_BMOD][l * MODW + cb * 256 + c];
            unsafeAtomicAdd(modb + ((size_t)l * 3 + v) * MODW + cb * 256 + c, s); }
        __syncthreads();
    }
    }
    if (parts & 2) {
        float* cosT = (float*)(ws + WS_COS); float* sinT = (float*)(ws + WS_SIN);
        for (int i = blockIdx.x * 512 + F.tid; i < DSEQ * 64; i += F.G * 512) { const int t = i >> 6, j = i & 63, ax = j >> 5, f = j & 31;
            const float pos = (float)(ax == 0 ? (t >> 6) : (t & 63)); const float inv = powf(10000.0f, -(float)f / 32.0f); const float ang = pos * inv;
            float sn, cn; sincosf(ang, &sn, &cn); cosT[i] = cn; sinT[i] = sn; }
        float* lamT = (float*)(ws + WS_LAM); float* bbT = (float*)(ws + WS_BBAR);
        for (int i = blockIdx.x * 512 + F.tid; i < NLAYER * 2 * 32 * 64; i += F.G * 512) {
            const int ldg = i >> 6;
            const float dt = expf(a->in[I_LOGDT][ldg]); const float ar = a->in[I_ARE][i], ai = a->in[I_AIM][i];
            const float x = ar * dt, y = ai * dt; float sn, cn; sincosf(y, &sn, &cn); const float ex = expf(x);
            lamT[2 * i] = ex * cn; lamT[2 * i + 1] = ex * sn;
            const float sh = sinf(0.5f * y); const float nr = expm1f(x) * cn - 2.0f * sh * sh, ni = ex * sn;
            const float d2 = ar * ar + ai * ai; const float cr = (nr * ar + ni * ai) / d2, ci = (ni * ar - nr * ai) / d2;
#pragma unroll
            for (int j = 0; j < 16; ++j) { const float br = a->in[I_BRE][(size_t)i * 16 + j], bi = a->in[I_BIM][(size_t)i * 16 + j];
                bbT[((size_t)i * 16 + j) * 2] = cr * br - ci * bi; bbT[((size_t)i * 16 + j) * 2 + 1] = cr * bi + ci * br; }
        }
    }
    if (parts & 4) {
        GAS f32x4* xr = (GAS f32x4*)(ws + WS_XR);
        const GAS f32x4* xp = (const GAS f32x4*)a->in[I_XP]; const GAS f32x4* xs = (const GAS f32x4*)a->in[I_XS];
        const int NP4 = NPR * DM / 4, NT4 = MT * DM / 4;
        for (int i = blockIdx.x * 512 + F.tid; i < NT4; i += F.G * 512) xr[i] = i < NP4 ? xp[i] : xs[i - NP4];
    }
    if (parts & 8) {
        LAS float* scr = (LAS float*)(F.lds + 49152 + F.wave * 8704);
        constexpr int I_FI = (DM / 64) * (2 * DFF / 32), I_FO = (DFF / 64) * (DM / 32), I_IN = (DM / 64) * (INW / 32), I_OUT = (DM / 64) * (DM / 32), I_GL = (512 / 64) * (1024 / 32);
        constexpr int NITEMS = 4 * I_FI + 4 * I_FO + 2 * I_IN + 2 * I_OUT + 2 * I_GL;
        for (int it = F.gw; it < NITEMS; it += F.NGW) {
            int r = it;
            if (r < 4 * I_FI) { const int m = r / I_FI; p0_transpose_item(a->in[I_WFI] + (size_t)m * DM * 2 * DFF, DM, 2 * DFF, (bf16*)(ws + WS_WFI) + (size_t)m * 2 * DFF * DM, DFF, scr, r % I_FI, F.lane); continue; } r -= 4 * I_FI;
            if (r < 4 * I_FO) { const int m = r / I_FO; p0_transpose_item(a->in[I_WFO] + (size_t)m * DFF * DM, DFF, DM, (bf16*)(ws + WS_WFO) + (size_t)m * DM * DFF, 0, scr, r % I_FO, F.lane); continue; } r -= 4 * I_FO;
            if (r < 2 * I_IN) { const int m = r / I_IN; p0_transpose_item(a->in[I_WIN] + (size_t)m * DM * INW, DM, INW, (bf16*)(ws + WS_WIN) + (size_t)m * INW * DM, 0, scr, r % I_IN, F.lane); continue; } r -= 2 * I_IN;
            if (r < 2 * I_OUT) { const int m = r / I_OUT; p0_transpose_item(a->in[I_WOUT] + (size_t)m * DM * DM, DM, DM, (bf16*)(ws + WS_WOUT) + (size_t)m * DM * DM, 0, scr, r % I_OUT, F.lane); continue; } r -= 2 * I_OUT;
            { const int m = r / I_GL; p0_transpose_item(a->in[I_WGLU] + (size_t)m * 512 * 1024, 512, 1024, (bf16*)(ws + WS_WGLU) + (size_t)m * 1024 * 512, 512, scr, r % I_GL, F.lane); }
        }
    }
}

__device__ __forceinline__ void phase_prenorm(const Frame& F, KA a, int l, int sub) {
    unsigned char* ws = a->ws;
    const float* xr = (const float*)(ws + WS_XR);
    for (int m = F.gw; m < MT; m += F.NGW) {
        const GAS f32x4* xp = (const GAS f32x4*)(xr + (size_t)m * DM) + F.lane;
        f32x4 v[8]; float s = 0.f;
#pragma unroll
        for (int j = 0; j < 8; ++j) { v[j] = xp[64 * j]; s += (v[j].x * v[j].x + v[j].y * v[j].y) + (v[j].z * v[j].z + v[j].w * v[j].w); }
        const float rstd = 1.0f / sqrtf(wave_sum(s) * (1.0f / DM) + EPS);
        if (sub == 3) {
            const GAS f32x4* gp = (const GAS f32x4*)a->in[I_FNG] + F.lane; GAS f32x4* op = (GAS f32x4*)(a->out + O_Y + (size_t)m * DM) + F.lane;
#pragma unroll
            for (int j = 0; j < 8; ++j) op[64 * j] = v[j] * rstd * gp[64 * j];
        } else {
            const int var = m < NPR ? 0 : 1 + (m - NPR) / DSEQ;
            const float* mod = (const float*)(ws + WS_MOD) + ((size_t)l * 3 + var) * MODW + sub * 3 * DM;
            const GAS f32x4* gp = (const GAS f32x4*)(a->in[I_NORMG] + ((size_t)l * 3 + sub) * DM) + F.lane;
            const GAS f32x4* shp = (const GAS f32x4*)mod + F.lane; const GAS f32x4* scp = (const GAS f32x4*)(mod + DM) + F.lane;
            GAS unsigned long long* o8 = (GAS unsigned long long*)((bf16*)(ws + WS_H) + (size_t)m * DM) + F.lane;
#pragma unroll
            for (int j = 0; j < 8; ++j) { const f32x4 y = v[j] * rstd * gp[64 * j] * (scp[64 * j] + 1.0f) + shp[64 * j];
                o8[64 * j] = (unsigned long long)pk2(y.x, y.y) | ((unsigned long long)pk2(y.z, y.w) << 32); }
        }
    }
}

__device__ __forceinline__ void phase_qkvpost(const Frame& F, KA a, int l) {
    unsigned char* ws = a->ws;
    const bf16* proj = (const bf16*)(ws + WS_PROJ);
    const float* cosT = (const float*)(ws + WS_COS); const float* sinT = (const float*)(ws + WS_SIN);
    const int i = F.lane, e0 = (i & 31) + 64 * (i >> 5), e1 = e0 + 32;
    const int NT1 = MT * 20, NT2 = NBS * PAST * 2 * 2;
    for (int task = F.gw; task < NT1 + NT2; task += F.NGW) {
        if (task >= NT1) {
            const int r = task - NT1; const int isv = r & 1, kvh = (r >> 1) & 1, t = (r >> 2) % PAST, b = (r >> 2) / PAST;
            const float* src = a->in[isv ? I_CV : I_CK] + ((((size_t)b * NLAYER + l) * PAST + t) * 2 + kvh) * 128;
            bf16* dst = (bf16*)(ws + (isv ? WS_VS : WS_KS)) + ((size_t)b * KALL + t) * 256 + kvh * 128;
            dst[e0] = (bf16)f2bf(src[e0]); dst[e1] = (bf16)f2bf(src[e1]);
            continue;
        }
        const int m = task / 20, ch = task % 20;
        const bool lat = m >= NPR; const int b = lat ? (m - NPR) / DSEQ : m / SEQ, t = lat ? (m - NPR) % DSEQ : m % SEQ;
        int scol; if (ch < 8) scol = C_QA + ch * 128; else if (ch < 10) scol = C_KA + (ch - 8) * 128; else if (ch < 12) scol = C_VA + (ch - 10) * 128; else if (ch < 16) scol = C_QR + (ch - 12) * 128; else scol = C_KR + (ch - 16) * 128;
        const bf16* src = proj + (size_t)m * INW + scol;
        float x0 = bf2f(src[e0]), x1 = bf2f(src[e1]);
        if (ch < 10) {
            const float ss = wave_sum(x0 * x0 + x1 * x1); const float r = 1.0f / sqrtf(ss * (1.0f / 128.0f) + EPS);
            const float* g = a->in[ch < 8 ? I_QNG : I_KNG] + l * 128;
            x0 *= r * g[e0]; x1 *= r * g[e1];
        }
        if (ch >= 16) { x0 *= 0.08838834764831845f; x1 *= 0.08838834764831845f; }
        if (lat && (ch < 10 || ch >= 12)) {
            const float c = cosT[t * 64 + i], s = sinT[t * 64 + i];
            const float y0 = x0 * c - x1 * s, y1 = x1 * c + x0 * s; x0 = y0; x1 = y1;
        }
        if (ch < 8) { bf16* d = (bf16*)(ws + WS_QB) + (size_t)m * 1024 + ch * 128; d[e0] = (bf16)f2bf(x0); d[e1] = (bf16)f2bf(x1); }
        else if (ch < 12) {
            const int isv = ch >= 10, kvh = (ch - 8) & 1;
            if (!lat) {
                float* o = a->out + (isv ? O_CV : O_CK) + ((((size_t)b * NLAYER + l) * SEQ + t) * 2 + kvh) * 128; o[e0] = x0; o[e1] = x1;
                bf16* d = (bf16*)(ws + (isv ? WS_VP : WS_KP)) + (size_t)m * 256 + kvh * 128; d[e0] = (bf16)f2bf(x0); d[e1] = (bf16)f2bf(x1);
            } else {
                bf16* d = (bf16*)(ws + (isv ? WS_VS : WS_KS)) + ((size_t)b * KALL + PAST + t) * 256 + kvh * 128; d[e0] = (bf16)f2bf(x0); d[e1] = (bf16)f2bf(x1);
            }
        }
        else if (ch < 16) { bf16* d = (bf16*)(ws + WS_QR) + (size_t)m * 512 + (ch - 12) * 128; d[e0] = (bf16)f2bf(x0); d[e1] = (bf16)f2bf(x1); }
        else { bf16* d = (bf16*)(ws + WS_KR) + (size_t)m * 512 + (ch - 16) * 128; d[e0] = (bf16)f2bf(x0); d[e1] = (bf16)f2bf(x1); }
    }
}

namespace mx {
using bf16x8 = __attribute__((ext_vector_type(8))) short;
using s16x4  = __attribute__((ext_vector_type(4))) short;
using f32x16 = __attribute__((ext_vector_type(16))) float;
using f32x8  = __attribute__((ext_vector_type(8))) float;
using u32x4  = __attribute__((ext_vector_type(4))) unsigned;
constexpr int D = 128, NW = 8, QBLK = 32, KVBLK = 64;
constexpr float SCALE = 0.088388347648318440f;
constexpr float THR = 8.f;
constexpr int SHM_V = KVBLK * D * 2, SHM_K = KVBLK * D * 2;
#define KSWZ(row, colB) ((row) * 256 + ((colB) ^ (((row) & 7) << 4)))
#define SBAR() __builtin_amdgcn_sched_barrier(0)
__device__ __forceinline__ int crow(int r, int hi) { return (r & 3) + 8 * (r >> 2) + 4 * hi; }
__device__ __forceinline__ unsigned cvtpk(float lo, float hi) { unsigned r; asm volatile("v_cvt_pk_bf16_f32 %0, %1, %2" : "=v"(r) : "v"(lo), "v"(hi)); return r; }
__device__ __forceinline__ bf16x8 ld8(const bf16* p) { return *reinterpret_cast<const bf16x8*>(p); }
__device__ __forceinline__ bf16x8 cvt8(f32x8 x) { u32x4 w = {cvtpk(x[0], x[1]), cvtpk(x[2], x[3]), cvtpk(x[4], x[5]), cvtpk(x[6], x[7])}; return *reinterpret_cast<bf16x8*>(&w); }

__device__ __forceinline__ void partialSM(f32x16& p0, f32x16& p1, float& m_reg, float& mn, float& alpha) {
  constexpr float C = SCALE * 1.4426950408889634f;
  float pmax = p0[0]; for (int r = 1; r < 16; ++r) pmax = fmaxf(pmax, p0[r]); for (int r = 0; r < 16; ++r) pmax = fmaxf(pmax, p1[r]);
  { auto rr = __builtin_amdgcn_permlane32_swap(__float_as_uint(pmax), __float_as_uint(pmax), false, false);
    pmax = fmaxf(__uint_as_float(rr[0]), __uint_as_float(rr[1])); }
  if (__builtin_expect(__all(pmax - m_reg <= THR / SCALE), 1)) { mn = m_reg; alpha = 1.f; }
  else { mn = fmaxf(m_reg, pmax); alpha = __builtin_amdgcn_exp2f((m_reg - mn) * C); m_reg = mn; }
  float mnC = -mn * C;
  for (int r = 0; r < 16; ++r) p0[r] = fmaf(p0[r], C, mnC); for (int r = 0; r < 16; ++r) p1[r] = fmaf(p1[r], C, mnC);
  for (int r = 0; r < 16; ++r) p0[r] = __builtin_amdgcn_exp2f(p0[r]);
}
#define PK4(P, BASE, OUT) do { unsigned a0 = cvtpk(P[BASE + 0], P[BASE + 1]), a1 = cvtpk(P[BASE + 2], P[BASE + 3]);   \
    unsigned b0 = cvtpk(P[BASE + 4], P[BASE + 5]), b1 = cvtpk(P[BASE + 6], P[BASE + 7]);                              \
    auto r0 = __builtin_amdgcn_permlane32_swap(a0, b0, false, false); auto r1 = __builtin_amdgcn_permlane32_swap(a1, b1, false, false); \
    u32x4 w = {r0[0], r1[0], r0[1], r1[1]}; OUT = *reinterpret_cast<bf16x8*>(&w); } while (0)
__device__ __forceinline__ void finishSM(f32x16& p0, f32x16& p1, float alpha, float& l_reg, bf16x8& pa0, bf16x8& pa1, bf16x8& pa2, bf16x8& pa3) {
  for (int r = 0; r < 16; ++r) p1[r] = __builtin_amdgcn_exp2f(p1[r]);
  float ps = 0; for (int r = 0; r < 16; ++r) ps += p0[r]; for (int r = 0; r < 16; ++r) ps += p1[r];
  { auto rr = __builtin_amdgcn_permlane32_swap(__float_as_uint(ps), __float_as_uint(ps), false, false);
    ps = __uint_as_float(rr[0]) + __uint_as_float(rr[1]); }
  l_reg = l_reg * alpha + ps;
  PK4(p0, 0, pa0); PK4(p0, 8, pa1); PK4(p1, 0, pa2); PK4(p1, 8, pa3);
}
__device__ __forceinline__ void packP(f32x16& p0, f32x16& p1, bf16x8& pa0, bf16x8& pa1, bf16x8& pa2, bf16x8& pa3) {
  PK4(p0, 0, pa0); PK4(p0, 8, pa1); PK4(p1, 0, pa2); PK4(p1, 8, pa3);
}
__device__ __forceinline__ void decayP(f32x16& p0, f32x16& p1, int e0  , float lgf, float nlgb, bool diag) {
  const float eb = (float)e0;
#pragma unroll
  for (int r = 0; r < 16; ++r) { const float c = (float)((r & 3) + 8 * (r >> 2));
    const float ea = eb - c, ec = eb - 32.f - c;
    float da = __builtin_amdgcn_exp2f(fminf(ea * lgf, ea * nlgb)), dc = __builtin_amdgcn_exp2f(fminf(ec * lgf, ec * nlgb));
    if (diag) { da = ea == 0.f ? 2.f : da; dc = ec == 0.f ? 2.f : dc; }
    p0[r] *= da; p1[r] *= dc; }
}
__device__ __forceinline__ void qkt(f32x16& p0, f32x16& p1, const LAS char* Ks, const bf16x8* qr, int r32, int hi) {
  p0 = f32x16{}; p1 = f32x16{};
#pragma unroll
  for (int d0 = 0; d0 < 8; ++d0) { int cb = (d0 * 16 + hi * 8) * 2;
    bf16x8 b0 = *reinterpret_cast<const LAS bf16x8*>(Ks + KSWZ(r32, cb));
    bf16x8 b1 = *reinterpret_cast<const LAS bf16x8*>(Ks + KSWZ(32 + r32, cb));
    p0 = __builtin_amdgcn_mfma_f32_32x32x16_bf16(b0, qr[d0], p0, 0, 0, 0);
    p1 = __builtin_amdgcn_mfma_f32_32x32x16_bf16(b1, qr[d0], p1, 0, 0, 0); }
}
__device__ __forceinline__ int v_st(int k, int c) { const int kk = (k & ~0xC) | ((k & 4) << 1) | ((k & 8) >> 1); return ((kk >> 3) * 4 + (c >> 5)) * 512 + ((kk & 7) * 32 + (c & 31)) * 2; }
__device__ __forceinline__ int v_rd_base(int lane) { return ((lane & 3) << 3) | (((lane >> 2) & 3) << 6) | (((lane >> 4) & 1) << 5) | (((lane >> 5) & 1) << 8); }
constexpr int v_rd_off(int d0, int ks, int half) { return d0 * 512 + ks * 4096 + half * 2048; }
template <int OFF> __device__ __forceinline__ s16x4 tr_read(int vb) {
  s16x4 r; asm volatile("ds_read_b64_tr_b16 %0, %1 offset:%2" : "=&v"(r) : "v"(vb), "i"(OFF) : "memory"); return r;
}
#define PKLH(L, H) (bf16x8){L[0], L[1], L[2], L[3], H[0], H[1], H[2], H[3]}
template <int D0> __device__ __forceinline__ void pv_one(f32x16& od, int vb, bf16x8 pa0, bf16x8 pa1, bf16x8 pa2, bf16x8 pa3) {
  const s16x4 l0 = tr_read<v_rd_off(D0, 0, 0)>(vb), h0 = tr_read<v_rd_off(D0, 0, 1)>(vb), l1 = tr_read<v_rd_off(D0, 1, 0)>(vb), h1 = tr_read<v_rd_off(D0, 1, 1)>(vb);
  const s16x4 l2 = tr_read<v_rd_off(D0, 2, 0)>(vb), h2 = tr_read<v_rd_off(D0, 2, 1)>(vb), l3 = tr_read<v_rd_off(D0, 3, 0)>(vb), h3 = tr_read<v_rd_off(D0, 3, 1)>(vb);
  asm volatile("s_waitcnt lgkmcnt(0)" ::: "memory"); SBAR();
  od = __builtin_amdgcn_mfma_f32_32x32x16_bf16(pa0, PKLH(l0, h0), od, 0, 0, 0);
  od = __builtin_amdgcn_mfma_f32_32x32x16_bf16(pa1, PKLH(l1, h1), od, 0, 0, 0);
  od = __builtin_amdgcn_mfma_f32_32x32x16_bf16(pa2, PKLH(l2, h2), od, 0, 0, 0);
  od = __builtin_amdgcn_mfma_f32_32x32x16_bf16(pa3, PKLH(l3, h3), od, 0, 0, 0);
}
__device__ __forceinline__ void pv_d0(f32x16* o, int vb, bf16x8 pa0, bf16x8 pa1, bf16x8 pa2, bf16x8 pa3) {
  pv_one<0>(o[0], vb, pa0, pa1, pa2, pa3); pv_one<1>(o[1], vb, pa0, pa1, pa2, pa3); pv_one<2>(o[2], vb, pa0, pa1, pa2, pa3); pv_one<3>(o[3], vb, pa0, pa1, pa2, pa3);
}

template <bool GN> __device__ __forceinline__ void store_tile(const f32x16* o, const float* rowscale  , LAS float* stg, bf16* Ow, int ldo, const bf16* Gw, int ldg, int lane) {
  const int r32 = lane & 31, hi = lane >> 5;
#pragma unroll
  for (int r = 0; r < 16; ++r) { const int orow = crow(r, hi);
#pragma unroll
    for (int d0 = 0; d0 < 4; ++d0) stg[orow * 128 + d0 * 32 + r32] = rowscale ? o[d0][r] * rowscale[r] : o[d0][r]; }
  asm volatile("s_waitcnt lgkmcnt(0)" ::: "memory");
  const int ch = lane & 15;
#pragma unroll
  for (int i = 0; i < 8; ++i) { const int row = (lane >> 4) + 4 * i;
    f32x4 a = *(const LAS f32x4*)(stg + row * 128 + ch * 8), b = *(const LAS f32x4*)(stg + row * 128 + ch * 8 + 4);
    if (GN) {
      float s = (a[0] + a[1]) + (a[2] + a[3]) + (b[0] + b[1]) + (b[2] + b[3]);
      s += shx<1>(s); s += shx<2>(s); s += shx<4>(s); s += shx<8>(s);
      const float mean = s * (1.f / 128.f); a = a - mean; b = b - mean;
      float q = (a[0] * a[0] + a[1] * a[1]) + (a[2] * a[2] + a[3] * a[3]) + (b[0] * b[0] + b[1] * b[1]) + (b[2] * b[2] + b[3] * b[3]);
      q += shx<1>(q); q += shx<2>(q); q += shx<4>(q); q += shx<8>(q);
      const float rs = 1.0f / sqrtf(q * (1.f / 128.f) + EPS);
      const v4u gw = *(const GAS v4u*)(Gw + (size_t)row * ldg + ch * 8);
      const float g0 = bflo(gw.x), g1 = bfhi(gw.x), g2 = bflo(gw.y), g3 = bfhi(gw.y), g4 = bflo(gw.z), g5 = bfhi(gw.z), g6 = bflo(gw.w), g7 = bfhi(gw.w);
      a[0] *= rs * g0 * pg8::fast_sigmoid(g0); a[1] *= rs * g1 * pg8::fast_sigmoid(g1); a[2] *= rs * g2 * pg8::fast_sigmoid(g2); a[3] *= rs * g3 * pg8::fast_sigmoid(g3);
      b[0] *= rs * g4 * pg8::fast_sigmoid(g4); b[1] *= rs * g5 * pg8::fast_sigmoid(g5); b[2] *= rs * g6 * pg8::fast_sigmoid(g6); b[3] *= rs * g7 * pg8::fast_sigmoid(g7);
    }
    u32x4 w = {cvtpk(a[0], a[1]), cvtpk(a[2], a[3]), cvtpk(b[0], b[1]), cvtpk(b[2], b[3])};
    *(GAS u32x4*)(Ow + (size_t)row * ldo + ch * 8) = w; }
  asm volatile("s_waitcnt lgkmcnt(0)" ::: "memory");
}

template <bool RET, int LDQ, int LDK, int LDV, int LDO>
__device__ __forceinline__ void unit_body(const bf16* __restrict__ Qb, const bf16* __restrict__ Kh, const bf16* __restrict__ Vh, bf16* __restrict__ Ob, int seq, LAS char* lds,
                                          int q0  , float lgf, float lgb, const float* S0f, const float* S0b, const bf16* Gb  , int tid0) {
  int tid_ = tid0; asm volatile("" : "+v"(tid_));
  const int tid = tid_, wid = __builtin_amdgcn_readfirstlane(tid >> 6), lane = tid & 63, r32 = lane & 31, hi = lane >> 5;
  LAS char* V_lds = lds; LAS char* K_lds = lds + 2 * SHM_V;
  LAS float* wsf = (LAS float*)(lds + 2 * SHM_V + 2 * SHM_K) + wid * 64; LAS float* li_l = wsf; LAS float* al_l = wsf + 32;
  float m_reg = -1e30f, l_reg = 0; f32x16 o[4] = {}; bf16x8 qr[8];
  const bf16* Qw = Qb + (long)(wid * QBLK + r32) * LDQ + hi * 8;
#pragma unroll
  for (int d0 = 0; d0 < 8; ++d0) qr[d0] = ld8(Qw + d0 * 16);
  const int sr = tid >> 4, sc = (tid & 15) * 8, vst0 = v_st(sr, sc), vst1 = v_st(32 + sr, sc);
  const int vb0 = (int)(unsigned)(size_t)V_lds + v_rd_base(lane);
  const float nlgb = -lgb;
  const int trow = q0 + wid * QBLK + r32;

  if (RET && S0f != nullptr) {
    f32x16 o2[4];
#pragma unroll
    for (int pass = 0; pass < 2; ++pass) {
      const float* S0 = pass == 0 ? S0f : S0b;
#pragma unroll
      for (int half = 0; half < 2; ++half) {
        const f32x8 x0 = *reinterpret_cast<const f32x8*>(S0 + (size_t)(half * 64 + sr) * 128 + sc), x1 = *reinterpret_cast<const f32x8*>(S0 + (size_t)(half * 64 + 32 + sr) * 128 + sc);
        *(LAS bf16x8*)(V_lds + half * SHM_V + vst0) = cvt8(x0); *(LAS bf16x8*)(V_lds + half * SHM_V + vst1) = cvt8(x1);
      }
      __syncthreads();
      if (pass == 0) { pv_d0(o, vb0, qr[0], qr[1], qr[2], qr[3]); pv_d0(o, vb0 + SHM_V, qr[4], qr[5], qr[6], qr[7]); }
      else { for (int d = 0; d < 4; ++d) o2[d] = f32x16{}; pv_d0(o2, vb0, qr[0], qr[1], qr[2], qr[3]); pv_d0(o2, vb0 + SHM_V, qr[4], qr[5], qr[6], qr[7]); }
      __syncthreads();
    }
#pragma unroll
    for (int r = 0; r < 16; ++r) { const int t = q0 + wid * QBLK + crow(r, hi);
      const float wf = __builtin_amdgcn_exp2f((float)(t + 1) * lgf), wb = __builtin_amdgcn_exp2f((float)(seq - t) * lgb);
#pragma unroll
      for (int d = 0; d < 4; ++d) o[d][r] = o[d][r] * wf + o2[d][r] * wb; }
  }

  struct { bf16x8 vs0, vs1, ks0, ks1; } sr_[2];
#define SLOAD(i, k0) do { sr_[i].vs0 = ld8(&Vh[(long)((k0) + sr) * LDV + sc]); sr_[i].vs1 = ld8(&Vh[(long)((k0) + 32 + sr) * LDV + sc]); \
    sr_[i].ks0 = ld8(&Kh[(long)((k0) + sr) * LDK + sc]); sr_[i].ks1 = ld8(&Kh[(long)((k0) + 32 + sr) * LDK + sc]); } while (0)
#define SWRITE(b, i) do { *(LAS bf16x8*)(V_lds + (b) * SHM_V + vst0) = sr_[i].vs0;          \
    *(LAS bf16x8*)(V_lds + (b) * SHM_V + vst1) = sr_[i].vs1; int kc = sc * 2;               \
    *(LAS bf16x8*)(K_lds + (b) * SHM_K + KSWZ(sr, kc)) = sr_[i].ks0;                       \
    *(LAS bf16x8*)(K_lds + (b) * SHM_K + KSWZ(32 + sr, kc)) = sr_[i].ks1; } while (0)
#define SWAIT() asm volatile("s_waitcnt vmcnt(4)" ::: "memory")
#define RESC(a) do { if (!RET) { if (__any((a) < 1.f)) { if (hi == 0) al_l[r32] = (a); asm volatile("s_waitcnt lgkmcnt(0)" ::: "memory"); \
    for (int d = 0; d < 4; ++d) for (int r = 0; r < 16; ++r) o[d][r] *= al_l[crow(r, hi)]; } } } while (0)
#define SM1(P0, P1, MN, AL, TILE) do { if (RET) { const int k0_ = (TILE) * KVBLK; const bool dg_ = (k0_ <= q0 + wid * QBLK + 31) && (k0_ + 63 >= q0 + wid * QBLK); \
      decayP(P0, P1, trow - k0_ - 4 * hi, lgf, nlgb, dg_); } else partialSM(P0, P1, m_reg, MN, AL); } while (0)
#define SM2(P0, P1, AL) do { if (RET) packP(P0, P1, pa0, pa1, pa2, pa3); else finishSM(P0, P1, AL, l_reg, pa0, pa1, pa2, pa3); } while (0)
  f32x16 pA0, pA1, pB0, pB1; float mnA = 0.f, mnB = 0.f, alA = 1.f, alB = 1.f; bf16x8 pa0, pa1, pa2, pa3; const int NT = seq / KVBLK;
  constexpr int SE = 0, SO = 1;
  SLOAD(SE, 0); asm volatile("s_waitcnt vmcnt(0)" ::: "memory"); SWRITE(0, SE); __syncthreads();
  qkt(pA0, pA1, K_lds, qr, r32, hi); SM1(pA0, pA1, mnA, alA, 0);
  SLOAD(SO, KVBLK); if (2 < NT) SLOAD(SE, 2 * KVBLK);
  SWAIT(); SWRITE(1, SO); __syncthreads();
  for (int j = 1; j + 1 < NT; j += 2) {
    SBAR(); qkt(pB0, pB1, K_lds + SHM_K, qr, r32, hi);
    SM2(pA0, pA1, alA); SBAR();
    SLOAD(SO, (j + 2) * KVBLK); SBAR();
    pv_d0(o, vb0, pa0, pa1, pa2, pa3); SM1(pB0, pB1, mnB, alB, j);
    __syncthreads(); SWAIT(); SWRITE(0, SE);
    RESC(alB); __syncthreads();
    SBAR(); qkt(pA0, pA1, K_lds, qr, r32, hi);
    SM2(pB0, pB1, alB); SBAR();
    if (j + 3 < NT) SLOAD(SE, (j + 3) * KVBLK); SBAR();
    pv_d0(o, vb0 + (int)SHM_V, pa0, pa1, pa2, pa3); SM1(pA0, pA1, mnA, alA, j + 1);
    __syncthreads(); SWAIT(); SWRITE(1, SO);
    RESC(alA); __syncthreads();
  }
  SBAR(); qkt(pB0, pB1, K_lds + SHM_K, qr, r32, hi);
  SM2(pA0, pA1, alA); SBAR();
  pv_d0(o, vb0, pa0, pa1, pa2, pa3); SM1(pB0, pB1, mnB, alB, NT - 1);
  __syncthreads(); RESC(alB);
  SM2(pB0, pB1, alB); SBAR();
  pv_d0(o, vb0 + (int)SHM_V, pa0, pa1, pa2, pa3);
  float rli[16];
  if (!RET) {
    if (hi == 0) li_l[r32] = l_reg; asm volatile("s_waitcnt lgkmcnt(0)" ::: "memory");
#pragma unroll
    for (int r = 0; r < 16; ++r) rli[r] = __builtin_amdgcn_rcpf(li_l[crow(r, hi)]);
  }
  __syncthreads();
  LAS float* stg = (LAS float*)(lds + wid * 16384);
  store_tile<RET>(o, RET ? nullptr : rli, stg, Ob + (size_t)(wid * QBLK) * LDO, LDO, RET ? Gb + (size_t)(wid * QBLK) * INW : nullptr, INW, lane);
  __syncthreads();
#undef SLOAD
#undef SWRITE
#undef SWAIT
#undef RESC
#undef SM1
#undef SM2
}

__device__ __forceinline__ void ret_state_unit(const bf16* __restrict__ Kh  , const bf16* __restrict__ Vh  , float* __restrict__ outF, float* __restrict__ outB, float lgf, float lgb, LAS char* lds, int tid0) {
  int tid_ = tid0; asm volatile("" : "+v"(tid_));
  const int tid = tid_, wid = __builtin_amdgcn_readfirstlane(tid >> 6), lane = tid & 63, r32 = lane & 31, hi = lane >> 5;
  const int sr = tid >> 4, sc = (tid & 15) * 8, vst0 = v_st(sr, sc), vst1 = v_st(32 + sr, sc);
  LAS char* KF = lds; LAS char* KB = lds + 16384; LAS char* VV = lds + 32768;
  const int dir = wid >> 2, Dd = wid & 3;
  const int ab = (int)(unsigned)(size_t)(dir ? KB : KF) + v_rd_base(lane) + Dd * 512;
  const int bb = (int)(unsigned)(size_t)VV + v_rd_base(lane);
  f32x16 acc[4] = {};
  for (int tile = 0; tile < SEQ / 64; ++tile) {
    const int s0 = tile * 64 + sr, s1 = s0 + 32;
    const bf16x8 k0 = ld8(Kh + (size_t)s0 * 512 + sc), k1 = ld8(Kh + (size_t)s1 * 512 + sc), v0 = ld8(Vh + (size_t)s0 * INW + sc), v1 = ld8(Vh + (size_t)s1 * INW + sc);
    const float wf0 = exp2f((float)(SEQ - 1 - s0) * lgf), wf1 = exp2f((float)(SEQ - 1 - s1) * lgf), wb0 = exp2f((float)s0 * lgb), wb1 = exp2f((float)s1 * lgb);
    f32x8 x0, x1;
#pragma unroll
    for (int j = 0; j < 8; ++j) { x0[j] = bf2f((unsigned short)k0[j]); x1[j] = bf2f((unsigned short)k1[j]); }
    *(LAS bf16x8*)(KF + vst0) = cvt8(x0 * wf0); *(LAS bf16x8*)(KF + vst1) = cvt8(x1 * wf1);
    *(LAS bf16x8*)(KB + vst0) = cvt8(x0 * wb0); *(LAS bf16x8*)(KB + vst1) = cvt8(x1 * wb1);
    *(LAS bf16x8*)(VV + vst0) = v0; *(LAS bf16x8*)(VV + vst1) = v1;
    __syncthreads();
#define RS_STEP(KS) do { const s16x4 al = tr_read<v_rd_off(0, KS, 0)>(ab), ah = tr_read<v_rd_off(0, KS, 1)>(ab); \
      const s16x4 l0 = tr_read<v_rd_off(0, KS, 0)>(bb), h0 = tr_read<v_rd_off(0, KS, 1)>(bb), l1 = tr_read<v_rd_off(1, KS, 0)>(bb), h1 = tr_read<v_rd_off(1, KS, 1)>(bb); \
      const s16x4 l2 = tr_read<v_rd_off(2, KS, 0)>(bb), h2 = tr_read<v_rd_off(2, KS, 1)>(bb), l3 = tr_read<v_rd_off(3, KS, 0)>(bb), h3 = tr_read<v_rd_off(3, KS, 1)>(bb); \
      asm volatile("s_waitcnt lgkmcnt(0)" ::: "memory"); SBAR(); const bf16x8 af = PKLH(al, ah); \
      acc[0] = __builtin_amdgcn_mfma_f32_32x32x16_bf16(af, PKLH(l0, h0), acc[0], 0, 0, 0); acc[1] = __builtin_amdgcn_mfma_f32_32x32x16_bf16(af, PKLH(l1, h1), acc[1], 0, 0, 0); \
      acc[2] = __builtin_amdgcn_mfma_f32_32x32x16_bf16(af, PKLH(l2, h2), acc[2], 0, 0, 0); acc[3] = __builtin_amdgcn_mfma_f32_32x32x16_bf16(af, PKLH(l3, h3), acc[3], 0, 0, 0); } while (0)
    RS_STEP(0); RS_STEP(1); RS_STEP(2); RS_STEP(3);
#undef RS_STEP
    __syncthreads();
  }
  float* out = dir ? outB : outF;
#pragma unroll
  for (int r = 0; r < 16; ++r) { const int d = Dd * 32 + crow(r, hi);
#pragma unroll
    for (int e = 0; e < 4; ++e) out[(size_t)d * 128 + e * 32 + r32] = acc[e][r]; }
}

using f32x4m = __attribute__((ext_vector_type(4))) float;
template <bool OUT>
__device__ __forceinline__ void s5_seg(KA a, int l, int m0, int t_lo, int len, int g, int dir, float& hr, float& hi_, LAS char* wl, int lane) {
  unsigned char* ws = a->ws;
  const bf16* proj = (const bf16*)(ws + WS_PROJ);
  float* YS = (float*)(ws + WS_YS); bf16* YSB = (bf16*)(ws + WS_YSB);
  const int r32 = lane & 31, hi = lane >> 5, fr = lane & 15, q = lane >> 4;
  LAS float* BU = (LAS float*)wl;
  const int ldg = (l * 2 + dir) * 32 + g;
  const float* lamT = (const float*)(ws + WS_LAM) + ((size_t)ldg * 64 + lane) * 2;
  const float lr = lamT[0], li = lamT[1];
  bf16x8 bfr[4], cfr[4]; float dcoef = 0.f;
  {
    const float* bbT = (const float*)(ws + WS_BBAR);
#pragma unroll
    for (int tile = 0; tile < 4; ++tile) { const int p = 32 * (tile & 1) + r32, part = tile >> 1; f32x8 x;
#pragma unroll
      for (int j = 0; j < 8; ++j) x[j] = bbT[(((size_t)ldg * 64 + p) * 16 + 8 * hi + j) * 2 + part];
      bfr[tile] = cvt8(x); }
    if (OUT) {
      dcoef = a->in[I_SSMD][l * 512 + g * 16 + fr];
      const float* cre = a->in[I_CRE] + ((size_t)ldg * 16 + fr) * 64; const float* cim = a->in[I_CIM] + ((size_t)ldg * 16 + fr) * 64;
#pragma unroll
      for (int ks = 0; ks < 4; ++ks) { f32x8 x;
#pragma unroll
        for (int j = 0; j < 8; ++j) { const int p = 16 * ks + 4 * q + (j >> 1); x[j] = (j & 1) ? -cim[p] : cre[p]; }
        cfr[ks] = cvt8(x); }
    }
  }
  const int NC = len / 32;
  const bf16* ubase = proj + (size_t)m0 * INW + C_US + g * 16;
#define S5_T0(c) (dir == 0 ? t_lo + 32 * (c) : t_lo + len - 32 * ((c) + 1))
  bf16x8 ua_next = ld8(ubase + (size_t)(S5_T0(0) + r32) * INW + 8 * hi);
  for (int c = 0; c < NC; ++c) {
    const int T0 = S5_T0(c);
    const bf16x8 ua = ua_next;
    if (c + 1 < NC) ua_next = ld8(ubase + (size_t)(S5_T0(c + 1) + r32) * INW + 8 * hi);
    float ysv[8]; unsigned short uv[8];
    if (OUT && dir == 0) {
#pragma unroll
      for (int k = 0; k < 8; ++k) { const size_t m = (size_t)(m0 + T0 + 16 * (k >> 2) + 4 * q + (k & 3)); ysv[k] = YS[m * 512 + g * 16 + fr]; uv[k] = proj[m * INW + C_US + g * 16 + fr]; }
    }
#pragma unroll
    for (int tile = 0; tile < 4; ++tile) {
      const f32x16 d = __builtin_amdgcn_mfma_f32_32x32x16_bf16(ua, bfr[tile], f32x16{}, 0, 0, 0);
#pragma unroll
      for (int r = 0; r < 16; ++r) BU[crow(r, hi) * 128 + tile * 32 + r32] = d[r];
    }
    asm volatile("s_waitcnt lgkmcnt(0)" ::: "memory");
#pragma unroll
    for (int half = 0; half < 2; ++half) {
      float bre[16], bim[16];
#pragma unroll
      for (int k = 0; k < 16; ++k) { const int i = dir == 0 ? half * 16 + k : 31 - half * 16 - k; bre[k] = BU[i * 128 + lane]; bim[k] = BU[i * 128 + 64 + lane]; }
      asm volatile("s_waitcnt lgkmcnt(0)" ::: "memory");
#pragma unroll
      for (int k = 0; k < 16; ++k) { const int i = dir == 0 ? half * 16 + k : 31 - half * 16 - k;
        const float nr = lr * hr - li * hi_ + bre[k], ni = lr * hi_ + li * hr + bim[k]; hr = nr; hi_ = ni;
        if (OUT) ((LAS unsigned*)BU)[i * 128 + (lane ^ (4 * (i & 15)))] = cvtpk(hr, hi_); }
    }
    if (OUT) {
      asm volatile("s_waitcnt lgkmcnt(0)" ::: "memory");
#pragma unroll
      for (int mt = 0; mt < 2; ++mt) {
        f32x4m y = {0.f, 0.f, 0.f, 0.f};
#pragma unroll
        for (int ks = 0; ks < 4; ++ks) { const int i = 16 * mt + fr;
          const bf16x8 hf = *(const LAS bf16x8*)((LAS unsigned*)BU + i * 128 + ((16 * ks + 4 * q) ^ (4 * (i & 15))));
          y = __builtin_amdgcn_mfma_f32_16x16x32_bf16(hf, cfr[ks], y, 0, 0, 0); }
#pragma unroll
        for (int rg = 0; rg < 4; ++rg) { const int i = 16 * mt + 4 * q + rg; const size_t m = (size_t)(m0 + T0 + i);
          if (dir == 1) YS[m * 512 + g * 16 + fr] = y[rg];
          else { const float yt = y[rg] + ysv[mt * 4 + rg] + dcoef * bf2f(uv[mt * 4 + rg]);
            YSB[m * 512 + g * 16 + fr] = (bf16)f2bf(gelu_tanh(yt)); } }
      }
    }
    asm volatile("s_waitcnt lgkmcnt(0)" ::: "memory");
  }
#undef S5_T0
}
__device__ __forceinline__ void s5_ctx_wave(KA a, int l, int b, int g, LAS char* lds, int tid0) {
  int tid_ = tid0; asm volatile("" : "+v"(tid_));
  const int lane = tid_ & 63; LAS char* wl = lds + __builtin_amdgcn_readfirstlane(tid_ >> 6) * 16384;
#pragma unroll 1
  for (int dir = 1; dir >= 0; --dir) {
    float hr = 0.f, hi_ = 0.f;
    s5_seg<true>(a, l, b * SEQ, 0, SEQ, g, dir, hr, hi_, wl, lane);
    float* o = a->out + O_SSM + (((((size_t)b * NLAYER + l) * 2 + dir) * 32 + g) * 64 + lane) * 2; o[0] = hr; o[1] = hi_;
  }
}
constexpr int S5X_OFF = RING_BYTES + 1024;
__device__ __forceinline__ void s5_lat_unit(KA a, int l, int v  , LAS char* lds, int tid0) {
  int tid_ = tid0; asm volatile("" : "+v"(tid_));
  const int lane = tid_ & 63, wid = __builtin_amdgcn_readfirstlane(tid_ >> 6); LAS char* wl = lds + wid * 16384;
  const int pr = wid >> 2, seg = wid & 3, bg = 2 * v + pr, b = bg >> 5, g = bg & 31;
  const int m0 = NPR + b * DSEQ;
  LAS float* X = (LAS float*)(lds + S5X_OFF);
#pragma unroll 1
  for (int dir = 1; dir >= 0; --dir) {
    float hr = 0.f, hi_ = 0.f;
    const bool last = dir == 0 ? seg == 3 : seg == 0;
    if (!last) s5_seg<false>(a, l, m0, seg * 256, 256, g, dir, hr, hi_, wl, lane);
    X[(((pr * 2 + dir) * 4 + seg) * 64 + lane) * 2] = hr; X[(((pr * 2 + dir) * 4 + seg) * 64 + lane) * 2 + 1] = hi_;
  }
  __syncthreads();
#pragma unroll 1
  for (int dir = 1; dir >= 0; --dir) {
    const int ldg = (l * 2 + dir) * 32 + g;
    const float* lamT = (const float*)(a->ws + WS_LAM) + ((size_t)ldg * 64 + lane) * 2;
    float pr_ = lamT[0], pi_ = lamT[1];
#pragma unroll
    for (int k = 0; k < 8; ++k) { const float nr = pr_ * pr_ - pi_ * pi_, ni = 2.f * pr_ * pi_; pr_ = nr; pi_ = ni; }
    const float* h0 = a->in[I_SSSM] + (((((size_t)b * NLAYER + l) * 2 + dir) * 32 + g) * 64 + lane) * 2;
    float hr = h0[0], hi_ = h0[1];
    const int nprev = dir == 0 ? seg : 3 - seg;
    for (int k = 0; k < nprev; ++k) { const int sk = dir == 0 ? k : 3 - k;
      const float fr_ = X[(((pr * 2 + dir) * 4 + sk) * 64 + lane) * 2], fi_ = X[(((pr * 2 + dir) * 4 + sk) * 64 + lane) * 2 + 1];
      const float nr = pr_ * hr - pi_ * hi_ + fr_, ni = pr_ * hi_ + pi_ * hr + fi_; hr = nr; hi_ = ni; }
    s5_seg<true>(a, l, m0, seg * 256, 256, g, dir, hr, hi_, wl, lane);
  }
}
#undef KSWZ
#undef SBAR
#undef PK4
#undef PKLH
}

__device__ __forceinline__ void decay_log2(KA a, int l, int h, float& lgf, float& lgb) {
    const float xf = a->in[I_DECAY][(l * 2 + 0) * 4 + h], xb = a->in[I_DECAY][(l * 2 + 1) * 4 + h];
    lgf = -log1pf(expf(-xf)) * 1.4426950408889634f; lgb = -log1pf(expf(-xb)) * 1.4426950408889634f;
}

constexpr int MX_NBIG = 128, MX_NUNITS = 448;
__device__ __forceinline__ void mixer_unit(const Frame& F, KA a, int l, int u) {
  unsigned char* ws = a->ws; LAS char* lds = (LAS char*)F.lds;
  const bf16* proj = (const bf16*)(ws + WS_PROJ);
  int kind, lat, b, h = 0, qb = 0, v;
  const int wv_ = F.wave;
  if (u < 64) { kind = 0; lat = 1; qb = u & 3; h = (u >> 2) & 7; b = u >> 5; }
  else if (u < 96) { v = u - 64; kind = 1; lat = 1; qb = v & 3; h = (v >> 2) & 3; b = v >> 4; }
  else if (u < 128) { v = u - 96; kind = 2; lat = 1; b = 0; h = v; }
  else if (u < 256) { v = u - 128; kind = 0; lat = 0; h = v & 7; b = v >> 3; }
  else if (u < 320) { v = u - 256; kind = 1; lat = 0; h = v & 3; b = v >> 2; }
  else if (u < 384) { v = (u - 320) * 8 + wv_; kind = 2; lat = 0; b = v >> 5; h = v & 31; }
  else { v = u - 384; kind = 3; lat = 0; h = v & 3; b = v >> 2; }
  const size_t m0 = lat ? NPR + (size_t)b * DSEQ : (size_t)b * SEQ;
  const size_t m = m0 + (size_t)qb * 256;
  const int L = lat ? DSEQ : SEQ;
#ifndef MXK
#define MXK 15
#endif
  if (kind == 0) { if (MXK & 1) {
    const bf16* Kb = lat ? (const bf16*)(ws + WS_KS) + (size_t)b * KALL * 256 : (const bf16*)(ws + WS_KP) + m0 * 256;
    const bf16* Vb = lat ? (const bf16*)(ws + WS_VS) + (size_t)b * KALL * 256 : (const bf16*)(ws + WS_VP) + m0 * 256;
    mx::unit_body<false, 1024, 256, 256, DM>((const bf16*)(ws + WS_QB) + m * 1024 + h * 128, Kb + (h >> 2) * 128, Vb + (h >> 2) * 128, (bf16*)(ws + WS_MIX) + m * DM + h * 128,
        lat ? KALL : SEQ, lds, 0, 0.f, 0.f, nullptr, nullptr, nullptr, F.tid); }
  } else if (kind == 1) { if (MXK & 2) {
    float lgf, lgb; decay_log2(a, l, h, lgf, lgb);
    const float* S0f = lat ? a->in[I_SRET] + ((((size_t)b * NLAYER + l) * 2 + 0) * 4 + h) * 16384 : nullptr;
    const float* S0b = lat ? a->in[I_SRET] + ((((size_t)b * NLAYER + l) * 2 + 1) * 4 + h) * 16384 : nullptr;
    mx::unit_body<true, 512, 512, INW, DM>((const bf16*)(ws + WS_QR) + m * 512 + h * 128, (const bf16*)(ws + WS_KR) + m0 * 512 + h * 128, proj + m0 * INW + C_VR + h * 128,
        (bf16*)(ws + WS_MIX) + m * DM + 1536 + h * 128, L, lds, qb * 256, lgf, lgb, S0f, S0b, proj + m * INW + C_GR + h * 128, F.tid); }
  } else if (kind == 2) { if (MXK & 4)
    if (lat) mx::s5_lat_unit(a, l, h, lds, F.tid); else mx::s5_ctx_wave(a, l, b, h, lds, F.tid);
  } else if (MXK & 8) {
    float lgf, lgb; decay_log2(a, l, h, lgf, lgb);
    float* oF = a->out + O_RET + ((((size_t)b * NLAYER + l) * 2 + 0) * 4 + h) * 16384; float* oB = a->out + O_RET + ((((size_t)b * NLAYER + l) * 2 + 1) * 4 + h) * 16384;
    mx::ret_state_unit((const bf16*)(ws + WS_KR) + m0 * 512 + h * 128, proj + m0 * INW + C_VR + h * 128, oF, oB, lgf, lgb, lds, F.tid);
  }
}
__device__ __forceinline__ void phase_mixer(const Frame& F, KA a, int l) {
  const int w = blockIdx.x;
  if (F.G == 256) {
    if (w < MX_NBIG) { mixer_unit(F, a, l, w); __syncthreads(); }
    else { for (int u = w; u < MX_NUNITS; u += 256 - MX_NBIG) { mixer_unit(F, a, l, u); __syncthreads(); } }
  } else { for (int u = w; u < MX_NUNITS; u += F.G) { mixer_unit(F, a, l, u); __syncthreads(); } }
}

constexpr int N_PHASES = 26;

template <class Epi> __device__ __forceinline__ void run_gemm(const Frame& F, const bf16* A, const bf16* Bt, int N, int K, const Epi& E) {
    pg8::Gemm g{A, Bt, MT, N, K}; pg8::StaticOrder S; S.init(MT, N, F.G, (int)blockIdx.x);
    pg8::gemm_phase<Epi, pg8::StaticOrder, true, true>(F.lds, g, S, E, F.tid);
}

__device__ __forceinline__ int cur_tid(int widS) { unsigned z = 0; asm volatile("" : "+s"(z)); const int lane = (int)__builtin_amdgcn_mbcnt_hi(~0u, __builtin_amdgcn_mbcnt_lo(~0u, z)); return widS * 64 + lane; }
__device__ __forceinline__ Frame mkframe(LAS unsigned char* lds, int widS) {
    Frame F; F.tid = cur_tid(widS);
    F.lds = lds; F.lane = F.tid & 63; F.wave = widS;
    F.G = gridDim.x; F.gw = blockIdx.x * NWAVES + F.wave; F.NGW = F.G * NWAVES; return F;
}
#define FR mkframe((LAS unsigned char*)lds, widS)
__global__ void __launch_bounds__(NWAVES * 64, 2) trunk_fwd(KArgs args) {
    extern __shared__ __attribute__((aligned(16))) unsigned char lds[];
    const int widS = __builtin_amdgcn_readfirstlane((int)threadIdx.x >> 6);
    volatile LAS unsigned* MISC = (volatile LAS unsigned*)((LAS unsigned char*)lds + MISC_OFF);
    for (int u = threadIdx.x; u < (LDS_BYTES - LDSCTL_OFF) / 4; u += NWAVES * 64) ((LAS unsigned*)((LAS unsigned char*)lds + LDSCTL_OFF))[u] = 0u;
    __syncthreads();
    unsigned* ctl = (unsigned*)(args.ws + WS_CTL);
    XcdBarrier bar; bar.bar = ctl + CW_BAR; bar.x = 0; bar.st = nullptr;
    const bool multi = (args.ph_hi - args.ph_lo) > 1;
    if (multi) bar = xcd_barrier_post(ctl + CW_BAR, MISC + 8);

    for (int ph = args.ph_lo; ph < args.ph_hi; ++ph) {
        KA ap; { unsigned long long p_ = (unsigned long long)__builtin_amdgcn_kernarg_segment_ptr(); asm volatile("" : "+s"(p_)); ap = (KA)p_; }
        unsigned char* ws = ap->ws;
#ifndef PH_MASK
#define PH_MASK 0xFFFF
#endif
#ifndef DUP_MASK
#define DUP_MASK 0
#endif
#define DUPB(bit, stmt) for (int rep_ = (DUP_MASK & (bit)) ? 0 : 1; rep_ < 2; ++rep_) { stmt; if (rep_ == 0) xcd_barrier(bar, cur_tid(widS)); }
        if (ph == 0) { if (DUP_MASK & 1) { phase_prologue(FR, ap, 8); xcd_barrier(bar, cur_tid(widS)); } if (DUP_MASK & 512) { phase_prologue(FR, ap, 4); xcd_barrier(bar, cur_tid(widS)); } if (PH_MASK & 1) phase_prologue(FR, ap); }
        else if (ph == N_PHASES - 1) { DUPB(2, phase_prenorm(FR, ap, 0, 3)) }
        else {
            const int l = (ph - 1) / 12, s = (ph - 1) % 12;
            const float* modl = (const float*)(ws + WS_MOD) + (size_t)l * 3 * MODW;
            switch (s) {
                case 0: DUPB(2, phase_prenorm(FR, ap, l, 0)); break;
                case 3: DUPB(2, phase_prenorm(FR, ap, l, 1)); break;
                case 9: DUPB(2, phase_prenorm(FR, ap, l, 2)); break;
                case 1: case 10: {
                    const int i = s == 1 ? 0 : 1;
                    pg8::EpiPair<0> E{(bf16*)(ws + WS_ACT), DFF, 0};
                    DUPB(4, run_gemm(FR, (const bf16*)(ws + WS_H), (const bf16*)(ws + WS_WFI) + (size_t)(l * 2 + i) * 2 * DFF * DM, 2 * DFF, DM, E)); break; }
                case 2: case 11: {
                    const int i = s == 2 ? 0 : 1, sub = s == 2 ? 0 : 2;
                    pg8::EpiResid E{(float*)(ws + WS_XR), modl + sub * 3 * DM + 2 * DM, MODW, 0.5f};
                    DUPB(8, { pg8::EpiResid E0 = E; if (rep_ == 0) E0.s = 0.f; run_gemm(FR, (const bf16*)(ws + WS_ACT), (const bf16*)(ws + WS_WFO) + (size_t)(l * 2 + i) * DM * DFF, DM, DFF, E0); }); break; }
                case 4: {
                    pg8::EpiBf16 E{(bf16*)(ws + WS_PROJ), INW};
                    DUPB(16, run_gemm(FR, (const bf16*)(ws + WS_H), (const bf16*)(ws + WS_WIN) + (size_t)l * INW * DM, INW, DM, E)); break; }
                case 5: DUPB(32, phase_qkvpost(FR, ap, l)); break;
                case 6: DUPB(64, phase_mixer(FR, ap, l)); break;
                case 7: {
                    pg8::EpiPair<1> E{(bf16*)(ws + WS_MIX), DM, 1024};
                    DUPB(128, run_gemm(FR, (const bf16*)(ws + WS_YSB), (const bf16*)(ws + WS_WGLU) + (size_t)l * 1024 * 512, 1024, 512, E)); break; }
                case 8: {
                    pg8::EpiResid E{(float*)(ws + WS_XR), modl + 1 * 3 * DM + 2 * DM, MODW, 1.0f};
                    DUPB(256, { pg8::EpiResid E0 = E; if (rep_ == 0) E0.s = 0.f; run_gemm(FR, (const bf16*)(ws + WS_MIX), (const bf16*)(ws + WS_WOUT) + (size_t)l * DM * DM, DM, DM, E0); }); break; }
                default: break;
            }
        }
        if (ph + 1 < args.ph_hi) xcd_barrier(bar, cur_tid(widS));
    }
}

extern "C" void kernel_launch(void* const* d_in, const int* in_sizes, int n_in, void* d_out, int out_size, void* d_ws, size_t ws_size, hipStream_t stream) {
    static int grid = 0;
    if (grid == 0) {
        if (n_in != 28 || out_size != (int)O_END || ws_size < WS_END) { fprintf(stderr, "kernel_launch: unexpected shapes: n_in %d out %d ws %zu (need >= %zu)\n", n_in, out_size, ws_size, (size_t)WS_END); grid = -1; return; }
        int dev = 0, cus = 0, per_cu = 0;
        if (hipGetDevice(&dev) != hipSuccess || hipDeviceGetAttribute(&cus, hipDeviceAttributeMultiprocessorCount, dev) != hipSuccess) { fprintf(stderr, "kernel_launch: device query failed\n"); grid = -1; return; }
        if (hipFuncSetAttribute((const void*)trunk_fwd, hipFuncAttributeMaxDynamicSharedMemorySize, LDS_BYTES) != hipSuccess) { fprintf(stderr, "kernel_launch: hipFuncSetAttribute failed\n"); grid = -1; return; }
        if (hipOccupancyMaxActiveBlocksPerMultiprocessor(&per_cu, (const void*)trunk_fwd, NWAVES * 64, LDS_BYTES) != hipSuccess || per_cu < 1) { fprintf(stderr, "kernel_launch: occupancy query says %d blocks per CU\n", per_cu); (void)hipGetLastError(); grid = -1; return; }
        grid = cus;
        if (grid > 256) grid = 256;
    }
    if (grid < 0) return;
    (void)hipMemsetAsync((char*)d_ws + WS_CTL, 0, CTL_ZERO_BYTES, stream);
    KArgs a{};
    for (int i = 0; i < 28; ++i) a.in[i] = (const float*)d_in[i];
    a.out = (float*)d_out; a.ws = (unsigned char*)d_ws;
#if MK_ONE_LAUNCH
    a.ph_lo = 0; a.ph_hi = N_PHASES; a.li = 0;
    hipLaunchKernelGGL(trunk_fwd, dim3(grid), dim3(NWAVES * 64), LDS_BYTES, stream, a);
#else
    for (int ph = 0; ph < N_PHASES; ++ph) { a.ph_lo = ph; a.ph_hi = ph + 1; a.li = ph;
        hipLaunchKernelGGL(trunk_fwd, dim3(grid), dim3(NWAVES * 64), LDS_BYTES, stream, a); }
#endif
    const hipError_t le = hipPeekAtLastError();
    if (le != hipSuccess) fprintf(stderr, "kernel_launch: launch failed: %s\n", hipGetErrorName(le));
}
```

```cpp
#define MK_ONE_LAUNCH 1
#include <hip/hip_runtime.h>
#include <cstdio>
#include <cstdint>
#include <cmath>

constexpr int DM = 2048, NPR = 4096, NSR = 2048, MT = 6144, DFF = 5632, INW = 4096;
constexpr int SEQ = 256, DSEQ = 1024, PAST = 512, NBP = 16, NBS = 2, NLAYER = 2;
constexpr int KALL = PAST + DSEQ;
constexpr int MODW = 9 * DM;
constexpr float EPS = 1e-6f;
constexpr int C_QA = 0, C_KA = 1024, C_VA = 1280, C_US = 1536, C_QR = 2048, C_KR = 2560, C_VR = 3072, C_GR = 3584;
constexpr size_t O_Y = 0, O_CK = 12582912, O_CV = 14680064, O_SSM = 16777216, O_RET = 17039360, O_END = 21233664;

namespace pg8 {
#define PG8_LAS __attribute__((address_space(3)))
typedef unsigned short bf16_t;
typedef short bf16x8 __attribute__((ext_vector_type(8)));
typedef float f32x4 __attribute__((ext_vector_type(4)));
typedef unsigned u32x4 __attribute__((ext_vector_type(4)));
constexpr int BM = 256, BK = 64, HALF = 128, HTB = HALF * BK * 2, STAGE_BYTES = 8 * HTB, NXCD = 8, WGM = 8;

__host__ __device__ __forceinline__ int lds_byte(int r, int c) { const int st = (r >> 4) * 2 + (c >> 5), rr = r & 15, cc = c & 31, ob = rr * 64 + cc * 2; return st * 1024 + (ob ^ (((ob >> 9) & 1) << 5)); }
__host__ __device__ __forceinline__ void stage_rc(int b, int& R, int& C) { const int st = b / 1024, sb = b % 1024, swz = sb ^ (((sb >> 9) & 1) << 5); R = (st >> 1) * 16 + swz / 64; C = (st & 1) * 32 + (swz % 64) / 2; }
__host__ __device__ __forceinline__ int perm32(int rho) { const int n = rho >> 4, i = rho & 15; return 8 * (i >> 2) + 4 * n + (i & 3); }

struct Unit { int pm, pn; };
struct Gemm { const bf16_t* A; const bf16_t* Bt; int M, N, K; };

struct StaticOrder {
    int nM, nN, nwg, G, c;
    __host__ __device__ void init(int M, int N, int G_, int c_) { nM = M / BM; nN = N / BM; nwg = nM * nN; G = G_; c = c_; }
    __host__ __device__ bool next(int i, Unit& u) const {
        const long L = (long)i * G + c; if (L >= nwg) return false;
        int wgid = (int)L; { const int q = nwg / NXCD, r = nwg % NXCD, xcd = wgid % NXCD, off = wgid / NXCD; wgid = (xcd < r ? xcd * (q + 1) : r * (q + 1) + (xcd - r) * q) + off; }
        const int nig = WGM * nN, gid = wgid / nig, fm = gid * WGM, gsz = (nM - fm) < WGM ? (nM - fm) : WGM;
        u.pm = fm + ((wgid % nig) % gsz); u.pn = (wgid % nig) / gsz; return true;
    }
    __device__ __forceinline__ void a_ready(const Unit&) const {}
    __device__ __forceinline__ void done(const Unit&) const {}
};

typedef float f32x2_t __attribute__((ext_vector_type(2))); typedef __bf16 bf16x2_t __attribute__((ext_vector_type(2)));
__device__ __forceinline__ unsigned cvt_pk_bf16(float lo, float hi) { f32x2_t v = {lo, hi}; bf16x2_t b = __builtin_convertvector(v, bf16x2_t); return __builtin_bit_cast(unsigned, b); }
__device__ __forceinline__ float fast_sigmoid(float x) { return __builtin_amdgcn_rcpf(1.0f + __builtin_amdgcn_exp2f(-1.4426950408889634f * x)); }

struct EpiBf16 {
    static constexpr bool PERM = true, AFTER_DRAIN = false;
    bf16_t* O; int ldc;
    __device__ __forceinline__ void operator()(const f32x4 (&acc)[2][2][4][2], const Unit& u, int wr, int wc, int fr, int fq) const {
        const int row0 = u.pm * BM + wr * 64 + fr; const int col0 = u.pn * BM + wc * 32 + 8 * fq;
#pragma unroll
        for (int ai = 0; ai < 2; ++ai)
#pragma unroll
            for (int m = 0; m < 4; ++m) { bf16_t* rowp = O + (size_t)(row0 + ai * HALF + m * 16) * ldc + col0;
#pragma unroll
                for (int bj = 0; bj < 2; ++bj) { const f32x4 v0 = acc[ai][bj][m][0], v1 = acc[ai][bj][m][1];
                    u32x4 w; w.x = cvt_pk_bf16(v0[0], v0[1]); w.y = cvt_pk_bf16(v0[2], v0[3]); w.z = cvt_pk_bf16(v1[0], v1[1]); w.w = cvt_pk_bf16(v1[2], v1[3]);
                    *(u32x4*)(rowp + bj * HALF) = w; } }
    }
};
template <int ACT> struct EpiPair {
    static constexpr bool PERM = true, AFTER_DRAIN = false;
    bf16_t* O; int ldc; int coff;
    __device__ __forceinline__ void operator()(const f32x4 (&acc)[2][2][4][2], const Unit& u, int wr, int wc, int fr, int fq) const {
        const int row0 = u.pm * BM + wr * 64 + fr; const int col0 = coff + u.pn * HALF + wc * 32 + 8 * fq;
#pragma unroll
        for (int ai = 0; ai < 2; ++ai)
#pragma unroll
            for (int m = 0; m < 4; ++m) { bf16_t* rowp = O + (size_t)(row0 + ai * HALF + m * 16) * ldc + col0;
                float r[8];
#pragma unroll
                for (int n = 0; n < 2; ++n)
#pragma unroll
                    for (int j = 0; j < 4; ++j) { const float a = acc[ai][0][m][n][j], g = acc[ai][1][m][n][j];
                        r[n * 4 + j] = (ACT == 0) ? a * fast_sigmoid(a) * g : a * fast_sigmoid(g); }
                u32x4 w; w.x = cvt_pk_bf16(r[0], r[1]); w.y = cvt_pk_bf16(r[2], r[3]); w.z = cvt_pk_bf16(r[4], r[5]); w.w = cvt_pk_bf16(r[6], r[7]);
                *(u32x4*)rowp = w; }
    }
};
struct EpiResid {
    static constexpr bool PERM = false, AFTER_DRAIN = false;
    float* X; const float* gate0; int gstride; float s;
    __device__ __forceinline__ void operator()(const f32x4 (&acc)[2][2][4][2], const Unit& u, int wr, int wc, int fr, int fq) const {
        const int row0 = u.pm * BM + wr * 64 + fr, col0 = u.pn * BM + wc * 32 + 4 * fq;
        const int var = u.pm < 16 ? 0 : (u.pm < 20 ? 1 : 2);
        const float* gp = gate0 + (size_t)var * gstride + col0;
        f32x4 gv[2][2];
#pragma unroll
        for (int bj = 0; bj < 2; ++bj)
#pragma unroll
            for (int n = 0; n < 2; ++n) gv[bj][n] = *(const f32x4*)(gp + bj * HALF + n * 16) * s;
#pragma unroll
        for (int ai = 0; ai < 2; ++ai)
#pragma unroll
            for (int m = 0; m < 4; ++m) { float* rowp = X + (size_t)(row0 + ai * HALF + m * 16) * DM + col0;
#pragma unroll
                for (int bj = 0; bj < 2; ++bj)
#pragma unroll
                    for (int n = 0; n < 2; ++n) { float* p = rowp + bj * HALF + n * 16; const f32x4 x = *(const f32x4*)p; *(f32x4*)p = x + gv[bj][n] * acc[ai][bj][m][n]; } }
    }
};

template <class Epi, class Sched, bool ALIGN_EPI = false, bool SP2 = false>
__device__ __forceinline__ void gemm_phase(PG8_LAS unsigned char* lds, const Gemm g, const Sched& S, const Epi& E, int tid0) {
    int tid_ = tid0; asm volatile("" : "+v"(tid_));
    const int tid = tid_, wid = __builtin_amdgcn_readfirstlane(tid >> 6), lane = tid & 63, wr = wid >> 2, wc = wid & 3, fr = lane & 15, fq = lane >> 4;
    const int K = g.K, nt = K / BK;
    unsigned voffA[2], voffB[2];
#pragma unroll
    for (int i = 0; i < 2; ++i) { int R, C; stage_rc(tid * 16 + i * 8192, R, C); const int Rb = Epi::PERM ? ((R & ~31) + perm32(R & 31)) : R;
        voffA[i] = (unsigned)(R * K + C) * 2u; voffB[i] = (unsigned)(Rb * K + C) * 2u; }
    const size_t kstep = (size_t)(BK * 2);
    const size_t hstep = (size_t)HALF * K * 2;
    const size_t tstep = 2 * hstep;
    const unsigned ldsw = (unsigned)wid * 1024u;
    const int aoff = lds_byte(wr * 64 + fr, fq * 8), boff = lds_byte(wc * 32 + fr, fq * 8);
#define PG8_SA(b, h) (((b) * 2 + (h)) * HTB)
#define PG8_SB(b, h) ((4 + (b) * 2 + (h)) * HTB)
#define PG8_STAGE(bufoff, gbase, voff) do { _Pragma("unroll") for (int _i = 0; _i < 2; ++_i) \
        __builtin_amdgcn_global_load_lds((const unsigned*)((const char*)(gbase) + (voff)[_i]), (PG8_LAS unsigned*)(lds + (bufoff) + ldsw + _i * 8192), 16, 0, 0); } while (0)
#define PG8_LDA(dst, b, h) do { _Pragma("unroll") for (int m = 0; m < 4; ++m) _Pragma("unroll") for (int k = 0; k < 2; ++k) dst[m][k] = *(const PG8_LAS bf16x8*)(lds + PG8_SA(b, h) + aoff + m * 2048 + k * 1024); } while (0)
#define PG8_LDB(dst, b, h) do { _Pragma("unroll") for (int n = 0; n < 2; ++n) _Pragma("unroll") for (int k = 0; k < 2; ++k) dst[n][k] = *(const PG8_LAS bf16x8*)(lds + PG8_SB(b, h) + boff + n * 2048 + k * 1024); } while (0)
#define PG8_MMA(ai, bj, At, Bt) do { __builtin_amdgcn_s_setprio(1); _Pragma("unroll") for (int m = 0; m < 4; ++m) _Pragma("unroll") for (int n = 0; n < 2; ++n) _Pragma("unroll") for (int k = 0; k < 2; ++k) \
        acc[ai][bj][m][n] = __builtin_amdgcn_mfma_f32_16x16x32_bf16(Bt[n][k], At[m][k], acc[ai][bj][m][n], 0, 0, 0); __builtin_amdgcn_s_setprio(0); } while (0)
#define PG8_WAIT_V(n) asm volatile("s_waitcnt vmcnt(" #n ")" ::: "memory")
#define PG8_WAIT_L(n) asm volatile("s_waitcnt lgkmcnt(" #n ")" ::: "memory")
#define PG8_BAR __builtin_amdgcn_s_barrier()
#define PG8_SCHED __builtin_amdgcn_sched_barrier(0)
    Unit cur, nxt; int ui = 0;
    if (!S.next(0, cur)) return;
    f32x4 acc[2][2][4][2];
#pragma unroll
    for (int a = 0; a < 2; ++a)
#pragma unroll
        for (int b = 0; b < 2; ++b)
#pragma unroll
            for (int m = 0; m < 4; ++m)
#pragma unroll
                for (int n = 0; n < 2; ++n) acc[a][b][m][n] = (f32x4){0.f, 0.f, 0.f, 0.f};
    bf16x8 At[4][2], B0[2][2], B1[2][2];
    const char* cA = (const char*)g.A + (size_t)cur.pm * tstep; const char* cB = (const char*)g.Bt + (size_t)cur.pn * tstep;
    S.a_ready(cur);
    if constexpr (SP2) {
        PG8_STAGE(PG8_SB(0, 0), cB, voffB); PG8_STAGE(PG8_SB(0, 1), cB + hstep, voffB); PG8_STAGE(PG8_SA(0, 0), cA, voffA); PG8_STAGE(PG8_SA(0, 1), cA + hstep, voffA);
        if (wr == 1) PG8_BAR;
        PG8_WAIT_V(2); PG8_BAR;
        PG8_STAGE(PG8_SB(1, 0), cB + kstep, voffB); PG8_STAGE(PG8_SA(1, 0), cA + kstep, voffA); PG8_STAGE(PG8_SB(1, 1), cB + hstep + kstep, voffB);
        PG8_WAIT_V(6); PG8_BAR;
    } else {
        PG8_STAGE(PG8_SB(0, 0), cB, voffB); PG8_STAGE(PG8_SA(0, 0), cA, voffA); PG8_STAGE(PG8_SB(0, 1), cB + hstep, voffB); PG8_STAGE(PG8_SA(0, 1), cA + hstep, voffA);
        if (wr == 1) PG8_BAR;
        PG8_WAIT_V(4); PG8_BAR;
        PG8_STAGE(PG8_SB(1, 0), cB + kstep, voffB); PG8_STAGE(PG8_SA(1, 0), cA + kstep, voffA); PG8_STAGE(PG8_SB(1, 1), cB + hstep + kstep, voffB);
        PG8_WAIT_V(6); PG8_BAR;
    }
    for (;;) {
        const bool has_next = S.next(ui + 1, nxt);
        const char* nA = has_next ? (const char*)g.A + (size_t)nxt.pm * tstep : cA; const char* nB = has_next ? (const char*)g.Bt + (size_t)nxt.pn * tstep : cB;
        for (int t = 0; t < nt; t += 2) {
            const bool last = (t == nt - 2);
            const char* a1 = cA + (size_t)(t + 1) * kstep;
            const char* a2 = last ? nA : cA + (size_t)(t + 2) * kstep; const char* b2 = last ? nB : cB + (size_t)(t + 2) * kstep;
            const char* a3 = a2 + kstep; const char* b3 = b2 + kstep;
            if (last && has_next) S.a_ready(nxt);
            if constexpr (SP2) {
            PG8_LDB(B0, 0, 0); PG8_LDB(B1, 0, 1); PG8_SCHED; PG8_LDA(At, 0, 0); PG8_STAGE(PG8_SA(1, 1), a1 + hstep, voffA);
            PG8_WAIT_V(8); PG8_WAIT_L(0); PG8_BAR; PG8_MMA(0, 0, At, B0); PG8_MMA(0, 1, At, B1); PG8_BAR; PG8_SCHED;
            PG8_LDA(At, 0, 1); PG8_STAGE(PG8_SB(0, 0), b2, voffB); PG8_STAGE(PG8_SB(0, 1), b2 + hstep, voffB); PG8_STAGE(PG8_SA(0, 0), a2, voffA);
            PG8_WAIT_V(8); PG8_WAIT_L(0); PG8_BAR; PG8_MMA(1, 0, At, B0); PG8_MMA(1, 1, At, B1); PG8_BAR; PG8_SCHED;
            PG8_LDB(B0, 1, 0); PG8_LDB(B1, 1, 1); PG8_SCHED; PG8_LDA(At, 1, 0); PG8_STAGE(PG8_SA(0, 1), a2 + hstep, voffA);
            PG8_WAIT_V(8); PG8_WAIT_L(0); PG8_BAR; PG8_MMA(0, 0, At, B0); PG8_MMA(0, 1, At, B1); PG8_BAR; PG8_SCHED;
            PG8_LDA(At, 1, 1); PG8_STAGE(PG8_SB(1, 0), b3, voffB); PG8_STAGE(PG8_SB(1, 1), b3 + hstep, voffB); PG8_STAGE(PG8_SA(1, 0), a3, voffA);
            PG8_WAIT_V(8); PG8_WAIT_L(0); PG8_BAR; PG8_MMA(1, 0, At, B0); PG8_MMA(1, 1, At, B1); PG8_BAR; PG8_SCHED;
            } else {
            PG8_LDB(B0, 0, 0); PG8_SCHED; PG8_LDA(At, 0, 0); PG8_STAGE(PG8_SA(1, 1), a1 + hstep, voffA);
            PG8_WAIT_L(8); PG8_BAR; PG8_WAIT_L(0); PG8_MMA(0, 0, At, B0); PG8_BAR; PG8_SCHED;
            PG8_LDB(B1, 0, 1); PG8_STAGE(PG8_SB(0, 0), b2, voffB);
            PG8_BAR; PG8_WAIT_L(0); PG8_MMA(0, 1, At, B1); PG8_BAR;
            PG8_LDA(At, 0, 1); PG8_STAGE(PG8_SA(0, 0), a2, voffA);
            PG8_BAR; PG8_WAIT_L(0); PG8_MMA(1, 0, At, B0); PG8_BAR; PG8_SCHED;
            PG8_STAGE(PG8_SB(0, 1), b2 + hstep, voffB);
            PG8_WAIT_V(6); PG8_BAR; PG8_MMA(1, 1, At, B1); PG8_BAR;
            PG8_LDB(B0, 1, 0); PG8_SCHED; PG8_LDA(At, 1, 0); PG8_STAGE(PG8_SA(0, 1), a2 + hstep, voffA);
            PG8_WAIT_L(8); PG8_BAR; PG8_WAIT_L(0); PG8_MMA(0, 0, At, B0); PG8_BAR; PG8_SCHED;
            PG8_LDB(B1, 1, 1); PG8_STAGE(PG8_SB(1, 0), b3, voffB);
            PG8_BAR; PG8_WAIT_L(0); PG8_MMA(0, 1, At, B1); PG8_BAR;
            PG8_LDA(At, 1, 1); PG8_STAGE(PG8_SA(1, 0), a3, voffA);
            PG8_BAR; PG8_WAIT_L(0); PG8_MMA(1, 0, At, B0); PG8_BAR; PG8_SCHED;
            PG8_STAGE(PG8_SB(1, 1), b3 + hstep, voffB);
            PG8_WAIT_V(6); PG8_BAR; PG8_MMA(1, 1, At, B1); PG8_BAR;
            }
        }
        if constexpr (ALIGN_EPI) { if (wr == 0) PG8_BAR; }
        if constexpr (!Epi::AFTER_DRAIN) { E(acc, cur, wr, wc, fr, fq); S.done(cur); }
        if (!has_next) break;
#pragma unroll
        for (int a = 0; a < 2; ++a)
#pragma unroll
            for (int b = 0; b < 2; ++b)
#pragma unroll
                for (int m = 0; m < 4; ++m)
#pragma unroll
                    for (int n = 0; n < 2; ++n) acc[a][b][m][n] = (f32x4){0.f, 0.f, 0.f, 0.f};
        cur = nxt; cA = nA; cB = nB; ++ui;
        if constexpr (ALIGN_EPI) { if (wr == 1) PG8_BAR; }
    }
    PG8_WAIT_V(0);
    if constexpr (!ALIGN_EPI) { if (wr == 0) PG8_BAR; }
    PG8_BAR;
    if constexpr (Epi::AFTER_DRAIN) { E.fused(acc, cur, wr, wc, fr, fq, lds, wid, lane); S.done(cur); }
#undef PG8_SA
#undef PG8_SB
#undef PG8_STAGE
#undef PG8_LDA
#undef PG8_LDB
#undef PG8_MMA
#undef PG8_WAIT_V
#undef PG8_WAIT_L
#undef PG8_BAR
#undef PG8_SCHED
}
}

typedef unsigned short bf16;
typedef unsigned v4u __attribute__((ext_vector_type(4)));
typedef float f32x4 __attribute__((ext_vector_type(4)));
#define GAS __attribute__((address_space(1)))
#define LAS __attribute__((address_space(3)))
typedef GAS unsigned gu32;
#define RLX_AGENT __ATOMIC_RELAXED, __HIP_MEMORY_SCOPE_AGENT
#define LDS_WAIT() asm volatile("s_waitcnt lgkmcnt(0)" ::: "memory")
#define VM_WAIT() asm volatile("s_waitcnt vmcnt(0)" ::: "memory")

constexpr int NWAVES = 8;
#ifndef MIXER_NAIVE
#define MIXER_NAIVE 0
#endif
#ifndef MK_ONE_LAUNCH
#define MK_ONE_LAUNCH 0
#endif
constexpr size_t MiB = 1u << 20;
constexpr size_t WS_CTL = 0, CTL_ZERO_BYTES = 2 * MiB;
constexpr size_t WS_MOD = 1 * MiB;
constexpr size_t WS_COS = 2 * MiB, WS_SIN = 2 * MiB + 256 * 1024, WS_LAM = 2 * MiB + 512 * 1024, WS_BBAR = 3 * MiB;
constexpr size_t WS_WFI = 8 * MiB, WS_WFO = 184 * MiB, WS_WIN = 272 * MiB, WS_WOUT = 304 * MiB, WS_WGLU = 320 * MiB;
constexpr size_t WS_XR = 322 * MiB, WS_H = 370 * MiB, WS_ACT = 394 * MiB, WS_PROJ = 460 * MiB, WS_QB = 508 * MiB;
constexpr size_t WS_KP = 520 * MiB, WS_VP = 522 * MiB, WS_KS = 524 * MiB, WS_VS = 526 * MiB, WS_QR = 528 * MiB, WS_KR = 534 * MiB;
constexpr size_t WS_MIX = 540 * MiB, WS_YS = 564 * MiB, WS_YSB = 576 * MiB, WS_END = 582 * MiB;
constexpr int CW_BAR = 4096;
constexpr int RING_BYTES = 131072, LDSCTL_OFF = RING_BYTES, MISC_OFF = LDSCTL_OFF + 320, LDS_BYTES = 147456;

__device__ __forceinline__ unsigned f2bf(float f) { unsigned u = __builtin_bit_cast(unsigned, f); return (u + 0x7fffu + ((u >> 16) & 1u)) >> 16; }
__device__ __forceinline__ unsigned pk2(float lo, float hi) { return f2bf(lo) | (f2bf(hi) << 16); }
__device__ __forceinline__ float bf2f(unsigned short h) { return __builtin_bit_cast(float, (unsigned)h << 16); }
__device__ __forceinline__ float bflo(unsigned w) { return __builtin_bit_cast(float, w << 16); }
__device__ __forceinline__ float bfhi(unsigned w) { return __builtin_bit_cast(float, w & 0xffff0000u); }

#define XB_TMO      128
#define XB_XCNT(j)  (256  + 64 * (j))
#define XB_XSUB(j)  (1280 + 64 * (j))
#define XB_XGEN(j)  (2304 + 64 * (j))
#define XB_TOP      3328
#define XB_TOPGEN   3392
#define XCD_BAR_WORDS 3456
#define XB_SPIN_CAP (1u << 18)
__device__ __forceinline__ unsigned xb_ld(unsigned* p)              { return __hip_atomic_load(p, __ATOMIC_RELAXED, __HIP_MEMORY_SCOPE_AGENT); }
__device__ __forceinline__ unsigned xb_add(unsigned* p, unsigned v) { return __hip_atomic_fetch_add(p, v, __ATOMIC_RELAXED, __HIP_MEMORY_SCOPE_AGENT); }
__device__ __forceinline__ unsigned xb_xcc_id() { return (unsigned)__builtin_amdgcn_s_getreg((3 << 11) | 20) & 0xFu; }
#define XB_SPIN(cond, bar) do { unsigned _sp = 0; while (cond) { __builtin_amdgcn_s_sleep(1); \
    if ((++_sp & 255u) == 0u) { if (xb_ld(&(bar)[XB_TMO])) break; if (_sp > XB_SPIN_CAP) { atomicAdd(&(bar)[XB_TMO], 1u); break; } } } } while (0)
struct XcdBarrier { unsigned* bar; unsigned x; volatile LAS unsigned* st; };
__device__ __forceinline__ XcdBarrier xcd_barrier_post(unsigned* bar, volatile LAS unsigned* st) {
    XcdBarrier b; b.bar = bar; b.x = xb_xcc_id(); b.st = st;
    if (threadIdx.x == 0) (void)xb_add(&bar[XB_XCNT(b.x)], 1u);
    return b;
}
__device__ __forceinline__ void xcd_barrier_complete(unsigned* bar, unsigned x, unsigned& nloc, unsigned& nx) {
    const unsigned G = gridDim.x * gridDim.y * gridDim.z;
    unsigned sum, cnt, mine, sp = 0u;
    for (;;) {
        sum = 0u; cnt = 0u; mine = 0u;
#pragma unroll
        for (unsigned j = 0; j < 16; ++j) { const unsigned c = xb_ld(&bar[XB_XCNT(j)]); sum += c; cnt += (c > 0u) ? 1u : 0u; mine = (j == x) ? c : mine; }
        if (sum == G) break;
        __builtin_amdgcn_s_sleep(1);
        if ((++sp & 255u) == 0u) { if (xb_ld(&bar[XB_TMO])) break; if (sp > XB_SPIN_CAP) { atomicAdd(&bar[XB_TMO], 1u); break; } }
    }
    nloc = mine > 0u ? mine : 1u; nx = cnt > 0u ? cnt : 1u;
}
__device__ __forceinline__ void xcd_barrier(const XcdBarrier& b, int tid) {
    asm volatile("s_waitcnt vmcnt(0)" ::: "memory");
    __syncthreads();
    if (tid == 0) {
        unsigned* bar = b.bar; asm volatile("" : "+s"(bar));
        __builtin_amdgcn_s_waitcnt(0);
        unsigned nloc = b.st[0], nx = b.st[1];
        if (nloc == 0u) { xcd_barrier_complete(bar, b.x, nloc, nx); b.st[0] = nloc; b.st[1] = nx; }
        const unsigned old = xb_add(&bar[XB_XSUB(b.x)], 1u);
        const unsigned gen = old / nloc;
        if (old + 1u == (gen + 1u) * nloc) {
            __builtin_amdgcn_fence(__ATOMIC_RELEASE, "agent");
            asm volatile("s_waitcnt vmcnt(0)" ::: "memory");
            const unsigned og = xb_add(&bar[XB_TOP], 1u);
            const unsigned tg = og / nx;
            if (og + 1u == (tg + 1u) * nx) xb_add(&bar[XB_TOPGEN], 1u);
            else XB_SPIN(xb_ld(&bar[XB_TOPGEN]) == tg, bar);
            __builtin_amdgcn_fence(__ATOMIC_ACQUIRE, "agent");
            xb_add(&bar[XB_XGEN(b.x)], 1u);
            asm volatile("s_waitcnt vmcnt(0)" ::: "memory");
        } else {
            XB_SPIN(xb_ld(&bar[XB_XGEN(b.x)]) == gen, bar);
            __builtin_amdgcn_fence(__ATOMIC_ACQUIRE, "agent");
            asm volatile("s_waitcnt vmcnt(0)" ::: "memory");
        }
    }
    __syncthreads();
}

struct KArgs { const float* in[28]; float* out; unsigned char* ws; int ph_lo, ph_hi, li, pad; };
typedef const __attribute__((address_space(4))) KArgs* KA;
enum { I_XP = 0, I_XS, I_CK, I_CV, I_SSSM, I_SRET, I_C, I_CCTX, I_WMOD, I_BMOD, I_NORMG, I_WFI, I_WFO, I_WIN, I_WOUT, I_QNG, I_KNG,
       I_ARE, I_AIM, I_LOGDT, I_BRE, I_BIM, I_CRE, I_CIM, I_SSMD, I_WGLU, I_DECAY, I_FNG };

struct Frame {
    LAS unsigned char* lds;
    int tid, lane, wave, G, gw, NGW;
};

template <int O> __device__ __forceinline__ float shx(float v) { return __builtin_bit_cast(float, __builtin_amdgcn_ds_swizzle(__builtin_bit_cast(int, v), (O << 10) | 0x1f)); }
__device__ __forceinline__ float wave_sum(float v) {
    v += shx<1>(v); v += shx<2>(v); v += shx<4>(v); v += shx<8>(v); v += shx<16>(v);
    const auto rr = __builtin_amdgcn_permlane32_swap(__float_as_uint(v), __float_as_uint(v), false, false);
    return __uint_as_float(rr[0]) + __uint_as_float(rr[1]);
}
__device__ __forceinline__ float wave_max(float v) {
    v = fmaxf(v, shx<1>(v)); v = fmaxf(v, shx<2>(v)); v = fmaxf(v, shx<4>(v)); v = fmaxf(v, shx<8>(v)); v = fmaxf(v, shx<16>(v));
    const auto rr = __builtin_amdgcn_permlane32_swap(__float_as_uint(v), __float_as_uint(v), false, false);
    return fmaxf(__uint_as_float(rr[0]), __uint_as_float(rr[1]));
}
__device__ __forceinline__ float silu_f(float x) { return x / (1.0f + __expf(-x)); }
__device__ __forceinline__ float gelu_tanh(float x) { const float u = 0.7978845608028654f * (x + 0.044715f * x * x * x); return 0.5f * x * (1.0f + tanhf(u)); }

__device__ __forceinline__ void p0_transpose_item(const float* W, int K, int N, bf16* WT, int halfN, LAS float* scr, int item, int lane) {
    const int nblk = N / 32, kb = item / nblk, nb = item % nblk, k0 = 64 * kb, n0 = 32 * nb;
    int R0 = n0;
    if (halfN) { if (n0 < halfN) R0 = 256 * (n0 >> 7) + (n0 & 127); else { const int n1 = n0 - halfN; R0 = 256 * (n1 >> 7) + 128 + (n1 & 127); } }
#pragma unroll 8
    for (int i = 0; i < 32; ++i) { const int kk = 2 * i + (lane >> 5); scr[kk * 33 + (lane & 31)] = W[(size_t)(k0 + kk) * N + n0 + (lane & 31)]; }
    LDS_WAIT(); asm volatile("" ::: "memory");
    const int c = lane & 7;
#pragma unroll
    for (int j = 0; j < 4; ++j) { const int n = (lane >> 3) + 8 * j; const LAS float* s = scr + (8 * c) * 33 + n;
        v4u o; o.x = pk2(s[0 * 33], s[1 * 33]); o.y = pk2(s[2 * 33], s[3 * 33]); o.z = pk2(s[4 * 33], s[5 * 33]); o.w = pk2(s[6 * 33], s[7 * 33]);
        *(GAS v4u*)(WT + (size_t)(R0 + n) * K + k0 + 8 * c) = o; }
    LDS_WAIT(); asm volatile("" ::: "memory");
}

__device__ __forceinline__ void phase_prologue(const Frame& F, KA a, int parts = 15) {
    unsigned char* ws = a->ws;
    LAS float* cs = (LAS float*)(F.lds);
    LAS float* red = (LAS float*)(F.lds + 24576);
    if (parts & 1) {
    for (int i = F.tid; i < 3 * DM; i += 512) { const int v = i / DM, k = i % DM; const float c = v == 0 ? a->in[I_CCTX][k] : a->in[I_C][(v - 1) * DM + k]; cs[i] = silu_f(c); }
    __syncthreads();
    float* modb = (float*)(ws + WS_MOD);
    for (int task = blockIdx.x; task < 2 * 72 * 8; task += F.G) {
        const int l = task / 576, r = task % 576, cb = r / 8, kc = r % 8;
        const int kbase = kc * 256 + F.wave * 32, col = cb * 256 + F.lane * 4;
        const float* wp = a->in[I_WMOD] + ((size_t)l * DM + kbase) * MODW + col;
        f32x4 s0 = {0, 0, 0, 0}, s1 = s0, s2 = s0;
#pragma unroll 8
        for (int k = 0; k < 32; ++k) { const f32x4 w = *(const GAS f32x4*)(wp + (size_t)k * MODW);
            s0 += w * cs[kbase + k]; s1 += w * cs[DM + kbase + k]; s2 += w * cs[2 * DM + kbase + k]; }
        LAS float* rp = red + (F.wave * 64 + F.lane) * 12;
#pragma unroll
        for (int j = 0; j < 4; ++j) { rp[j] = s0[j]; rp[4 + j] = s1[j]; rp[8 + j] = s2[j]; }
        __syncthreads();
        for (int o = F.tid; o < 768; o += 512) { const int v = o >> 8, c = o & 255; float s = 0.f;
#pragma unroll
            for (int w = 0; w < 8; ++w) s += red[(w * 64 + (c >> 2)) * 12 + v * 4 + (c & 3)];
            if (kc == 0) s += a->in[I_BMOD][l * MODW + cb * 256 + c];
            unsafeAtomicAdd(modb + ((size_t)l * 3 + v) * MODW + cb * 256 + c, s); }
        __syncthreads();
    }
    }
    if (parts & 2) {
        float* cosT = (float*)(ws + WS_COS); float* sinT = (float*)(ws + WS_SIN);
        for (int i = blockIdx.x * 512 + F.tid; i < DSEQ * 64; i += F.G * 512) { const int t = i >> 6, j = i & 63, ax = j >> 5, f = j & 31;
            const float pos = (float)(ax == 0 ? (t >> 6) : (t & 63)); const float inv = powf(10000.0f, -(float)f / 32.0f); const float ang = pos * inv;
            float sn, cn; sincosf(ang, &sn, &cn); cosT[i] = cn; sinT[i] = sn; }
        float* lamT = (float*)(ws + WS_LAM); float* bbT = (float*)(ws + WS_BBAR);
        for (int i = blockIdx.x * 512 + F.tid; i < NLAYER * 2 * 32 * 64; i += F.G * 512) {
            const int ldg = i >> 6;
            const float dt = expf(a->in[I_LOGDT][ldg]); const float ar = a->in[I_ARE][i], ai = a->in[I_AIM][i];
            const float x = ar * dt, y = ai * dt; float sn, cn; sincosf(y, &sn, &cn); const float ex = expf(x);
            lamT[2 * i] = ex * cn; lamT[2 * i + 1] = ex * sn;
            const float sh = sinf(0.5f * y); const float nr = expm1f(x) * cn - 2.0f * sh * sh, ni = ex * sn;
            const float d2 = ar * ar + ai * ai; const float cr = (nr * ar + ni * ai) / d2, ci = (ni * ar - nr * ai) / d2;
#pragma unroll
            for (int j = 0; j < 16; ++j) { const float br = a->in[I_BRE][(size_t)i * 16 + j], bi = a->in[I_BIM][(size_t)i * 16 + j];
                bbT[((size_t)i * 16 + j) * 2] = cr * br - ci * bi; bbT[((size_t)i * 16 + j) * 2 + 1] = cr * bi + ci * br; }
        }
    }
    if (parts & 4) {
        GAS f32x4* xr = (GAS f32x4*)(ws + WS_XR);
        const GAS f32x4* xp = (const GAS f32x4*)a->in[I_XP]; const GAS f32x4* xs = (const GAS f32x4*)a->in[I_XS];
        const int NP4 = NPR * DM / 4, NT4 = MT * DM / 4;
        for (int i = blockIdx.x * 512 + F.tid; i < NT4; i += F.G * 512) xr[i] = i < NP4 ? xp[i] : xs[i - NP4];
    }
    if (parts & 8) {
        LAS float* scr = (LAS float*)(F.lds + 49152 + F.wave * 8704);
        constexpr int I_FI = (DM / 64) * (2 * DFF / 32), I_FO = (DFF / 64) * (DM / 32), I_IN = (DM / 64) * (INW / 32), I_OUT = (DM / 64) * (DM / 32), I_GL = (512 / 64) * (1024 / 32);
        constexpr int NITEMS = 4 * I_FI + 4 * I_FO + 2 * I_IN + 2 * I_OUT + 2 * I_GL;
        for (int it = F.gw; it < NITEMS; it += F.NGW) {
            int r = it;
            if (r < 4 * I_FI) { const int m = r / I_FI; p0_transpose_item(a->in[I_WFI] + (size_t)m * DM * 2 * DFF, DM, 2 * DFF, (bf16*)(ws + WS_WFI) + (size_t)m * 2 * DFF * DM, DFF, scr, r % I_FI, F.lane); continue; } r -= 4 * I_FI;
            if (r < 4 * I_FO) { const int m = r / I_FO; p0_transpose_item(a->in[I_WFO] + (size_t)m * DFF * DM, DFF, DM, (bf16*)(ws + WS_WFO) + (size_t)m * DM * DFF, 0, scr, r % I_FO, F.lane); continue; } r -= 4 * I_FO;
            if (r < 2 * I_IN) { const int m = r / I_IN; p0_transpose_item(a->in[I_WIN] + (size_t)m * DM * INW, DM, INW, (bf16*)(ws + WS_WIN) + (size_t)m * INW * DM, 0, scr, r % I_IN, F.lane); continue; } r -= 2 * I_IN;
            if (r < 2 * I_OUT) { const int m = r / I_OUT; p0_transpose_item(a->in[I_WOUT] + (size_t)m * DM * DM, DM, DM, (bf16*)(ws + WS_WOUT) + (size_t)m * DM * DM, 0, scr, r % I_OUT, F.lane); continue; } r -= 2 * I_OUT;
            { const int m = r / I_GL; p0_transpose_item(a->in[I_WGLU] + (size_t)m * 512 * 1024, 512, 1024, (bf16*)(ws + WS_WGLU) + (size_t)m * 1024 * 512, 512, scr, r % I_GL, F.lane); }
        }
    }
}

__device__ __forceinline__ void phase_prenorm(const Frame& F, KA a, int l, int sub) {
    unsigned char* ws = a->ws;
    const float* xr = (const float*)(ws + WS_XR);
    for (int m = F.gw; m < MT; m += F.NGW) {
        const GAS f32x4* xp = (const GAS f32x4*)(xr + (size_t)m * DM) + F.lane;
        f32x4 v[8]; float s = 0.f;
#pragma unroll
        for (int j = 0; j < 8; ++j) { v[j] = xp[64 * j]; s += (v[j].x * v[j].x + v[j].y * v[j].y) + (v[j].z * v[j].z + v[j].w * v[j].w); }
        const float rstd = 1.0f / sqrtf(wave_sum(s) * (1.0f / DM) + EPS);
        if (sub == 3) {
            const GAS f32x4* gp = (const GAS f32x4*)a->in[I_FNG] + F.lane; GAS f32x4* op = (GAS f32x4*)(a->out + O_Y + (size_t)m * DM) + F.lane;
#pragma unroll
            for (int j = 0; j < 8; ++j) op[64 * j] = v[j] * rstd * gp[64 * j];
        } else {
            const int var = m < NPR ? 0 : 1 + (m - NPR) / DSEQ;
            const float* mod = (const float*)(ws + WS_MOD) + ((size_t)l * 3 + var) * MODW + sub * 3 * DM;
            const GAS f32x4* gp = (const GAS f32x4*)(a->in[I_NORMG] + ((size_t)l * 3 + sub) * DM) + F.lane;
            const GAS f32x4* shp = (const GAS f32x4*)mod + F.lane; const GAS f32x4* scp = (const GAS f32x4*)(mod + DM) + F.lane;
            GAS unsigned long long* o8 = (GAS unsigned long long*)((bf16*)(ws + WS_H) + (size_t)m * DM) + F.lane;
#pragma unroll
            for (int j = 0; j < 8; ++j) { const f32x4 y = v[j] * rstd * gp[64 * j] * (scp[64 * j] + 1.0f) + shp[64 * j];
                o8[64 * j] = (unsigned long long)pk2(y.x, y.y) | ((unsigned long long)pk2(y.z, y.w) << 32); }
        }
    }
}

__device__ __forceinline__ void phase_qkvpost(const Frame& F, KA a, int l) {
    unsigned char* ws = a->ws;
    const bf16* proj = (const bf16*)(ws + WS_PROJ);
    const float* cosT = (const float*)(ws + WS_COS); const float* sinT = (const float*)(ws + WS_SIN);
    const int i = F.lane, e0 = (i & 31) + 64 * (i >> 5), e1 = e0 + 32;
    const int NT1 = MT * 20, NT2 = NBS * PAST * 2 * 2;
    for (int task = F.gw; task < NT1 + NT2; task += F.NGW) {
        if (task >= NT1) {
            const int r = task - NT1; const int isv = r & 1, kvh = (r >> 1) & 1, t = (r >> 2) % PAST, b = (r >> 2) / PAST;
            const float* src = a->in[isv ? I_CV : I_CK] + ((((size_t)b * NLAYER + l) * PAST + t) * 2 + kvh) * 128;
            bf16* dst = (bf16*)(ws + (isv ? WS_VS : WS_KS)) + ((size_t)b * KALL + t) * 256 + kvh * 128;
            dst[e0] = (bf16)f2bf(src[e0]); dst[e1] = (bf16)f2bf(src[e1]);
            continue;
        }
        const int m = task / 20, ch = task % 20;
        const bool lat = m >= NPR; const int b = lat ? (m - NPR) / DSEQ : m / SEQ, t = lat ? (m - NPR) % DSEQ : m % SEQ;
        int scol; if (ch < 8) scol = C_QA + ch * 128; else if (ch < 10) scol = C_KA + (ch - 8) * 128; else if (ch < 12) scol = C_VA + (ch - 10) * 128; else if (ch < 16) scol = C_QR + (ch - 12) * 128; else scol = C_KR + (ch - 16) * 128;
        const bf16* src = proj + (size_t)m * INW + scol;
        float x0 = bf2f(src[e0]), x1 = bf2f(src[e1]);
        if (ch < 10) {
            const float ss = wave_sum(x0 * x0 + x1 * x1); const float r = 1.0f / sqrtf(ss * (1.0f / 128.0f) + EPS);
            const float* g = a->in[ch < 8 ? I_QNG : I_KNG] + l * 128;
            x0 *= r * g[e0]; x1 *= r * g[e1];
        }
        if (ch >= 16) { x0 *= 0.08838834764831845f; x1 *= 0.08838834764831845f; }
        if (lat && (ch < 10 || ch >= 12)) {
            const float c = cosT[t * 64 + i], s = sinT[t * 64 + i];
            const float y0 = x0 * c - x1 * s, y1 = x1 * c + x0 * s; x0 = y0; x1 = y1;
        }
        if (ch < 8) { bf16* d = (bf16*)(ws + WS_QB) + (size_t)m * 1024 + ch * 128; d[e0] = (bf16)f2bf(x0); d[e1] = (bf16)f2bf(x1); }
        else if (ch < 12) {
            const int isv = ch >= 10, kvh = (ch - 8) & 1;
            if (!lat) {
                float* o = a->out + (isv ? O_CV : O_CK) + ((((size_t)b * NLAYER + l) * SEQ + t) * 2 + kvh) * 128; o[e0] = x0; o[e1] = x1;
                bf16* d = (bf16*)(ws + (isv ? WS_VP : WS_KP)) + (size_t)m * 256 + kvh * 128; d[e0] = (bf16)f2bf(x0); d[e1] = (bf16)f2bf(x1);
            } else {
                bf16* d = (bf16*)(ws + (isv ? WS_VS : WS_KS)) + ((size_t)b * KALL + PAST + t) * 256 + kvh * 128; d[e0] = (bf16)f2bf(x0); d[e1] = (bf16)f2bf(x1);
            }
        }
        else if (ch < 16) { bf16* d = (bf16*)(ws + WS_QR) + (size_t)m * 512 + (ch - 12) * 128; d[e0] = (bf16)f2bf(x0); d[e1] = (bf16)f2bf(x1); }
        else { bf16* d = (bf16*)(ws + WS_KR) + (size_t)m * 512 + (ch - 16) * 128; d[e0] = (bf16)f2bf(x0); d[e1] = (bf16)f2bf(x1); }
    }
}

namespace mx {
using bf16x8 = __attribute__((ext_vector_type(8))) short;
using s16x4  = __attribute__((ext_vector_type(4))) short;
using f32x16 = __attribute__((ext_vector_type(16))) float;
using f32x8  = __attribute__((ext_vector_type(8))) float;
using u32x4  = __attribute__((ext_vector_type(4))) unsigned;
constexpr int D = 128, NW = 8, QBLK = 32, KVBLK = 64;
constexpr float SCALE = 0.088388347648318440f;
constexpr float THR = 8.f;
constexpr int SHM_V = KVBLK * D * 2, SHM_K = KVBLK * D * 2;
#define KSWZ(row, colB) ((row) * 256 + ((colB) ^ (((row) & 7) << 4)))
#define SBAR() __builtin_amdgcn_sched_barrier(0)
__device__ __forceinline__ int crow(int r, int hi) { return (r & 3) + 8 * (r >> 2) + 4 * hi; }
__device__ __forceinline__ unsigned cvtpk(float lo, float hi) { return pg8::cvt_pk_bf16(lo, hi); }
__device__ __forceinline__ bf16x8 ld8(const bf16* p) { return *reinterpret_cast<const bf16x8*>(p); }
__device__ __forceinline__ bf16x8 cvt8(f32x8 x) { u32x4 w = {cvtpk(x[0], x[1]), cvtpk(x[2], x[3]), cvtpk(x[4], x[5]), cvtpk(x[6], x[7])}; return *reinterpret_cast<bf16x8*>(&w); }

__device__ __forceinline__ void partialSM(f32x16& p0, f32x16& p1, float& m_reg, float& mn, float& alpha) {
  constexpr float C = SCALE * 1.4426950408889634f;
  float pmax = p0[0]; for (int r = 1; r < 16; ++r) pmax = fmaxf(pmax, p0[r]); for (int r = 0; r < 16; ++r) pmax = fmaxf(pmax, p1[r]);
  { auto rr = __builtin_amdgcn_permlane32_swap(__float_as_uint(pmax), __float_as_uint(pmax), false, false);
    pmax = fmaxf(__uint_as_float(rr[0]), __uint_as_float(rr[1])); }
  if (__builtin_expect(__all(pmax - m_reg <= THR / SCALE), 1)) { mn = m_reg; alpha = 1.f; }
  else { mn = fmaxf(m_reg, pmax); alpha = __builtin_amdgcn_exp2f((m_reg - mn) * C); m_reg = mn; }
  float mnC = -mn * C;
  for (int r = 0; r < 16; ++r) p0[r] = fmaf(p0[r], C, mnC); for (int r = 0; r < 16; ++r) p1[r] = fmaf(p1[r], C, mnC);
  for (int r = 0; r < 16; ++r) p0[r] = __builtin_amdgcn_exp2f(p0[r]);
}
#define PK4(P, BASE, OUT) do { unsigned a0 = cvtpk(P[BASE + 0], P[BASE + 1]), a1 = cvtpk(P[BASE + 2], P[BASE + 3]);   \
    unsigned b0 = cvtpk(P[BASE + 4], P[BASE + 5]), b1 = cvtpk(P[BASE + 6], P[BASE + 7]);                              \
    auto r0 = __builtin_amdgcn_permlane32_swap(a0, b0, false, false); auto r1 = __builtin_amdgcn_permlane32_swap(a1, b1, false, false); \
    u32x4 w = {r0[0], r1[0], r0[1], r1[1]}; OUT = *reinterpret_cast<bf16x8*>(&w); } while (0)
__device__ __forceinline__ void finishSM(f32x16& p0, f32x16& p1, float alpha, float& l_reg, bf16x8& pa0, bf16x8& pa1, bf16x8& pa2, bf16x8& pa3) {
  for (int r = 0; r < 16; ++r) p1[r] = __builtin_amdgcn_exp2f(p1[r]);
  float ps = 0; for (int r = 0; r < 16; ++r) ps += p0[r]; for (int r = 0; r < 16; ++r) ps += p1[r];
  { auto rr = __builtin_amdgcn_permlane32_swap(__float_as_uint(ps), __float_as_uint(ps), false, false);
    ps = __uint_as_float(rr[0]) + __uint_as_float(rr[1]); }
  l_reg = l_reg * alpha + ps;
  PK4(p0, 0, pa0); PK4(p0, 8, pa1); PK4(p1, 0, pa2); PK4(p1, 8, pa3);
}
__device__ __forceinline__ void packP(f32x16& p0, f32x16& p1, bf16x8& pa0, bf16x8& pa1, bf16x8& pa2, bf16x8& pa3) {
  PK4(p0, 0, pa0); PK4(p0, 8, pa1); PK4(p1, 0, pa2); PK4(p1, 8, pa3);
}
__device__ __forceinline__ void decayP(f32x16& p0, f32x16& p1, int e0  , float lgf, float nlgb, bool diag) {
  const float eb = (float)e0;
#pragma unroll
  for (int r = 0; r < 16; ++r) { const float c = (float)((r & 3) + 8 * (r >> 2));
    const float ea = eb - c, ec = eb - 32.f - c;
    float da = __builtin_amdgcn_exp2f(fminf(ea * lgf, ea * nlgb)), dc = __builtin_amdgcn_exp2f(fminf(ec * lgf, ec * nlgb));
    if (diag) { da = ea == 0.f ? 2.f : da; dc = ec == 0.f ? 2.f : dc; }
    p0[r] *= da; p1[r] *= dc; }
}
__device__ __forceinline__ void qkt(f32x16& p0, f32x16& p1, const LAS char* Ks, const bf16x8* qr, int r32, int hi) {
  p0 = f32x16{}; p1 = f32x16{};
#pragma unroll
  for (int d0 = 0; d0 < 8; ++d0) { int cb = (d0 * 16 + hi * 8) * 2;
    bf16x8 b0 = *reinterpret_cast<const LAS bf16x8*>(Ks + KSWZ(r32, cb));
    bf16x8 b1 = *reinterpret_cast<const LAS bf16x8*>(Ks + KSWZ(32 + r32, cb));
    p0 = __builtin_amdgcn_mfma_f32_32x32x16_bf16(b0, qr[d0], p0, 0, 0, 0);
    p1 = __builtin_amdgcn_mfma_f32_32x32x16_bf16(b1, qr[d0], p1, 0, 0, 0); }
}
__device__ __forceinline__ int v_st(int k, int c) { const int kk = (k & ~0xC) | ((k & 4) << 1) | ((k & 8) >> 1); return ((kk >> 3) * 4 + (c >> 5)) * 512 + ((kk & 7) * 32 + (c & 31)) * 2; }
__device__ __forceinline__ int v_rd_base(int lane) { return ((lane & 3) << 3) | (((lane >> 2) & 3) << 6) | (((lane >> 4) & 1) << 5) | (((lane >> 5) & 1) << 8); }
constexpr int v_rd_off(int d0, int ks, int half) { return d0 * 512 + ks * 4096 + half * 2048; }
template <int OFF> __device__ __forceinline__ s16x4 tr_read(int vb) {
  s16x4 r; asm volatile("ds_read_b64_tr_b16 %0, %1 offset:%2" : "=&v"(r) : "v"(vb), "i"(OFF) : "memory"); return r;
}
#define PKLH(L, H) (bf16x8){L[0], L[1], L[2], L[3], H[0], H[1], H[2], H[3]}
template <int D0> __device__ __forceinline__ void pv_one(f32x16& od, int vb, bf16x8 pa0, bf16x8 pa1, bf16x8 pa2, bf16x8 pa3) {
  const s16x4 l0 = tr_read<v_rd_off(D0, 0, 0)>(vb), h0 = tr_read<v_rd_off(D0, 0, 1)>(vb), l1 = tr_read<v_rd_off(D0, 1, 0)>(vb), h1 = tr_read<v_rd_off(D0, 1, 1)>(vb);
  const s16x4 l2 = tr_read<v_rd_off(D0, 2, 0)>(vb), h2 = tr_read<v_rd_off(D0, 2, 1)>(vb), l3 = tr_read<v_rd_off(D0, 3, 0)>(vb), h3 = tr_read<v_rd_off(D0, 3, 1)>(vb);
  asm volatile("s_waitcnt lgkmcnt(0)" ::: "memory"); SBAR();
  od = __builtin_amdgcn_mfma_f32_32x32x16_bf16(pa0, PKLH(l0, h0), od, 0, 0, 0);
  od = __builtin_amdgcn_mfma_f32_32x32x16_bf16(pa1, PKLH(l1, h1), od, 0, 0, 0);
  od = __builtin_amdgcn_mfma_f32_32x32x16_bf16(pa2, PKLH(l2, h2), od, 0, 0, 0);
  od = __builtin_amdgcn_mfma_f32_32x32x16_bf16(pa3, PKLH(l3, h3), od, 0, 0, 0);
}
__device__ __forceinline__ void pv_d0(f32x16* o, int vb, bf16x8 pa0, bf16x8 pa1, bf16x8 pa2, bf16x8 pa3) {
  pv_one<0>(o[0], vb, pa0, pa1, pa2, pa3); pv_one<1>(o[1], vb, pa0, pa1, pa2, pa3); pv_one<2>(o[2], vb, pa0, pa1, pa2, pa3); pv_one<3>(o[3], vb, pa0, pa1, pa2, pa3);
}

template <bool GN> __device__ __forceinline__ void store_tile(const f32x16* o, const float* rowscale  , LAS float* stg, bf16* Ow, int ldo, const bf16* Gw, int ldg, int lane) {
  const int r32 = lane & 31, hi = lane >> 5;
#pragma unroll
  for (int r = 0; r < 16; ++r) { const int orow = crow(r, hi);
#pragma unroll
    for (int d0 = 0; d0 < 4; ++d0) stg[orow * 128 + d0 * 32 + r32] = rowscale ? o[d0][r] * rowscale[r] : o[d0][r]; }
  asm volatile("s_waitcnt lgkmcnt(0)" ::: "memory");
  const int ch = lane & 15;
#pragma unroll
  for (int i = 0; i < 8; ++i) { const int row = (lane >> 4) + 4 * i;
    f32x4 a = *(const LAS f32x4*)(stg + row * 128 + ch * 8), b = *(const LAS f32x4*)(stg + row * 128 + ch * 8 + 4);
    if (GN) {
      float s = (a[0] + a[1]) + (a[2] + a[3]) + (b[0] + b[1]) + (b[2] + b[3]);
      s += shx<1>(s); s += shx<2>(s); s += shx<4>(s); s += shx<8>(s);
      const float mean = s * (1.f / 128.f); a = a - mean; b = b - mean;
      float q = (a[0] * a[0] + a[1] * a[1]) + (a[2] * a[2] + a[3] * a[3]) + (b[0] * b[0] + b[1] * b[1]) + (b[2] * b[2] + b[3] * b[3]);
      q += shx<1>(q); q += shx<2>(q); q += shx<4>(q); q += shx<8>(q);
      const float rs = 1.0f / sqrtf(q * (1.f / 128.f) + EPS);
      const v4u gw = *(const GAS v4u*)(Gw + (size_t)row * ldg + ch * 8);
      const float g0 = bflo(gw.x), g1 = bfhi(gw.x), g2 = bflo(gw.y), g3 = bfhi(gw.y), g4 = bflo(gw.z), g5 = bfhi(gw.z), g6 = bflo(gw.w), g7 = bfhi(gw.w);
      a[0] *= rs * g0 * pg8::fast_sigmoid(g0); a[1] *= rs * g1 * pg8::fast_sigmoid(g1); a[2] *= rs * g2 * pg8::fast_sigmoid(g2); a[3] *= rs * g3 * pg8::fast_sigmoid(g3);
      b[0] *= rs * g4 * pg8::fast_sigmoid(g4); b[1] *= rs * g5 * pg8::fast_sigmoid(g5); b[2] *= rs * g6 * pg8::fast_sigmoid(g6); b[3] *= rs * g7 * pg8::fast_sigmoid(g7);
    }
    u32x4 w = {cvtpk(a[0], a[1]), cvtpk(a[2], a[3]), cvtpk(b[0], b[1]), cvtpk(b[2], b[3])};
    *(GAS u32x4*)(Ow + (size_t)row * ldo + ch * 8) = w; }
  asm volatile("s_waitcnt lgkmcnt(0)" ::: "memory");
}

template <bool RET, int LDQ, int LDK, int LDV, int LDO>
__device__ __forceinline__ void unit_body(const bf16* __restrict__ Qb, const bf16* __restrict__ Kh, const bf16* __restrict__ Vh, bf16* __restrict__ Ob, int seq, LAS char* lds,
                                          int q0  , float lgf, float lgb, const float* S0f, const float* S0b, const bf16* Gb  , int tid0) {
  int tid_ = tid0; asm volatile("" : "+v"(tid_));
  const int tid = tid_, wid = __builtin_amdgcn_readfirstlane(tid >> 6), lane = tid & 63, r32 = lane & 31, hi = lane >> 5;
  LAS char* V_lds = lds; LAS char* K_lds = lds + 2 * SHM_V;
  LAS float* wsf = (LAS float*)(lds + 2 * SHM_V + 2 * SHM_K) + wid * 64; LAS float* li_l = wsf; LAS float* al_l = wsf + 32;
  float m_reg = -1e30f, l_reg = 0; f32x16 o[4] = {}; bf16x8 qr[8];
  const bf16* Qw = Qb + (long)(wid * QBLK + r32) * LDQ + hi * 8;
#pragma unroll
  for (int d0 = 0; d0 < 8; ++d0) qr[d0] = ld8(Qw + d0 * 16);
  const int sr = tid >> 4, sc = (tid & 15) * 8, vst0 = v_st(sr, sc), vst1 = v_st(32 + sr, sc);
  const int vb0 = (int)(unsigned)(size_t)V_lds + v_rd_base(lane);
  const float nlgb = -lgb;
  const int trow = q0 + wid * QBLK + r32;

  if (RET && S0f != nullptr) {
    f32x16 o2[4];
#pragma unroll
    for (int pass = 0; pass < 2; ++pass) {
      const float* S0 = pass == 0 ? S0f : S0b;
#pragma unroll
      for (int half = 0; half < 2; ++half) {
        const f32x8 x0 = *reinterpret_cast<const f32x8*>(S0 + (size_t)(half * 64 + sr) * 128 + sc), x1 = *reinterpret_cast<const f32x8*>(S0 + (size_t)(half * 64 + 32 + sr) * 128 + sc);
        *(LAS bf16x8*)(V_lds + half * SHM_V + vst0) = cvt8(x0); *(LAS bf16x8*)(V_lds + half * SHM_V + vst1) = cvt8(x1);
      }
      __syncthreads();
      if (pass == 0) { pv_d0(o, vb0, qr[0], qr[1], qr[2], qr[3]); pv_d0(o, vb0 + SHM_V, qr[4], qr[5], qr[6], qr[7]); }
      else { for (int d = 0; d < 4; ++d) o2[d] = f32x16{}; pv_d0(o2, vb0, qr[0], qr[1], qr[2], qr[3]); pv_d0(o2, vb0 + SHM_V, qr[4], qr[5], qr[6], qr[7]); }
      __syncthreads();
    }
#pragma unroll
    for (int r = 0; r < 16; ++r) { const int t = q0 + wid * QBLK + crow(r, hi);
      const float wf = __builtin_amdgcn_exp2f((float)(t + 1) * lgf), wb = __builtin_amdgcn_exp2f((float)(seq - t) * lgb);
#pragma unroll
      for (int d = 0; d < 4; ++d) o[d][r] = o[d][r] * wf + o2[d][r] * wb; }
  }

  struct { bf16x8 vs0, vs1, ks0, ks1; } sr_[2];
#define SLOAD(i, k0) do { sr_[i].vs0 = ld8(&Vh[(long)((k0) + sr) * LDV + sc]); sr_[i].vs1 = ld8(&Vh[(long)((k0) + 32 + sr) * LDV + sc]); \
    sr_[i].ks0 = ld8(&Kh[(long)((k0) + sr) * LDK + sc]); sr_[i].ks1 = ld8(&Kh[(long)((k0) + 32 + sr) * LDK + sc]); } while (0)
#define SWRITE(b, i) do { *(LAS bf16x8*)(V_lds + (b) * SHM_V + vst0) = sr_[i].vs0;          \
    *(LAS bf16x8*)(V_lds + (b) * SHM_V + vst1) = sr_[i].vs1; int kc = sc * 2;               \
    *(LAS bf16x8*)(K_lds + (b) * SHM_K + KSWZ(sr, kc)) = sr_[i].ks0;                       \
    *(LAS bf16x8*)(K_lds + (b) * SHM_K + KSWZ(32 + sr, kc)) = sr_[i].ks1; } while (0)
#define SWAIT() asm volatile("s_waitcnt vmcnt(4)" ::: "memory")
#define RESC(a) do { if (!RET) { if (__any((a) < 1.f)) { if (hi == 0) al_l[r32] = (a); asm volatile("s_waitcnt lgkmcnt(0)" ::: "memory"); \
    for (int d = 0; d < 4; ++d) for (int r = 0; r < 16; ++r) o[d][r] *= al_l[crow(r, hi)]; } } } while (0)
#define SM1(P0, P1, MN, AL, TILE) do { if (RET) { const int k0_ = (TILE) * KVBLK; const bool dg_ = (k0_ <= q0 + wid * QBLK + 31) && (k0_ + 63 >= q0 + wid * QBLK); \
      decayP(P0, P1, trow - k0_ - 4 * hi, lgf, nlgb, dg_); } else partialSM(P0, P1, m_reg, MN, AL); } while (0)
#define SM2(P0, P1, AL) do { if (RET) packP(P0, P1, pa0, pa1, pa2, pa3); else finishSM(P0, P1, AL, l_reg, pa0, pa1, pa2, pa3); } while (0)
  f32x16 pA0, pA1, pB0, pB1; float mnA = 0.f, mnB = 0.f, alA = 1.f, alB = 1.f; bf16x8 pa0, pa1, pa2, pa3; const int NT = seq / KVBLK;
  constexpr int SE = 0, SO = 1;
  SLOAD(SE, 0); asm volatile("s_waitcnt vmcnt(0)" ::: "memory"); SWRITE(0, SE); __syncthreads();
  qkt(pA0, pA1, K_lds, qr, r32, hi); SM1(pA0, pA1, mnA, alA, 0);
  SLOAD(SO, KVBLK); if (2 < NT) SLOAD(SE, 2 * KVBLK);
  SWAIT(); SWRITE(1, SO); __syncthreads();
  for (int j = 1; j + 1 < NT; j += 2) {
    SBAR(); qkt(pB0, pB1, K_lds + SHM_K, qr, r32, hi);
    SM2(pA0, pA1, alA); SBAR();
    SLOAD(SO, (j + 2) * KVBLK); SBAR();
    pv_d0(o, vb0, pa0, pa1, pa2, pa3); SM1(pB0, pB1, mnB, alB, j);
    __syncthreads(); SWAIT(); SWRITE(0, SE);
    RESC(alB); __syncthreads();
    SBAR(); qkt(pA0, pA1, K_lds, qr, r32, hi);
    SM2(pB0, pB1, alB); SBAR();
    if (j + 3 < NT) SLOAD(SE, (j + 3) * KVBLK); SBAR();
    pv_d0(o, vb0 + (int)SHM_V, pa0, pa1, pa2, pa3); SM1(pA0, pA1, mnA, alA, j + 1);
    __syncthreads(); SWAIT(); SWRITE(1, SO);
    RESC(alA); __syncthreads();
  }
  SBAR(); qkt(pB0, pB1, K_lds + SHM_K, qr, r32, hi);
  SM2(pA0, pA1, alA); SBAR();
  pv_d0(o, vb0, pa0, pa1, pa2, pa3); SM1(pB0, pB1, mnB, alB, NT - 1);
  __syncthreads(); RESC(alB);
  SM2(pB0, pB1, alB); SBAR();
  pv_d0(o, vb0 + (int)SHM_V, pa0, pa1, pa2, pa3);
  float rli[16];
  if (!RET) {
    if (hi == 0) li_l[r32] = l_reg; asm volatile("s_waitcnt lgkmcnt(0)" ::: "memory");
#pragma unroll
    for (int r = 0; r < 16; ++r) rli[r] = __builtin_amdgcn_rcpf(li_l[crow(r, hi)]);
  }
  __syncthreads();
  LAS float* stg = (LAS float*)(lds + wid * 16384);
  store_tile<RET>(o, RET ? nullptr : rli, stg, Ob + (size_t)(wid * QBLK) * LDO, LDO, RET ? Gb + (size_t)(wid * QBLK) * INW : nullptr, INW, lane);
  __syncthreads();
#undef SLOAD
#undef SWRITE
#undef SWAIT
#undef RESC
#undef SM1
#undef SM2
}

__device__ __forceinline__ void ret_state_unit(const bf16* __restrict__ Kh  , const bf16* __restrict__ Vh  , float* __restrict__ outF, float* __restrict__ outB, float lgf, float lgb, LAS char* lds, int tid0) {
  int tid_ = tid0; asm volatile("" : "+v"(tid_));
  const int tid = tid_, wid = __builtin_amdgcn_readfirstlane(tid >> 6), lane = tid & 63, r32 = lane & 31, hi = lane >> 5;
  const int sr = tid >> 4, sc = (tid & 15) * 8, vst0 = v_st(sr, sc), vst1 = v_st(32 + sr, sc);
  LAS char* KF = lds; LAS char* KB = lds + 16384; LAS char* VV = lds + 32768;
  const int dir = wid >> 2, Dd = wid & 3;
  const int ab = (int)(unsigned)(size_t)(dir ? KB : KF) + v_rd_base(lane) + Dd * 512;
  const int bb = (int)(unsigned)(size_t)VV + v_rd_base(lane);
  f32x16 acc[4] = {};
  for (int tile = 0; tile < SEQ / 64; ++tile) {
    const int s0 = tile * 64 + sr, s1 = s0 + 32;
    const bf16x8 k0 = ld8(Kh + (size_t)s0 * 512 + sc), k1 = ld8(Kh + (size_t)s1 * 512 + sc), v0 = ld8(Vh + (size_t)s0 * INW + sc), v1 = ld8(Vh + (size_t)s1 * INW + sc);
    const float wf0 = exp2f((float)(SEQ - 1 - s0) * lgf), wf1 = exp2f((float)(SEQ - 1 - s1) * lgf), wb0 = exp2f((float)s0 * lgb), wb1 = exp2f((float)s1 * lgb);
    f32x8 x0, x1;
#pragma unroll
    for (int j = 0; j < 8; ++j) { x0[j] = bf2f((unsigned short)k0[j]); x1[j] = bf2f((unsigned short)k1[j]); }
    *(LAS bf16x8*)(KF + vst0) = cvt8(x0 * wf0); *(LAS bf16x8*)(KF + vst1) = cvt8(x1 * wf1);
    *(LAS bf16x8*)(KB + vst0) = cvt8(x0 * wb0); *(LAS bf16x8*)(KB + vst1) = cvt8(x1 * wb1);
    *(LAS bf16x8*)(VV + vst0) = v0; *(LAS bf16x8*)(VV + vst1) = v1;
    __syncthreads();
#define RS_STEP(KS) do { const s16x4 al = tr_read<v_rd_off(0, KS, 0)>(ab), ah = tr_read<v_rd_off(0, KS, 1)>(ab); \
      const s16x4 l0 = tr_read<v_rd_off(0, KS, 0)>(bb), h0 = tr_read<v_rd_off(0, KS, 1)>(bb), l1 = tr_read<v_rd_off(1, KS, 0)>(bb), h1 = tr_read<v_rd_off(1, KS, 1)>(bb); \
      const s16x4 l2 = tr_read<v_rd_off(2, KS, 0)>(bb), h2 = tr_read<v_rd_off(2, KS, 1)>(bb), l3 = tr_read<v_rd_off(3, KS, 0)>(bb), h3 = tr_read<v_rd_off(3, KS, 1)>(bb); \
      asm volatile("s_waitcnt lgkmcnt(0)" ::: "memory"); SBAR(); const bf16x8 af = PKLH(al, ah); \
      acc[0] = __builtin_amdgcn_mfma_f32_32x32x16_bf16(af, PKLH(l0, h0), acc[0], 0, 0, 0); acc[1] = __builtin_amdgcn_mfma_f32_32x32x16_bf16(af, PKLH(l1, h1), acc[1], 0, 0, 0); \
      acc[2] = __builtin_amdgcn_mfma_f32_32x32x16_bf16(af, PKLH(l2, h2), acc[2], 0, 0, 0); acc[3] = __builtin_amdgcn_mfma_f32_32x32x16_bf16(af, PKLH(l3, h3), acc[3], 0, 0, 0); } while (0)
    RS_STEP(0); RS_STEP(1); RS_STEP(2); RS_STEP(3);
#undef RS_STEP
    __syncthreads();
  }
  float* out = dir ? outB : outF;
#pragma unroll
  for (int r = 0; r < 16; ++r) { const int d = Dd * 32 + crow(r, hi);
#pragma unroll
    for (int e = 0; e < 4; ++e) out[(size_t)d * 128 + e * 32 + r32] = acc[e][r]; }
}

#ifndef S5_OLD_FMA
#define S5_OLD_FMA 0
#endif
#ifndef S5_OLD_ADDR
#define S5_OLD_ADDR 0
#endif
using f32x4m = __attribute__((ext_vector_type(4))) float;
__device__ __forceinline__ unsigned cvtpk_s(float lo, float hi) { return pg8::cvt_pk_bf16(lo, hi); }
__device__ __forceinline__ float gelu_fast(float x) { const float u = 0.7978845608028654f * (x + 0.044715f * x * x * x); return x * pg8::fast_sigmoid(2.0f * u); }
template <bool OUT, int DIR>
__device__ __forceinline__ void s5_seg_d(KA a, int l, int m0, int t_lo, int len, int g, float& hr, float& hi_, LAS char* wl, int lane) {
  unsigned char* ws = a->ws;
  const bf16* proj = (const bf16*)(ws + WS_PROJ);
  float* YS = (float*)(ws + WS_YS); bf16* YSB = (bf16*)(ws + WS_YSB);
  const int r32 = lane & 31, hi = lane >> 5, fr = lane & 15, q = lane >> 4;
  LAS float* BU = (LAS float*)wl;
  const int ldg = (l * 2 + DIR) * 32 + g;
  const float* lamT = (const float*)(ws + WS_LAM) + ((size_t)ldg * 64 + lane) * 2;
  const float lr = lamT[0], li = lamT[1], nli = -li;
  bf16x8 bfr[4], cfr[4]; float dcoef = 0.f;
  {
    const float* bbT = (const float*)(ws + WS_BBAR);
#pragma unroll
    for (int pb = 0; pb < 2; ++pb) { const GAS f32x4* bp = (const GAS f32x4*)(bbT + (((size_t)ldg * 64 + 32 * pb + r32) * 16 + 8 * hi) * 2);
      const f32x4 w0 = bp[0], w1 = bp[1], w2 = bp[2], w3 = bp[3];
      bfr[pb] = cvt8((f32x8){w0[0], w0[2], w1[0], w1[2], w2[0], w2[2], w3[0], w3[2]});
      bfr[2 + pb] = cvt8((f32x8){w0[1], w0[3], w1[1], w1[3], w2[1], w2[3], w3[1], w3[3]}); }
    if (OUT) {
      dcoef = a->in[I_SSMD][l * 512 + g * 16 + fr];
      const float* cre = a->in[I_CRE] + ((size_t)ldg * 16 + fr) * 64 + 4 * q; const float* cim = a->in[I_CIM] + ((size_t)ldg * 16 + fr) * 64 + 4 * q;
#pragma unroll
      for (int ks = 0; ks < 4; ++ks) { const f32x4 cr = *(const GAS f32x4*)(cre + 16 * ks), ci = *(const GAS f32x4*)(cim + 16 * ks);
        cfr[ks] = cvt8((f32x8){cr[0], -ci[0], cr[1], -ci[1], cr[2], -ci[2], cr[3], -ci[3]}); }
    }
  }
  LAS unsigned* hw[16];
#pragma unroll
  for (int j = 0; j < 16; ++j) hw[j] = (LAS unsigned*)BU + (lane ^ (4 * j));
  const LAS bf16x8* hrd[4];
#pragma unroll
  for (int ks = 0; ks < 4; ++ks) hrd[ks] = (const LAS bf16x8*)((LAS unsigned*)BU + fr * 128 + ((16 * ks + 4 * q) ^ (4 * fr)));
  const LAS float* brd = BU + lane;
  const int NC = len / 32;
  const bf16* ubase = proj + (size_t)m0 * INW + C_US + g * 16;
#define S5_T0(c) (DIR == 0 ? t_lo + 32 * (c) : t_lo + len - 32 * ((c) + 1))
  bf16x8 ua_next = ld8(ubase + (size_t)(S5_T0(0) + r32) * INW + 8 * hi);
#pragma unroll 1
  for (int c = 0; c < NC; ++c) {
    const int T0 = S5_T0(c);
    const bf16x8 ua = ua_next;
    if (c + 1 < NC) ua_next = ld8(ubase + (size_t)(S5_T0(c + 1) + r32) * INW + 8 * hi);
    float ysv[8]; unsigned short uv[8];
    const size_t mrow = (size_t)(m0 + T0 + 4 * q);
    if (OUT && DIR == 0) {
#pragma unroll
      for (int k = 0; k < 8; ++k) { const size_t m = mrow + 16 * (k >> 2) + (k & 3); ysv[k] = YS[m * 512 + g * 16 + fr]; uv[k] = proj[m * INW + C_US + g * 16 + fr]; }
    }
#pragma unroll
    for (int tile = 0; tile < 4; ++tile) {
      const f32x16 d = __builtin_amdgcn_mfma_f32_32x32x16_bf16(ua, bfr[tile], f32x16{}, 0, 0, 0);
#pragma unroll
      for (int r = 0; r < 16; ++r) BU[crow(r, hi) * 128 + tile * 32 + r32] = d[r];
    }
    asm volatile("s_waitcnt lgkmcnt(0)" ::: "memory");
#pragma unroll
    for (int half = 0; half < 2; ++half) {
      float bre[16], bim[16];
#pragma unroll
      for (int k = 0; k < 16; ++k) { constexpr int dummy = 0; const int i = DIR == 0 ? half * 16 + k : 31 - half * 16 - k; bre[k] = brd[i * 128]; bim[k] = brd[i * 128 + 64]; }
      asm volatile("s_waitcnt lgkmcnt(0)" ::: "memory");
#pragma unroll
      for (int k = 0; k < 16; ++k) { const int i = DIR == 0 ? half * 16 + k : 31 - half * 16 - k;
#if S5_OLD_FMA
        const float nr = lr * hr - li * hi_ + bre[k], ni = lr * hi_ + li * hr + bim[k]; hr = nr; hi_ = ni;
#else
        const float nr = fmaf(lr, hr, fmaf(nli, hi_, bre[k])), ni = fmaf(lr, hi_, fmaf(li, hr, bim[k])); hr = nr; hi_ = ni;
#endif
#if S5_OLD_ADDR
        if (OUT) ((LAS unsigned*)BU)[i * 128 + (lane ^ (4 * (i & 15)))] = cvtpk(hr, hi_); }
#else
        if (OUT) hw[i & 15][i * 128] = cvtpk_s(hr, hi_); }
#endif
    }
    if (OUT) {
      asm volatile("s_waitcnt lgkmcnt(0)" ::: "memory");
#pragma unroll
      for (int mt = 0; mt < 2; ++mt) {
        f32x4m y = {0.f, 0.f, 0.f, 0.f};
#pragma unroll
        for (int ks = 0; ks < 4; ++ks) {
#if S5_OLD_ADDR
          const int i_ = 16 * mt + fr; const bf16x8 hf = *(const LAS bf16x8*)((LAS unsigned*)BU + i_ * 128 + ((16 * ks + 4 * q) ^ (4 * (i_ & 15))));
#else
          const bf16x8 hf = hrd[ks][mt * 16 * 32];
#endif
          y = __builtin_amdgcn_mfma_f32_16x16x32_bf16(hf, cfr[ks], y, 0, 0, 0); }
#pragma unroll
        for (int rg = 0; rg < 4; ++rg) { const size_t m = mrow + 16 * mt + rg;
          if (DIR == 1) YS[m * 512 + g * 16 + fr] = y[rg];
          else { const float yt = y[rg] + ysv[mt * 4 + rg] + dcoef * bf2f(uv[mt * 4 + rg]);
            YSB[m * 512 + g * 16 + fr] = (bf16)f2bf(gelu_fast(yt)); } }
      }
    }
    asm volatile("s_waitcnt lgkmcnt(0)" ::: "memory");
  }
  asm volatile("s_waitcnt vmcnt(0)" ::: "memory");
#undef S5_T0
}
template <bool OUT>
__device__ __forceinline__ void s5_seg(KA a, int l, int m0, int t_lo, int len, int g, int dir, float& hr, float& hi_, LAS char* wl, int lane) {
  if (dir == 0) s5_seg_d<OUT, 0>(a, l, m0, t_lo, len, g, hr, hi_, wl, lane); else s5_seg_d<OUT, 1>(a, l, m0, t_lo, len, g, hr, hi_, wl, lane);
}
__device__ __forceinline__ void s5_ctx_wave(KA a, int l, int b, int g, LAS char* lds, int tid0) {
  int tid_ = tid0; asm volatile("" : "+v"(tid_));
  const int lane = tid_ & 63; LAS char* wl = lds + __builtin_amdgcn_readfirstlane(tid_ >> 6) * 16384;
#pragma unroll 1
  for (int dir = 1; dir >= 0; --dir) {
    float hr = 0.f, hi_ = 0.f;
    s5_seg<true>(a, l, b * SEQ, 0, SEQ, g, dir, hr, hi_, wl, lane);
    float* o = a->out + O_SSM + (((((size_t)b * NLAYER + l) * 2 + dir) * 32 + g) * 64 + lane) * 2; o[0] = hr; o[1] = hi_;
  }
}
constexpr int S5X_OFF = RING_BYTES + 1024;
__device__ __forceinline__ void s5_lat_unit(KA a, int l, int v  , LAS char* lds, int tid0) {
  int tid_ = tid0; asm volatile("" : "+v"(tid_));
  const int lane = tid_ & 63, wid = __builtin_amdgcn_readfirstlane(tid_ >> 6); LAS char* wl = lds + wid * 16384;
  const int pr = wid >> 2, seg = wid & 3, bg = 2 * v + pr, b = bg >> 5, g = bg & 31;
  const int m0 = NPR + b * DSEQ;
  LAS float* X = (LAS float*)(lds + S5X_OFF);
#pragma unroll 1
  for (int dir = 1; dir >= 0; --dir) {
    float hr = 0.f, hi_ = 0.f;
    const bool last = dir == 0 ? seg == 3 : seg == 0;
    if (!last) s5_seg<false>(a, l, m0, seg * 256, 256, g, dir, hr, hi_, wl, lane);
    X[(((pr * 2 + dir) * 4 + seg) * 64 + lane) * 2] = hr; X[(((pr * 2 + dir) * 4 + seg) * 64 + lane) * 2 + 1] = hi_;
  }
  __syncthreads();
#pragma unroll 1
  for (int dir = 1; dir >= 0; --dir) {
    const int ldg = (l * 2 + dir) * 32 + g;
    const float* lamT = (const float*)(a->ws + WS_LAM) + ((size_t)ldg * 64 + lane) * 2;
    float pr_ = lamT[0], pi_ = lamT[1];
#pragma unroll
    for (int k = 0; k < 8; ++k) { const float nr = pr_ * pr_ - pi_ * pi_, ni = 2.f * pr_ * pi_; pr_ = nr; pi_ = ni; }
    const float* h0 = a->in[I_SSSM] + (((((size_t)b * NLAYER + l) * 2 + dir) * 32 + g) * 64 + lane) * 2;
    float hr = h0[0], hi_ = h0[1];
    const int nprev = dir == 0 ? seg : 3 - seg;
    for (int k = 0; k < nprev; ++k) { const int sk = dir == 0 ? k : 3 - k;
      const float fr_ = X[(((pr * 2 + dir) * 4 + sk) * 64 + lane) * 2], fi_ = X[(((pr * 2 + dir) * 4 + sk) * 64 + lane) * 2 + 1];
      const float nr = pr_ * hr - pi_ * hi_ + fr_, ni = pr_ * hi_ + pi_ * hr + fi_; hr = nr; hi_ = ni; }
    s5_seg<true>(a, l, m0, seg * 256, 256, g, dir, hr, hi_, wl, lane);
  }
}
#undef KSWZ
#undef SBAR
#undef PK4
#undef PKLH
}

__device__ __forceinline__ void decay_log2(KA a, int l, int h, float& lgf, float& lgb) {
    const float xf = a->in[I_DECAY][(l * 2 + 0) * 4 + h], xb = a->in[I_DECAY][(l * 2 + 1) * 4 + h];
    lgf = -log1pf(expf(-xf)) * 1.4426950408889634f; lgb = -log1pf(expf(-xb)) * 1.4426950408889634f;
}

constexpr int MX_NBIG = 128, MX_NUNITS = 448;
__device__ __forceinline__ void mixer_unit(const Frame& F, KA a, int l, int u, int kmask) {
  unsigned char* ws = a->ws; LAS char* lds = (LAS char*)F.lds;
  const bf16* proj = (const bf16*)(ws + WS_PROJ);
  int kind, lat, b, h = 0, qb = 0, v;
  const int wv_ = F.wave;
  if (u < 64) { kind = 0; lat = 1; qb = u & 3; h = (u >> 2) & 7; b = u >> 5; }
  else if (u < 96) { v = u - 64; kind = 1; lat = 1; qb = v & 3; h = (v >> 2) & 3; b = v >> 4; }
  else if (u < 128) { v = u - 96; kind = 2; lat = 1; b = 0; h = v; }
  else if (u < 256) { v = u - 128; kind = 0; lat = 0; h = v & 7; b = v >> 3; }
  else if (u < 320) { v = u - 256; kind = 1; lat = 0; h = v & 3; b = v >> 2; }
  else if (u < 384) { v = (u - 320) * 8 + wv_; kind = 2; lat = 0; b = v >> 5; h = v & 31; }
  else { v = u - 384; kind = 3; lat = 0; h = v & 3; b = v >> 2; }
  if (!((kmask >> (kind + 4 * lat)) & 1)) return;
  const size_t m0 = lat ? NPR + (size_t)b * DSEQ : (size_t)b * SEQ;
  const size_t m = m0 + (size_t)qb * 256;
  const int L = lat ? DSEQ : SEQ;
#ifndef MXK
#define MXK 15
#endif
  if (kind == 0) { if (MXK & 1) {
    const bf16* Kb = lat ? (const bf16*)(ws + WS_KS) + (size_t)b * KALL * 256 : (const bf16*)(ws + WS_KP) + m0 * 256;
    const bf16* Vb = lat ? (const bf16*)(ws + WS_VS) + (size_t)b * KALL * 256 : (const bf16*)(ws + WS_VP) + m0 * 256;
    mx::unit_body<false, 1024, 256, 256, DM>((const bf16*)(ws + WS_QB) + m * 1024 + h * 128, Kb + (h >> 2) * 128, Vb + (h >> 2) * 128, (bf16*)(ws + WS_MIX) + m * DM + h * 128,
        lat ? KALL : SEQ, lds, 0, 0.f, 0.f, nullptr, nullptr, nullptr, F.tid); }
  } else if (kind == 1) { if (MXK & 2) {
    float lgf, lgb; decay_log2(a, l, h, lgf, lgb);
    const float* S0f = lat ? a->in[I_SRET] + ((((size_t)b * NLAYER + l) * 2 + 0) * 4 + h) * 16384 : nullptr;
    const float* S0b = lat ? a->in[I_SRET] + ((((size_t)b * NLAYER + l) * 2 + 1) * 4 + h) * 16384 : nullptr;
    mx::unit_body<true, 512, 512, INW, DM>((const bf16*)(ws + WS_QR) + m * 512 + h * 128, (const bf16*)(ws + WS_KR) + m0 * 512 + h * 128, proj + m0 * INW + C_VR + h * 128,
        (bf16*)(ws + WS_MIX) + m * DM + 1536 + h * 128, L, lds, qb * 256, lgf, lgb, S0f, S0b, proj + m * INW + C_GR + h * 128, F.tid); }
  } else if (kind == 2) { if (MXK & 4)
    if (lat) mx::s5_lat_unit(a, l, h, lds, F.tid); else mx::s5_ctx_wave(a, l, b, h, lds, F.tid);
  } else if (MXK & 8) {
    float lgf, lgb; decay_log2(a, l, h, lgf, lgb);
    float* oF = a->out + O_RET + ((((size_t)b * NLAYER + l) * 2 + 0) * 4 + h) * 16384; float* oB = a->out + O_RET + ((((size_t)b * NLAYER + l) * 2 + 1) * 4 + h) * 16384;
    mx::ret_state_unit((const bf16*)(ws + WS_KR) + m0 * 512 + h * 128, proj + m0 * INW + C_VR + h * 128, oF, oB, lgf, lgb, lds, F.tid);
  }
}
__device__ __forceinline__ void phase_mixer(const Frame& F, KA a, int l, int kmask = 255) {
  const int w = blockIdx.x;
  if (F.G == 256) {
    if (w < MX_NBIG) { mixer_unit(F, a, l, w, kmask); __syncthreads(); }
    else { for (int u = w; u < MX_NUNITS; u += 256 - MX_NBIG) { mixer_unit(F, a, l, u, kmask); __syncthreads(); } }
  } else { for (int u = w; u < MX_NUNITS; u += F.G) { mixer_unit(F, a, l, u, kmask); __syncthreads(); } }
}

constexpr int N_PHASES = 26;

template <class Epi> __device__ __forceinline__ void run_gemm(const Frame& F, const bf16* A, const bf16* Bt, int N, int K, const Epi& E) {
    pg8::Gemm g{A, Bt, MT, N, K}; pg8::StaticOrder S; S.init(MT, N, F.G, (int)blockIdx.x);
    pg8::gemm_phase<Epi, pg8::StaticOrder, true, true>(F.lds, g, S, E, F.tid);
}

__device__ __forceinline__ int cur_tid(int widS) { unsigned z = 0; asm volatile("" : "+s"(z)); const int lane = (int)__builtin_amdgcn_mbcnt_hi(~0u, __builtin_amdgcn_mbcnt_lo(~0u, z)); return widS * 64 + lane; }
__device__ __forceinline__ Frame mkframe(LAS unsigned char* lds, int widS) {
    Frame F; F.tid = cur_tid(widS);
    F.lds = lds; F.lane = F.tid & 63; F.wave = widS;
    F.G = gridDim.x; F.gw = blockIdx.x * NWAVES + F.wave; F.NGW = F.G * NWAVES; return F;
}
#define FR mkframe((LAS unsigned char*)lds, widS)
__global__ void __launch_bounds__(NWAVES * 64, 2) trunk_fwd(KArgs args) {
    extern __shared__ __attribute__((aligned(16))) unsigned char lds[];
    const int widS = __builtin_amdgcn_readfirstlane((int)threadIdx.x >> 6);
    volatile LAS unsigned* MISC = (volatile LAS unsigned*)((LAS unsigned char*)lds + MISC_OFF);
    for (int u = threadIdx.x; u < (LDS_BYTES - LDSCTL_OFF) / 4; u += NWAVES * 64) ((LAS unsigned*)((LAS unsigned char*)lds + LDSCTL_OFF))[u] = 0u;
    __syncthreads();
    unsigned* ctl = (unsigned*)(args.ws + WS_CTL);
    XcdBarrier bar; bar.bar = ctl + CW_BAR; bar.x = 0; bar.st = nullptr;
    const bool multi = (args.ph_hi - args.ph_lo) > 1;
    if (multi) bar = xcd_barrier_post(ctl + CW_BAR, MISC + 8);

    for (int ph = args.ph_lo; ph < args.ph_hi; ++ph) {
        KA ap; { unsigned long long p_ = (unsigned long long)__builtin_amdgcn_kernarg_segment_ptr(); asm volatile("" : "+s"(p_)); ap = (KA)p_; }
        unsigned char* ws = ap->ws;
#ifndef PH_MASK
#define PH_MASK 0xFFFF
#endif
#ifndef MIXER_DUP_KMASK
#define MIXER_DUP_KMASK 255
#endif
#ifndef DUP_MASK
#define DUP_MASK 0
#endif
#define DUPB(bit, stmt) for (int rep_ = (DUP_MASK & (bit)) ? 0 : 1; rep_ < 2; ++rep_) { stmt; if (rep_ == 0) xcd_barrier(bar, cur_tid(widS)); }
        if (ph == 0) { if (DUP_MASK & 1) { phase_prologue(FR, ap, 8); xcd_barrier(bar, cur_tid(widS)); } if (DUP_MASK & 512) { phase_prologue(FR, ap, 4); xcd_barrier(bar, cur_tid(widS)); } if (PH_MASK & 1) phase_prologue(FR, ap); }
        else if (ph == N_PHASES - 1) { DUPB(2, phase_prenorm(FR, ap, 0, 3)) }
        else {
            const int l = (ph - 1) / 12, s = (ph - 1) % 12;
            const float* modl = (const float*)(ws + WS_MOD) + (size_t)l * 3 * MODW;
            switch (s) {
                case 0: DUPB(2, phase_prenorm(FR, ap, l, 0)); break;
                case 3: DUPB(2, phase_prenorm(FR, ap, l, 1)); break;
                case 9: DUPB(2, phase_prenorm(FR, ap, l, 2)); break;
                case 1: case 10: {
                    const int i = s == 1 ? 0 : 1;
                    pg8::EpiPair<0> E{(bf16*)(ws + WS_ACT), DFF, 0};
                    DUPB(4, run_gemm(FR, (const bf16*)(ws + WS_H), (const bf16*)(ws + WS_WFI) + (size_t)(l * 2 + i) * 2 * DFF * DM, 2 * DFF, DM, E)); break; }
                case 2: case 11: {
                    const int i = s == 2 ? 0 : 1, sub = s == 2 ? 0 : 2;
                    pg8::EpiResid E{(float*)(ws + WS_XR), modl + sub * 3 * DM + 2 * DM, MODW, 0.5f};
                    DUPB(8, { pg8::EpiResid E0 = E; if (rep_ == 0) E0.s = 0.f; run_gemm(FR, (const bf16*)(ws + WS_ACT), (const bf16*)(ws + WS_WFO) + (size_t)(l * 2 + i) * DM * DFF, DM, DFF, E0); }); break; }
                case 4: {
                    pg8::EpiBf16 E{(bf16*)(ws + WS_PROJ), INW};
                    DUPB(16, run_gemm(FR, (const bf16*)(ws + WS_H), (const bf16*)(ws + WS_WIN) + (size_t)l * INW * DM, INW, DM, E)); break; }
                case 5: DUPB(32, phase_qkvpost(FR, ap, l)); break;
                case 6: DUPB(64, phase_mixer(FR, ap, l, rep_ == 0 ? MIXER_DUP_KMASK : 255)); break;
                case 7: {
                    pg8::EpiPair<1> E{(bf16*)(ws + WS_MIX), DM, 1024};
                    DUPB(128, run_gemm(FR, (const bf16*)(ws + WS_YSB), (const bf16*)(ws + WS_WGLU) + (size_t)l * 1024 * 512, 1024, 512, E)); break; }
                case 8: {
                    pg8::EpiResid E{(float*)(ws + WS_XR), modl + 1 * 3 * DM + 2 * DM, MODW, 1.0f};
                    DUPB(256, { pg8::EpiResid E0 = E; if (rep_ == 0) E0.s = 0.f; run_gemm(FR, (const bf16*)(ws + WS_MIX), (const bf16*)(ws + WS_WOUT) + (size_t)l * DM * DM, DM, DM, E0); }); break; }
                default: break;
            }
        }
        if (ph + 1 < args.ph_hi) xcd_barrier(bar, cur_tid(widS));
    }
}

extern "C" void kernel_launch(void* const* d_in, const int* in_sizes, int n_in, void* d_out, int out_size, void* d_ws, size_t ws_size, hipStream_t stream) {
    static int grid = 0;
    if (grid == 0) {
        if (n_in != 28 || out_size != (int)O_END || ws_size < WS_END) { fprintf(stderr, "kernel_launch: unexpected shapes: n_in %d out %d ws %zu (need >= %zu)\n", n_in, out_size, ws_size, (size_t)WS_END); grid = -1; return; }
        int dev = 0, cus = 0, per_cu = 0;
        if (hipGetDevice(&dev) != hipSuccess || hipDeviceGetAttribute(&cus, hipDeviceAttributeMultiprocessorCount, dev) != hipSuccess) { fprintf(stderr, "kernel_launch: device query failed\n"); grid = -1; return; }
        if (hipFuncSetAttribute((const void*)trunk_fwd, hipFuncAttributeMaxDynamicSharedMemorySize, LDS_BYTES) != hipSuccess) { fprintf(stderr, "kernel_launch: hipFuncSetAttribute failed\n"); grid = -1; return; }
        if (hipOccupancyMaxActiveBlocksPerMultiprocessor(&per_cu, (const void*)trunk_fwd, NWAVES * 64, LDS_BYTES) != hipSuccess || per_cu < 1) { fprintf(stderr, "kernel_launch: occupancy query says %d blocks per CU\n", per_cu); (void)hipGetLastError(); grid = -1; return; }
        grid = cus;
        if (grid > 256) grid = 256;
    }
    if (grid < 0) return;
    (void)hipMemsetAsync((char*)d_ws + WS_CTL, 0, CTL_ZERO_BYTES, stream);
    KArgs a{};
    for (int i = 0; i < 28; ++i) a.in[i] = (const float*)d_in[i];
    a.out = (float*)d_out; a.ws = (unsigned char*)d_ws;
#if MK_ONE_LAUNCH
    a.ph_lo = 0; a.ph_hi = N_PHASES; a.li = 0;
    hipLaunchKernelGGL(trunk_fwd, dim3(grid), dim3(NWAVES * 64), LDS_BYTES, stream, a);
#else
    for (int ph = 0; ph < N_PHASES; ++ph) { a.ph_lo = ph; a.ph_hi = ph + 1; a.li = ph;
        hipLaunchKernelGGL(trunk_fwd, dim3(grid), dim3(NWAVES * 64), LDS_BYTES, stream, a); }
#endif
    const hipError_t le = hipPeekAtLastError();
    if (le != hipSuccess) fprintf(stderr, "kernel_launch: launch failed: %s\n", hipGetErrorName(le));
}
```

```cpp
#define MK_ONE_LAUNCH 1
#include <hip/hip_runtime.h>
#include <cstdio>
#include <cstdint>
#include <cmath>

constexpr int DM = 2048, NPR = 4096, NSR = 2048, MT = 6144, DFF = 5632, INW = 4096;
constexpr int SEQ = 256, DSEQ = 1024, PAST = 512, NBP = 16, NBS = 2, NLAYER = 2;
constexpr int KALL = PAST + DSEQ;
constexpr int MODW = 9 * DM;
constexpr float EPS = 1e-6f;
constexpr int C_QA = 0, C_KA = 1024, C_VA = 1280, C_US = 1536, C_QR = 2048, C_KR = 2560, C_VR = 3072, C_GR = 3584;
constexpr size_t O_Y = 0, O_CK = 12582912, O_CV = 14680064, O_SSM = 16777216, O_RET = 17039360, O_END = 21233664;

namespace pg8 {
#define PG8_LAS __attribute__((address_space(3)))
typedef unsigned short bf16_t;
typedef short bf16x8 __attribute__((ext_vector_type(8)));
typedef float f32x4 __attribute__((ext_vector_type(4)));
typedef unsigned u32x4 __attribute__((ext_vector_type(4)));
constexpr int BM = 256, BK = 64, HALF = 128, HTB = HALF * BK * 2, STAGE_BYTES = 8 * HTB, NXCD = 8, WGM = 8;

__host__ __device__ __forceinline__ int lds_byte(int r, int c) { const int st = (r >> 4) * 2 + (c >> 5), rr = r & 15, cc = c & 31, ob = rr * 64 + cc * 2; return st * 1024 + (ob ^ (((ob >> 9) & 1) << 5)); }
__host__ __device__ __forceinline__ void stage_rc(int b, int& R, int& C) { const int st = b / 1024, sb = b % 1024, swz = sb ^ (((sb >> 9) & 1) << 5); R = (st >> 1) * 16 + swz / 64; C = (st & 1) * 32 + (swz % 64) / 2; }
__host__ __device__ __forceinline__ int perm32(int rho) { const int n = rho >> 4, i = rho & 15; return 8 * (i >> 2) + 4 * n + (i & 3); }

struct Unit { int pm, pn; };
struct Gemm { const bf16_t* A; const bf16_t* Bt; int M, N, K; };

struct StaticOrder {
    int nM, nN, nwg, G, c;
    __host__ __device__ void init(int M, int N, int G_, int c_) { nM = M / BM; nN = N / BM; nwg = nM * nN; G = G_; c = c_; }
    __host__ __device__ bool next(int i, Unit& u) const {
        const long L = (long)i * G + c; if (L >= nwg) return false;
        int wgid = (int)L; { const int q = nwg / NXCD, r = nwg % NXCD, xcd = wgid % NXCD, off = wgid / NXCD; wgid = (xcd < r ? xcd * (q + 1) : r * (q + 1) + (xcd - r) * q) + off; }
        const int nig = WGM * nN, gid = wgid / nig, fm = gid * WGM, gsz = (nM - fm) < WGM ? (nM - fm) : WGM;
        u.pm = fm + ((wgid % nig) % gsz); u.pn = (wgid % nig) / gsz; return true;
    }
    __device__ __forceinline__ void a_ready(const Unit&) const {}
    __device__ __forceinline__ void done(const Unit&) const {}
};

typedef float f32x2_t __attribute__((ext_vector_type(2))); typedef __bf16 bf16x2_t __attribute__((ext_vector_type(2)));
__device__ __forceinline__ unsigned cvt_pk_bf16(float lo, float hi) { f32x2_t v = {lo, hi}; bf16x2_t b = __builtin_convertvector(v, bf16x2_t); return __builtin_bit_cast(unsigned, b); }
__device__ __forceinline__ float fast_sigmoid(float x) { return __builtin_amdgcn_rcpf(1.0f + __builtin_amdgcn_exp2f(-1.4426950408889634f * x)); }

struct EpiBf16 {
    static constexpr bool PERM = true, AFTER_DRAIN = false;
    bf16_t* O; int ldc;
    __device__ __forceinline__ void operator()(const f32x4 (&acc)[2][2][4][2], const Unit& u, int wr, int wc, int fr, int fq) const {
        const int row0 = u.pm * BM + wr * 64 + fr; const int col0 = u.pn * BM + wc * 32 + 8 * fq;
#pragma unroll
        for (int ai = 0; ai < 2; ++ai)
#pragma unroll
            for (int m = 0; m < 4; ++m) { bf16_t* rowp = O + (size_t)(row0 + ai * HALF + m * 16) * ldc + col0;
#pragma unroll
                for (int bj = 0; bj < 2; ++bj) { const f32x4 v0 = acc[ai][bj][m][0], v1 = acc[ai][bj][m][1];
                    u32x4 w; w.x = cvt_pk_bf16(v0[0], v0[1]); w.y = cvt_pk_bf16(v0[2], v0[3]); w.z = cvt_pk_bf16(v1[0], v1[1]); w.w = cvt_pk_bf16(v1[2], v1[3]);
                    *(u32x4*)(rowp + bj * HALF) = w; } }
    }
};
template <int ACT> struct EpiPair {
    static constexpr bool PERM = true, AFTER_DRAIN = false;
    bf16_t* O; int ldc; int coff;
    __device__ __forceinline__ void operator()(const f32x4 (&acc)[2][2][4][2], const Unit& u, int wr, int wc, int fr, int fq) const {
        const int row0 = u.pm * BM + wr * 64 + fr; const int col0 = coff + u.pn * HALF + wc * 32 + 8 * fq;
#pragma unroll
        for (int ai = 0; ai < 2; ++ai)
#pragma unroll
            for (int m = 0; m < 4; ++m) { bf16_t* rowp = O + (size_t)(row0 + ai * HALF + m * 16) * ldc + col0;
                float r[8];
#pragma unroll
                for (int n = 0; n < 2; ++n)
#pragma unroll
                    for (int j = 0; j < 4; ++j) { const float a = acc[ai][0][m][n][j], g = acc[ai][1][m][n][j];
                        r[n * 4 + j] = (ACT == 0) ? a * fast_sigmoid(a) * g : a * fast_sigmoid(g); }
                u32x4 w; w.x = cvt_pk_bf16(r[0], r[1]); w.y = cvt_pk_bf16(r[2], r[3]); w.z = cvt_pk_bf16(r[4], r[5]); w.w = cvt_pk_bf16(r[6], r[7]);
                *(u32x4*)rowp = w; }
    }
};
struct EpiResid {
    static constexpr bool PERM = false, AFTER_DRAIN = false;
    float* X; const float* gate0; int gstride; float s;
    __device__ __forceinline__ void operator()(const f32x4 (&acc)[2][2][4][2], const Unit& u, int wr, int wc, int fr, int fq) const {
        const int row0 = u.pm * BM + wr * 64 + fr, col0 = u.pn * BM + wc * 32 + 4 * fq;
        const int var = u.pm < 16 ? 0 : (u.pm < 20 ? 1 : 2);
        const float* gp = gate0 + (size_t)var * gstride + col0;
        f32x4 gv[2][2];
#pragma unroll
        for (int bj = 0; bj < 2; ++bj)
#pragma unroll
            for (int n = 0; n < 2; ++n) gv[bj][n] = *(const f32x4*)(gp + bj * HALF + n * 16) * s;
#pragma unroll
        for (int ai = 0; ai < 2; ++ai)
#pragma unroll
            for (int m = 0; m < 4; ++m) { float* rowp = X + (size_t)(row0 + ai * HALF + m * 16) * DM + col0;
#pragma unroll
                for (int bj = 0; bj < 2; ++bj)
#pragma unroll
                    for (int n = 0; n < 2; ++n) { float* p = rowp + bj * HALF + n * 16; const f32x4 x = *(const f32x4*)p; *(f32x4*)p = x + gv[bj][n] * acc[ai][bj][m][n]; } }
    }
};

template <class Epi, class Sched, bool ALIGN_EPI = false, bool SP2 = false>
__device__ __forceinline__ void gemm_phase(PG8_LAS unsigned char* lds, const Gemm g, const Sched& S, const Epi& E, int tid0) {
    int tid_ = tid0; asm volatile("" : "+v"(tid_));
    const int tid = tid_, wid = __builtin_amdgcn_readfirstlane(tid >> 6), lane = tid & 63, wr = wid >> 2, wc = wid & 3, fr = lane & 15, fq = lane >> 4;
    const int K = g.K, nt = K / BK;
    unsigned voffA[2], voffB[2];
#pragma unroll
    for (int i = 0; i < 2; ++i) { int R, C; stage_rc(tid * 16 + i * 8192, R, C); const int Rb = Epi::PERM ? ((R & ~31) + perm32(R & 31)) : R;
        voffA[i] = (unsigned)(R * K + C) * 2u; voffB[i] = (unsigned)(Rb * K + C) * 2u; }
    const size_t kstep = (size_t)(BK * 2);
    const size_t hstep = (size_t)HALF * K * 2;
    const size_t tstep = 2 * hstep;
    const unsigned ldsw = (unsigned)wid * 1024u;
    const int aoff = lds_byte(wr * 64 + fr, fq * 8), boff = lds_byte(wc * 32 + fr, fq * 8);
#define PG8_SA(b, h) (((b) * 2 + (h)) * HTB)
#define PG8_SB(b, h) ((4 + (b) * 2 + (h)) * HTB)
#define PG8_STAGE(bufoff, gbase, voff) do { _Pragma("unroll") for (int _i = 0; _i < 2; ++_i) \
        __builtin_amdgcn_global_load_lds((const unsigned*)((const char*)(gbase) + (voff)[_i]), (PG8_LAS unsigned*)(lds + (bufoff) + ldsw + _i * 8192), 16, 0, 0); } while (0)
#define PG8_LDA(dst, b, h) do { _Pragma("unroll") for (int m = 0; m < 4; ++m) _Pragma("unroll") for (int k = 0; k < 2; ++k) dst[m][k] = *(const PG8_LAS bf16x8*)(lds + PG8_SA(b, h) + aoff + m * 2048 + k * 1024); } while (0)
#define PG8_LDB(dst, b, h) do { _Pragma("unroll") for (int n = 0; n < 2; ++n) _Pragma("unroll") for (int k = 0; k < 2; ++k) dst[n][k] = *(const PG8_LAS bf16x8*)(lds + PG8_SB(b, h) + boff + n * 2048 + k * 1024); } while (0)
#define PG8_MMA(ai, bj, At, Bt) do { __builtin_amdgcn_s_setprio(1); _Pragma("unroll") for (int m = 0; m < 4; ++m) _Pragma("unroll") for (int n = 0; n < 2; ++n) _Pragma("unroll") for (int k = 0; k < 2; ++k) \
        acc[ai][bj][m][n] = __builtin_amdgcn_mfma_f32_16x16x32_bf16(Bt[n][k], At[m][k], acc[ai][bj][m][n], 0, 0, 0); __builtin_amdgcn_s_setprio(0); } while (0)
#define PG8_WAIT_V(n) asm volatile("s_waitcnt vmcnt(" #n ")" ::: "memory")
#define PG8_WAIT_L(n) asm volatile("s_waitcnt lgkmcnt(" #n ")" ::: "memory")
#define PG8_BAR __builtin_amdgcn_s_barrier()
#define PG8_SCHED __builtin_amdgcn_sched_barrier(0)
    Unit cur, nxt; int ui = 0;
    if (!S.next(0, cur)) return;
    f32x4 acc[2][2][4][2];
#pragma unroll
    for (int a = 0; a < 2; ++a)
#pragma unroll
        for (int b = 0; b < 2; ++b)
#pragma unroll
            for (int m = 0; m < 4; ++m)
#pragma unroll
                for (int n = 0; n < 2; ++n) acc[a][b][m][n] = (f32x4){0.f, 0.f, 0.f, 0.f};
    bf16x8 At[4][2], B0[2][2], B1[2][2];
    const char* cA = (const char*)g.A + (size_t)cur.pm * tstep; const char* cB = (const char*)g.Bt + (size_t)cur.pn * tstep;
    S.a_ready(cur);
    if constexpr (SP2) {
        PG8_STAGE(PG8_SB(0, 0), cB, voffB); PG8_STAGE(PG8_SB(0, 1), cB + hstep, voffB); PG8_STAGE(PG8_SA(0, 0), cA, voffA); PG8_STAGE(PG8_SA(0, 1), cA + hstep, voffA);
        if (wr == 1) PG8_BAR;
        PG8_WAIT_V(2); PG8_BAR;
        PG8_STAGE(PG8_SB(1, 0), cB + kstep, voffB); PG8_STAGE(PG8_SA(1, 0), cA + kstep, voffA); PG8_STAGE(PG8_SB(1, 1), cB + hstep + kstep, voffB);
        PG8_WAIT_V(6); PG8_BAR;
    } else {
        PG8_STAGE(PG8_SB(0, 0), cB, voffB); PG8_STAGE(PG8_SA(0, 0), cA, voffA); PG8_STAGE(PG8_SB(0, 1), cB + hstep, voffB); PG8_STAGE(PG8_SA(0, 1), cA + hstep, voffA);
        if (wr == 1) PG8_BAR;
        PG8_WAIT_V(4); PG8_BAR;
        PG8_STAGE(PG8_SB(1, 0), cB + kstep, voffB); PG8_STAGE(PG8_SA(1, 0), cA + kstep, voffA); PG8_STAGE(PG8_SB(1, 1), cB + hstep + kstep, voffB);
        PG8_WAIT_V(6); PG8_BAR;
    }
    for (;;) {
        const bool has_next = S.next(ui + 1, nxt);
        const char* nA = has_next ? (const char*)g.A + (size_t)nxt.pm * tstep : cA; const char* nB = has_next ? (const char*)g.Bt + (size_t)nxt.pn * tstep : cB;
        for (int t = 0; t < nt; t += 2) {
            const bool last = (t == nt - 2);
            const char* a1 = cA + (size_t)(t + 1) * kstep;
            const char* a2 = last ? nA : cA + (size_t)(t + 2) * kstep; const char* b2 = last ? nB : cB + (size_t)(t + 2) * kstep;
            const char* a3 = a2 + kstep; const char* b3 = b2 + kstep;
            if (last && has_next) S.a_ready(nxt);
            if constexpr (SP2) {
            PG8_LDB(B0, 0, 0); PG8_LDB(B1, 0, 1); PG8_SCHED; PG8_LDA(At, 0, 0); PG8_STAGE(PG8_SA(1, 1), a1 + hstep, voffA);
            PG8_WAIT_V(8); PG8_WAIT_L(0); PG8_BAR; PG8_MMA(0, 0, At, B0); PG8_MMA(0, 1, At, B1); PG8_BAR; PG8_SCHED;
            PG8_LDA(At, 0, 1); PG8_STAGE(PG8_SB(0, 0), b2, voffB); PG8_STAGE(PG8_SB(0, 1), b2 + hstep, voffB); PG8_STAGE(PG8_SA(0, 0), a2, voffA);
            PG8_WAIT_V(8); PG8_WAIT_L(0); PG8_BAR; PG8_MMA(1, 0, At, B0); PG8_MMA(1, 1, At, B1); PG8_BAR; PG8_SCHED;
            PG8_LDB(B0, 1, 0); PG8_LDB(B1, 1, 1); PG8_SCHED; PG8_LDA(At, 1, 0); PG8_STAGE(PG8_SA(0, 1), a2 + hstep, voffA);
            PG8_WAIT_V(8); PG8_WAIT_L(0); PG8_BAR; PG8_MMA(0, 0, At, B0); PG8_MMA(0, 1, At, B1); PG8_BAR; PG8_SCHED;
            PG8_LDA(At, 1, 1); PG8_STAGE(PG8_SB(1, 0), b3, voffB); PG8_STAGE(PG8_SB(1, 1), b3 + hstep, voffB); PG8_STAGE(PG8_SA(1, 0), a3, voffA);
            PG8_WAIT_V(8); PG8_WAIT_L(0); PG8_BAR; PG8_MMA(1, 0, At, B0); PG8_MMA(1, 1, At, B1); PG8_BAR; PG8_SCHED;
            } else {
            PG8_LDB(B0, 0, 0); PG8_SCHED; PG8_LDA(At, 0, 0); PG8_STAGE(PG8_SA(1, 1), a1 + hstep, voffA);
            PG8_WAIT_L(8); PG8_BAR; PG8_WAIT_L(0); PG8_MMA(0, 0, At, B0); PG8_BAR; PG8_SCHED;
            PG8_LDB(B1, 0, 1); PG8_STAGE(PG8_SB(0, 0), b2, voffB);
            PG8_BAR; PG8_WAIT_L(0); PG8_MMA(0, 1, At, B1); PG8_BAR;
            PG8_LDA(At, 0, 1); PG8_STAGE(PG8_SA(0, 0), a2, voffA);
            PG8_BAR; PG8_WAIT_L(0); PG8_MMA(1, 0, At, B0); PG8_BAR; PG8_SCHED;
            PG8_STAGE(PG8_SB(0, 1), b2 + hstep, voffB);
            PG8_WAIT_V(6); PG8_BAR; PG8_MMA(1, 1, At, B1); PG8_BAR;
            PG8_LDB(B0, 1, 0); PG8_SCHED; PG8_LDA(At, 1, 0); PG8_STAGE(PG8_SA(0, 1), a2 + hstep, voffA);
            PG8_WAIT_L(8); PG8_BAR; PG8_WAIT_L(0); PG8_MMA(0, 0, At, B0); PG8_BAR; PG8_SCHED;
            PG8_LDB(B1, 1, 1); PG8_STAGE(PG8_SB(1, 0), b3, voffB);
            PG8_BAR; PG8_WAIT_L(0); PG8_MMA(0, 1, At, B1); PG8_BAR;
            PG8_LDA(At, 1, 1); PG8_STAGE(PG8_SA(1, 0), a3, voffA);
            PG8_BAR; PG8_WAIT_L(0); PG8_MMA(1, 0, At, B0); PG8_BAR; PG8_SCHED;
            PG8_STAGE(PG8_SB(1, 1), b3 + hstep, voffB);
            PG8_WAIT_V(6); PG8_BAR; PG8_MMA(1, 1, At, B1); PG8_BAR;
            }
        }
        if constexpr (ALIGN_EPI) { if (wr == 0) PG8_BAR; }
        if constexpr (!Epi::AFTER_DRAIN) { E(acc, cur, wr, wc, fr, fq); S.done(cur); }
        if (!has_next) break;
#pragma unroll
        for (int a = 0; a < 2; ++a)
#pragma unroll
            for (int b = 0; b < 2; ++b)
#pragma unroll
                for (int m = 0; m < 4; ++m)
#pragma unroll
                    for (int n = 0; n < 2; ++n) acc[a][b][m][n] = (f32x4){0.f, 0.f, 0.f, 0.f};
        cur = nxt; cA = nA; cB = nB; ++ui;
        if constexpr (ALIGN_EPI) { if (wr == 1) PG8_BAR; }
    }
    PG8_WAIT_V(0);
    if constexpr (!ALIGN_EPI) { if (wr == 0) PG8_BAR; }
    PG8_BAR;
    if constexpr (Epi::AFTER_DRAIN) { E.fused(acc, cur, wr, wc, fr, fq, lds, wid, lane); S.done(cur); }
#undef PG8_SA
#undef PG8_SB
#undef PG8_STAGE
#undef PG8_LDA
#undef PG8_LDB
#undef PG8_MMA
#undef PG8_WAIT_V
#undef PG8_WAIT_L
#undef PG8_BAR
#undef PG8_SCHED
}
}

typedef unsigned short bf16;
typedef unsigned v4u __attribute__((ext_vector_type(4)));
typedef float f32x4 __attribute__((ext_vector_type(4)));
#define GAS __attribute__((address_space(1)))
#define LAS __attribute__((address_space(3)))
typedef GAS unsigned gu32;
#define RLX_AGENT __ATOMIC_RELAXED, __HIP_MEMORY_SCOPE_AGENT
#define LDS_WAIT() asm volatile("s_waitcnt lgkmcnt(0)" ::: "memory")
#define VM_WAIT() asm volatile("s_waitcnt vmcnt(0)" ::: "memory")

constexpr int NWAVES = 8;
#ifndef MIXER_NAIVE
#define MIXER_NAIVE 0
#endif
#ifndef MK_ONE_LAUNCH
#define MK_ONE_LAUNCH 0
#endif
constexpr size_t MiB = 1u << 20;
constexpr size_t WS_CTL = 0, CTL_ZERO_BYTES = 2 * MiB;
constexpr size_t WS_MOD = 1 * MiB;
constexpr size_t WS_COS = 2 * MiB, WS_SIN = 2 * MiB + 256 * 1024, WS_LAM = 2 * MiB + 512 * 1024, WS_BBAR = 3 * MiB;
constexpr size_t WS_WFI = 8 * MiB, WS_WFO = 184 * MiB, WS_WIN = 272 * MiB, WS_WOUT = 304 * MiB, WS_WGLU = 320 * MiB;
constexpr size_t WS_XR = 322 * MiB, WS_H = 370 * MiB, WS_ACT = 394 * MiB, WS_PROJ = 460 * MiB, WS_QB = 508 * MiB;
constexpr size_t WS_KP = 520 * MiB, WS_VP = 522 * MiB, WS_KS = 524 * MiB, WS_VS = 526 * MiB, WS_QR = 528 * MiB, WS_KR = 534 * MiB;
constexpr size_t WS_MIX = 540 * MiB, WS_YS = 564 * MiB, WS_YSB = 576 * MiB, WS_END = 582 * MiB;
constexpr int CW_BAR = 4096;
constexpr int RING_BYTES = 131072, LDSCTL_OFF = RING_BYTES, MISC_OFF = LDSCTL_OFF + 320, LDS_BYTES = 147456;

__device__ __forceinline__ unsigned f2bf(float f) { unsigned u = __builtin_bit_cast(unsigned, f); return (u + 0x7fffu + ((u >> 16) & 1u)) >> 16; }
__device__ __forceinline__ unsigned pk2(float lo, float hi) { return f2bf(lo) | (f2bf(hi) << 16); }
__device__ __forceinline__ float bf2f(unsigned short h) { return __builtin_bit_cast(float, (unsigned)h << 16); }
__device__ __forceinline__ float bflo(unsigned w) { return __builtin_bit_cast(float, w << 16); }
__device__ __forceinline__ float bfhi(unsigned w) { return __builtin_bit_cast(float, w & 0xffff0000u); }

#define XB_TMO      128
#define XB_XCNT(j)  (256  + 64 * (j))
#define XB_XSUB(j)  (1280 + 64 * (j))
#define XB_XGEN(j)  (2304 + 64 * (j))
#define XB_TOP      3328
#define XB_TOPGEN   3392
#define XCD_BAR_WORDS 3456
#define XB_SPIN_CAP (1u << 18)
__device__ __forceinline__ unsigned xb_ld(unsigned* p)              { return __hip_atomic_load(p, __ATOMIC_RELAXED, __HIP_MEMORY_SCOPE_AGENT); }
__device__ __forceinline__ unsigned xb_add(unsigned* p, unsigned v) { return __hip_atomic_fetch_add(p, v, __ATOMIC_RELAXED, __HIP_MEMORY_SCOPE_AGENT); }
__device__ __forceinline__ unsigned xb_xcc_id() { return (unsigned)__builtin_amdgcn_s_getreg((3 << 11) | 20) & 0xFu; }
#define XB_SPIN(cond, bar) do { unsigned _sp = 0; while (cond) { __builtin_amdgcn_s_sleep(1); \
    if ((++_sp & 255u) == 0u) { if (xb_ld(&(bar)[XB_TMO])) break; if (_sp > XB_SPIN_CAP) { atomicAdd(&(bar)[XB_TMO], 1u); break; } } } } while (0)
struct XcdBarrier { unsigned* bar; unsigned x; volatile LAS unsigned* st; };
__device__ __forceinline__ XcdBarrier xcd_barrier_post(unsigned* bar, volatile LAS unsigned* st) {
    XcdBarrier b; b.bar = bar; b.x = xb_xcc_id(); b.st = st;
    if (threadIdx.x == 0) (void)xb_add(&bar[XB_XCNT(b.x)], 1u);
    return b;
}
__device__ __forceinline__ void xcd_barrier_complete(unsigned* bar, unsigned x, unsigned& nloc, unsigned& nx) {
    const unsigned G = gridDim.x * gridDim.y * gridDim.z;
    unsigned sum, cnt, mine, sp = 0u;
    for (;;) {
        sum = 0u; cnt = 0u; mine = 0u;
#pragma unroll
        for (unsigned j = 0; j < 16; ++j) { const unsigned c = xb_ld(&bar[XB_XCNT(j)]); sum += c; cnt += (c > 0u) ? 1u : 0u; mine = (j == x) ? c : mine; }
        if (sum == G) break;
        __builtin_amdgcn_s_sleep(1);
        if ((++sp & 255u) == 0u) { if (xb_ld(&bar[XB_TMO])) break; if (sp > XB_SPIN_CAP) { atomicAdd(&bar[XB_TMO], 1u); break; } }
    }
    nloc = mine > 0u ? mine : 1u; nx = cnt > 0u ? cnt : 1u;
}
__device__ __forceinline__ void xcd_barrier(const XcdBarrier& b, int tid) {
    asm volatile("s_waitcnt vmcnt(0)" ::: "memory");
    __syncthreads();
    if (tid == 0) {
        unsigned* bar = b.bar; asm volatile("" : "+s"(bar));
        __builtin_amdgcn_s_waitcnt(0);
        unsigned nloc = b.st[0], nx = b.st[1];
        if (nloc == 0u) { xcd_barrier_complete(bar, b.x, nloc, nx); b.st[0] = nloc; b.st[1] = nx; }
        const unsigned old = xb_add(&bar[XB_XSUB(b.x)], 1u);
        const unsigned gen = old / nloc;
        if (old + 1u == (gen + 1u) * nloc) {
            __builtin_amdgcn_fence(__ATOMIC_RELEASE, "agent");
            asm volatile("s_waitcnt vmcnt(0)" ::: "memory");
            const unsigned og = xb_add(&bar[XB_TOP], 1u);
            const unsigned tg = og / nx;
            if (og + 1u == (tg + 1u) * nx) xb_add(&bar[XB_TOPGEN], 1u);
            else XB_SPIN(xb_ld(&bar[XB_TOPGEN]) == tg, bar);
            __builtin_amdgcn_fence(__ATOMIC_ACQUIRE, "agent");
            xb_add(&bar[XB_XGEN(b.x)], 1u);
            asm volatile("s_waitcnt vmcnt(0)" ::: "memory");
        } else {
            XB_SPIN(xb_ld(&bar[XB_XGEN(b.x)]) == gen, bar);
            __builtin_amdgcn_fence(__ATOMIC_ACQUIRE, "agent");
            asm volatile("s_waitcnt vmcnt(0)" ::: "memory");
        }
    }
    __syncthreads();
}

struct KArgs { const float* in[28]; float* out; unsigned char* ws; int ph_lo, ph_hi, li, pad; };
typedef const __attribute__((address_space(4))) KArgs* KA;
enum { I_XP = 0, I_XS, I_CK, I_CV, I_SSSM, I_SRET, I_C, I_CCTX, I_WMOD, I_BMOD, I_NORMG, I_WFI, I_WFO, I_WIN, I_WOUT, I_QNG, I_KNG,
       I_ARE, I_AIM, I_LOGDT, I_BRE, I_BIM, I_CRE, I_CIM, I_SSMD, I_WGLU, I_DECAY, I_FNG };

struct Frame {
    LAS unsigned char* lds;
    int tid, lane, wave, G, gw, NGW;
};

template <int O> __device__ __forceinline__ float shx(float v) { return __builtin_bit_cast(float, __builtin_amdgcn_ds_swizzle(__builtin_bit_cast(int, v), (O << 10) | 0x1f)); }
__device__ __forceinline__ float wave_sum(float v) {
    v += shx<1>(v); v += shx<2>(v); v += shx<4>(v); v += shx<8>(v); v += shx<16>(v);
    const auto rr = __builtin_amdgcn_permlane32_swap(__float_as_uint(v), __float_as_uint(v), false, false);
    return __uint_as_float(rr[0]) + __uint_as_float(rr[1]);
}
__device__ __forceinline__ float wave_max(float v) {
    v = fmaxf(v, shx<1>(v)); v = fmaxf(v, shx<2>(v)); v = fmaxf(v, shx<4>(v)); v = fmaxf(v, shx<8>(v)); v = fmaxf(v, shx<16>(v));
    const auto rr = __builtin_amdgcn_permlane32_swap(__float_as_uint(v), __float_as_uint(v), false, false);
    return fmaxf(__uint_as_float(rr[0]), __uint_as_float(rr[1]));
}
__device__ __forceinline__ float silu_f(float x) { return x / (1.0f + __expf(-x)); }
__device__ __forceinline__ float gelu_tanh(float x) { const float u = 0.7978845608028654f * (x + 0.044715f * x * x * x); return 0.5f * x * (1.0f + tanhf(u)); }

__device__ __forceinline__ void p0_transpose_item(const float* W, int K, int N, bf16* WT, int halfN, LAS float* scr, int item, int lane) {
    const int nblk = N / 32, kb = item / nblk, nb = item % nblk, k0 = 64 * kb, n0 = 32 * nb;
    int R0 = n0;
    if (halfN) { if (n0 < halfN) R0 = 256 * (n0 >> 7) + (n0 & 127); else { const int n1 = n0 - halfN; R0 = 256 * (n1 >> 7) + 128 + (n1 & 127); } }
    float wv[32];
    const float* wsrc = W + (size_t)(k0 + (lane >> 5)) * N + n0 + (lane & 31);
#pragma unroll
    for (int i = 0; i < 32; ++i) wv[i] = __builtin_nontemporal_load(wsrc + (size_t)(2 * i) * N);
#pragma unroll
    for (int i = 0; i < 32; ++i) scr[(2 * i + (lane >> 5)) * 33 + (lane & 31)] = wv[i];
    LDS_WAIT(); asm volatile("" ::: "memory");
    const int c = lane & 7;
#pragma unroll
    for (int j = 0; j < 4; ++j) { const int n = (lane >> 3) + 8 * j; const LAS float* s = scr + (8 * c) * 33 + n;
        v4u o; o.x = pk2(s[0 * 33], s[1 * 33]); o.y = pk2(s[2 * 33], s[3 * 33]); o.z = pk2(s[4 * 33], s[5 * 33]); o.w = pk2(s[6 * 33], s[7 * 33]);
        __builtin_nontemporal_store(o, (GAS v4u*)(WT + (size_t)(R0 + n) * K + k0 + 8 * c)); }
    LDS_WAIT(); asm volatile("" ::: "memory");
}

__device__ __forceinline__ void mod_stage(const Frame& F, KA a) {
    LAS float* cs = (LAS float*)(F.lds);
    for (int i = F.tid; i < 3 * DM; i += 512) { const int v = i / DM, k = i % DM; const float c = v == 0 ? a->in[I_CCTX][k] : a->in[I_C][(v - 1) * DM + k]; cs[i] = silu_f(c); }
    __syncthreads();
}
__device__ __forceinline__ void mod_task(const Frame& F, KA a, int task) {
    LAS float* cs = (LAS float*)(F.lds); LAS float* red = (LAS float*)(F.lds + 24576);
    float* modb = (float*)(a->ws + WS_MOD);
    const int l = task / 576, r = task % 576, cb = r / 8, kc = r % 8;
    const int kbase = kc * 256 + F.wave * 32, col = cb * 256 + F.lane * 4;
    const float* wp = a->in[I_WMOD] + ((size_t)l * DM + kbase) * MODW + col;
    f32x4 s0 = {0, 0, 0, 0}, s1 = s0, s2 = s0;
#pragma unroll 8
    for (int k = 0; k < 32; ++k) { const f32x4 w = __builtin_nontemporal_load((const GAS f32x4*)(wp + (size_t)k * MODW));
        s0 += w * cs[kbase + k]; s1 += w * cs[DM + kbase + k]; s2 += w * cs[2 * DM + kbase + k]; }
    LAS float* rp = red + (F.wave * 64 + F.lane) * 12;
#pragma unroll
    for (int j = 0; j < 4; ++j) { rp[j] = s0[j]; rp[4 + j] = s1[j]; rp[8 + j] = s2[j]; }
    __syncthreads();
    for (int o = F.tid; o < 768; o += 512) { const int v = o >> 8, c = o & 255; float s = 0.f;
#pragma unroll
        for (int w = 0; w < 8; ++w) s += red[(w * 64 + (c >> 2)) * 12 + v * 4 + (c & 3)];
        if (kc == 0) s += a->in[I_BMOD][l * MODW + cb * 256 + c];
        unsafeAtomicAdd(modb + ((size_t)l * 3 + v) * MODW + cb * 256 + c, s); }
    __syncthreads();
}
constexpr int I_FI = (DM / 64) * (2 * DFF / 32), I_FO = (DFF / 64) * (DM / 32), I_IN = (DM / 64) * (INW / 32), I_OUT = (DM / 64) * (DM / 32), I_GL = (512 / 64) * (1024 / 32);
__device__ __forceinline__ int conv_items(int id) { return id < 4 ? I_FI : id < 8 ? I_FO : id < 10 ? I_IN : id < 12 ? I_OUT : I_GL; }
__device__ __forceinline__ void conv_item(KA a, int id, int it, LAS float* scr, int lane) {
    unsigned char* ws = a->ws;
    if (id < 4) p0_transpose_item(a->in[I_WFI] + (size_t)id * DM * 2 * DFF, DM, 2 * DFF, (bf16*)(ws + WS_WFI) + (size_t)id * 2 * DFF * DM, DFF, scr, it, lane);
    else if (id < 8) p0_transpose_item(a->in[I_WFO] + (size_t)(id - 4) * DFF * DM, DFF, DM, (bf16*)(ws + WS_WFO) + (size_t)(id - 4) * DM * DFF, 0, scr, it, lane);
    else if (id < 10) p0_transpose_item(a->in[I_WIN] + (size_t)(id - 8) * DM * INW, DM, INW, (bf16*)(ws + WS_WIN) + (size_t)(id - 8) * INW * DM, 0, scr, it, lane);
    else if (id < 12) p0_transpose_item(a->in[I_WOUT] + (size_t)(id - 10) * DM * DM, DM, DM, (bf16*)(ws + WS_WOUT) + (size_t)(id - 10) * DM * DM, 0, scr, it, lane);
    else p0_transpose_item(a->in[I_WGLU] + (size_t)(id - 12) * 512 * 1024, 512, 1024, (bf16*)(ws + WS_WGLU) + (size_t)(id - 12) * 1024 * 512, 512, scr, it, lane);
}
constexpr int CW_Q = 8192;
__device__ __forceinline__ int slot_mat(int slot, int j) {
    switch (slot) {
        case 0: return j == 0 ? 0 : -1;
        case 1: return j == 0 ? 4 : j == 1 ? 8 : j == 2 ? 10 : 12;
        case 2: return j == 0 ? 1 : j == 1 ? 5 : -1;
        case 4: return j == 0 ? 9 : j == 1 ? 11 : j == 2 ? 13 : -1;
        case 5: return j == 0 ? 2 : -1;
        case 6: return j == 0 ? 6 : j == 1 ? 3 : -1;
        case 7: return j == 0 ? 7 : -1;
        default: return -1;
    }
}
__device__ __forceinline__ void side_jobs(const Frame& F, KA a, int slot) {
    if (slot < 0) return;
    LAS unsigned* qb = (LAS unsigned*)(F.lds + 126976);
    unsigned* qc = (unsigned*)(a->ws + WS_CTL) + CW_Q + 64 * slot;
    if (slot == 3) {
        mod_stage(F, a);
        for (;;) {
            if (F.tid == 0) *qb = __hip_atomic_fetch_add(qc, 1u, __ATOMIC_RELAXED, __HIP_MEMORY_SCOPE_AGENT);
            __syncthreads();
            const unsigned t = *qb;
            if (t >= 576u) break;
            mod_task(F, a, 576 + (int)t);
        }
        __syncthreads();
        return;
    }
    int n0 = 0, n1 = 0, n2 = 0, n3 = 0;
    { const int m0 = slot_mat(slot, 0), m1 = slot_mat(slot, 1), m2 = slot_mat(slot, 2), m3 = slot_mat(slot, 3);
      n0 = m0 >= 0 ? conv_items(m0) : 0; n1 = n0 + (m1 >= 0 ? conv_items(m1) : 0); n2 = n1 + (m2 >= 0 ? conv_items(m2) : 0); n3 = n2 + (m3 >= 0 ? conv_items(m3) : 0); }
    LAS float* scr = (LAS float*)(F.lds + 49152 + F.wave * 8704);
    for (;;) {
        if (F.tid == 0) *qb = __hip_atomic_fetch_add(qc, 64u, __ATOMIC_RELAXED, __HIP_MEMORY_SCOPE_AGENT);
        __syncthreads();
        const int base = (int)*qb;
        if (base >= n3) break;
        const int end = base + 64 < n3 ? base + 64 : n3;
        for (int it = base + F.wave; it < end; it += 8) {
            const int j = it < n0 ? 0 : it < n1 ? 1 : it < n2 ? 2 : 3;
            conv_item(a, slot_mat(slot, j), it - (j == 0 ? 0 : j == 1 ? n0 : j == 2 ? n1 : n2), scr, F.lane);
        }
        __syncthreads();
    }
    __syncthreads();
}

__device__ __forceinline__ void phase_prologue(const Frame& F, KA a, int parts = 15) {
    unsigned char* ws = a->ws;
    if (parts & 1) {
        mod_stage(F, a);
        for (int task = blockIdx.x; task < 576; task += F.G) mod_task(F, a, task);
    }
    if (parts & 2) {
        float* cosT = (float*)(ws + WS_COS); float* sinT = (float*)(ws + WS_SIN);
        for (int i = blockIdx.x * 512 + F.tid; i < DSEQ * 64; i += F.G * 512) { const int t = i >> 6, j = i & 63, ax = j >> 5, f = j & 31;
            const float pos = (float)(ax == 0 ? (t >> 6) : (t & 63)); const float inv = powf(10000.0f, -(float)f / 32.0f); const float ang = pos * inv;
            float sn, cn; sincosf(ang, &sn, &cn); cosT[i] = cn; sinT[i] = sn; }
        float* lamT = (float*)(ws + WS_LAM); float* bbT = (float*)(ws + WS_BBAR);
        for (int i = blockIdx.x * 512 + F.tid; i < NLAYER * 2 * 32 * 64; i += F.G * 512) {
            const int ldg = i >> 6;
            const float dt = expf(a->in[I_LOGDT][ldg]); const float ar = a->in[I_ARE][i], ai = a->in[I_AIM][i];
            const float x = ar * dt, y = ai * dt; float sn, cn; sincosf(y, &sn, &cn); const float ex = expf(x);
            lamT[2 * i] = ex * cn; lamT[2 * i + 1] = ex * sn;
            const float sh = sinf(0.5f * y); const float nr = expm1f(x) * cn - 2.0f * sh * sh, ni = ex * sn;
            const float d2 = ar * ar + ai * ai; const float cr = (nr * ar + ni * ai) / d2, ci = (ni * ar - nr * ai) / d2;
#pragma unroll
            for (int j = 0; j < 16; ++j) { const float br = a->in[I_BRE][(size_t)i * 16 + j], bi = a->in[I_BIM][(size_t)i * 16 + j];
                bbT[((size_t)i * 16 + j) * 2] = cr * br - ci * bi; bbT[((size_t)i * 16 + j) * 2 + 1] = cr * bi + ci * br; }
        }
    }
    if (parts & 4) {
        GAS f32x4* xr = (GAS f32x4*)(ws + WS_XR);
        const GAS f32x4* xp = (const GAS f32x4*)a->in[I_XP]; const GAS f32x4* xs = (const GAS f32x4*)a->in[I_XS];
        const int NP4 = NPR * DM / 4, NT4 = MT * DM / 4;
        for (int i = blockIdx.x * 512 + F.tid; i < NT4; i += F.G * 512) xr[i] = i < NP4 ? xp[i] : xs[i - NP4];
    }
    if (parts & 8) { __syncthreads(); side_jobs(F, a, 0); }
}

__device__ __forceinline__ void phase_prenorm(const Frame& F, KA a, int l, int sub) {
    unsigned char* ws = a->ws;
    const float* xr = (const float*)(ws + WS_XR);
    for (int m = F.gw; m < MT; m += F.NGW) {
        const GAS f32x4* xp = (const GAS f32x4*)(xr + (size_t)m * DM) + F.lane;
        f32x4 v[8]; float s = 0.f;
#pragma unroll
        for (int j = 0; j < 8; ++j) { v[j] = xp[64 * j]; s += (v[j].x * v[j].x + v[j].y * v[j].y) + (v[j].z * v[j].z + v[j].w * v[j].w); }
        const float rstd = 1.0f / sqrtf(wave_sum(s) * (1.0f / DM) + EPS);
        if (sub == 3) {
            const GAS f32x4* gp = (const GAS f32x4*)a->in[I_FNG] + F.lane; GAS f32x4* op = (GAS f32x4*)(a->out + O_Y + (size_t)m * DM) + F.lane;
#pragma unroll
            for (int j = 0; j < 8; ++j) op[64 * j] = v[j] * rstd * gp[64 * j];
        } else {
            const int var = m < NPR ? 0 : 1 + (m - NPR) / DSEQ;
            const float* mod = (const float*)(ws + WS_MOD) + ((size_t)l * 3 + var) * MODW + sub * 3 * DM;
            const GAS f32x4* gp = (const GAS f32x4*)(a->in[I_NORMG] + ((size_t)l * 3 + sub) * DM) + F.lane;
            const GAS f32x4* shp = (const GAS f32x4*)mod + F.lane; const GAS f32x4* scp = (const GAS f32x4*)(mod + DM) + F.lane;
            GAS unsigned long long* o8 = (GAS unsigned long long*)((bf16*)(ws + WS_H) + (size_t)m * DM) + F.lane;
#pragma unroll
            for (int j = 0; j < 8; ++j) { const f32x4 y = v[j] * rstd * gp[64 * j] * (scp[64 * j] + 1.0f) + shp[64 * j];
                o8[64 * j] = (unsigned long long)pk2(y.x, y.y) | ((unsigned long long)pk2(y.z, y.w) << 32); }
        }
    }
}

__device__ __forceinline__ void phase_qkvpost(const Frame& F, KA a, int l) {
    unsigned char* ws = a->ws;
    const bf16* proj = (const bf16*)(ws + WS_PROJ);
    const float* cosT = (const float*)(ws + WS_COS); const float* sinT = (const float*)(ws + WS_SIN);
    const int i = F.lane, e0 = (i & 31) + 64 * (i >> 5), e1 = e0 + 32;
    const int NT1 = MT * 20, NT2 = NBS * PAST * 2 * 2;
    for (int task = F.gw; task < NT1 + NT2; task += F.NGW) {
        if (task >= NT1) {
            const int r = task - NT1; const int isv = r & 1, kvh = (r >> 1) & 1, t = (r >> 2) % PAST, b = (r >> 2) / PAST;
            const float* src = a->in[isv ? I_CV : I_CK] + ((((size_t)b * NLAYER + l) * PAST + t) * 2 + kvh) * 128;
            bf16* dst = (bf16*)(ws + (isv ? WS_VS : WS_KS)) + ((size_t)b * KALL + t) * 256 + kvh * 128;
            dst[e0] = (bf16)f2bf(src[e0]); dst[e1] = (bf16)f2bf(src[e1]);
            continue;
        }
        const int m = task / 20, ch = task % 20;
        const bool lat = m >= NPR; const int b = lat ? (m - NPR) / DSEQ : m / SEQ, t = lat ? (m - NPR) % DSEQ : m % SEQ;
        int scol; if (ch < 8) scol = C_QA + ch * 128; else if (ch < 10) scol = C_KA + (ch - 8) * 128; else if (ch < 12) scol = C_VA + (ch - 10) * 128; else if (ch < 16) scol = C_QR + (ch - 12) * 128; else scol = C_KR + (ch - 16) * 128;
        const bf16* src = proj + (size_t)m * INW + scol;
        float x0 = bf2f(src[e0]), x1 = bf2f(src[e1]);
        if (ch < 10) {
            const float ss = wave_sum(x0 * x0 + x1 * x1); const float r = 1.0f / sqrtf(ss * (1.0f / 128.0f) + EPS);
            const float* g = a->in[ch < 8 ? I_QNG : I_KNG] + l * 128;
            x0 *= r * g[e0]; x1 *= r * g[e1];
        }
        if (ch >= 16) { x0 *= 0.08838834764831845f; x1 *= 0.08838834764831845f; }
        if (lat && (ch < 10 || ch >= 12)) {
            const float c = cosT[t * 64 + i], s = sinT[t * 64 + i];
            const float y0 = x0 * c - x1 * s, y1 = x1 * c + x0 * s; x0 = y0; x1 = y1;
        }
        if (ch < 8) { bf16* d = (bf16*)(ws + WS_QB) + (size_t)m * 1024 + ch * 128; d[e0] = (bf16)f2bf(x0); d[e1] = (bf16)f2bf(x1); }
        else if (ch < 12) {
            const int isv = ch >= 10, kvh = (ch - 8) & 1;
            if (!lat) {
                float* o = a->out + (isv ? O_CV : O_CK) + ((((size_t)b * NLAYER + l) * SEQ + t) * 2 + kvh) * 128; o[e0] = x0; o[e1] = x1;
                bf16* d = (bf16*)(ws + (isv ? WS_VP : WS_KP)) + (size_t)m * 256 + kvh * 128; d[e0] = (bf16)f2bf(x0); d[e1] = (bf16)f2bf(x1);
            } else {
                bf16* d = (bf16*)(ws + (isv ? WS_VS : WS_KS)) + ((size_t)b * KALL + PAST + t) * 256 + kvh * 128; d[e0] = (bf16)f2bf(x0); d[e1] = (bf16)f2bf(x1);
            }
        }
        else if (ch < 16) { bf16* d = (bf16*)(ws + WS_QR) + (size_t)m * 512 + (ch - 12) * 128; d[e0] = (bf16)f2bf(x0); d[e1] = (bf16)f2bf(x1); }
        else { bf16* d = (bf16*)(ws + WS_KR) + (size_t)m * 512 + (ch - 16) * 128; d[e0] = (bf16)f2bf(x0); d[e1] = (bf16)f2bf(x1); }
    }
}

namespace mx {
using bf16x8 = __attribute__((ext_vector_type(8))) short;
using s16x4  = __attribute__((ext_vector_type(4))) short;
using f32x16 = __attribute__((ext_vector_type(16))) float;
using f32x8  = __attribute__((ext_vector_type(8))) float;
using u32x4  = __attribute__((ext_vector_type(4))) unsigned;
constexpr int D = 128, NW = 8, QBLK = 32, KVBLK = 64;
constexpr float SCALE = 0.088388347648318440f;
constexpr float THR = 8.f;
constexpr int SHM_V = KVBLK * D * 2, SHM_K = KVBLK * D * 2;
#define KSWZ(row, colB) ((row) * 256 + ((colB) ^ (((row) & 7) << 4)))
#define SBAR() __builtin_amdgcn_sched_barrier(0)
__device__ __forceinline__ int crow(int r, int hi) { return (r & 3) + 8 * (r >> 2) + 4 * hi; }
__device__ __forceinline__ unsigned cvtpk(float lo, float hi) { return pg8::cvt_pk_bf16(lo, hi); }
__device__ __forceinline__ bf16x8 ld8(const bf16* p) { return *reinterpret_cast<const bf16x8*>(p); }
__device__ __forceinline__ bf16x8 cvt8(f32x8 x) { u32x4 w = {cvtpk(x[0], x[1]), cvtpk(x[2], x[3]), cvtpk(x[4], x[5]), cvtpk(x[6], x[7])}; return *reinterpret_cast<bf16x8*>(&w); }

__device__ __forceinline__ void partialSM(f32x16& p0, f32x16& p1, float& m_reg, float& mn, float& alpha) {
  constexpr float C = SCALE * 1.4426950408889634f;
  float pmax = p0[0]; for (int r = 1; r < 16; ++r) pmax = fmaxf(pmax, p0[r]); for (int r = 0; r < 16; ++r) pmax = fmaxf(pmax, p1[r]);
  { auto rr = __builtin_amdgcn_permlane32_swap(__float_as_uint(pmax), __float_as_uint(pmax), false, false);
    pmax = fmaxf(__uint_as_float(rr[0]), __uint_as_float(rr[1])); }
  if (__builtin_expect(__all(pmax - m_reg <= THR / SCALE), 1)) { mn = m_reg; alpha = 1.f; }
  else { mn = fmaxf(m_reg, pmax); alpha = __builtin_amdgcn_exp2f((m_reg - mn) * C); m_reg = mn; }
  float mnC = -mn * C;
  for (int r = 0; r < 16; ++r) p0[r] = fmaf(p0[r], C, mnC); for (int r = 0; r < 16; ++r) p1[r] = fmaf(p1[r], C, mnC);
  for (int r = 0; r < 16; ++r) p0[r] = __builtin_amdgcn_exp2f(p0[r]);
}
#define PK4(P, BASE, OUT) do { unsigned a0 = cvtpk(P[BASE + 0], P[BASE + 1]), a1 = cvtpk(P[BASE + 2], P[BASE + 3]);   \
    unsigned b0 = cvtpk(P[BASE + 4], P[BASE + 5]), b1 = cvtpk(P[BASE + 6], P[BASE + 7]);                              \
    auto r0 = __builtin_amdgcn_permlane32_swap(a0, b0, false, false); auto r1 = __builtin_amdgcn_permlane32_swap(a1, b1, false, false); \
    u32x4 w = {r0[0], r1[0], r0[1], r1[1]}; OUT = *reinterpret_cast<bf16x8*>(&w); } while (0)
__device__ __forceinline__ void finishSM(f32x16& p0, f32x16& p1, float alpha, float& l_reg, bf16x8& pa0, bf16x8& pa1, bf16x8& pa2, bf16x8& pa3) {
  for (int r = 0; r < 16; ++r) p1[r] = __builtin_amdgcn_exp2f(p1[r]);
  float ps = 0; for (int r = 0; r < 16; ++r) ps += p0[r]; for (int r = 0; r < 16; ++r) ps += p1[r];
  { auto rr = __builtin_amdgcn_permlane32_swap(__float_as_uint(ps), __float_as_uint(ps), false, false);
    ps = __uint_as_float(rr[0]) + __uint_as_float(rr[1]); }
  l_reg = l_reg * alpha + ps;
  PK4(p0, 0, pa0); PK4(p0, 8, pa1); PK4(p1, 0, pa2); PK4(p1, 8, pa3);
}
__device__ __forceinline__ void packP(f32x16& p0, f32x16& p1, bf16x8& pa0, bf16x8& pa1, bf16x8& pa2, bf16x8& pa3) {
  PK4(p0, 0, pa0); PK4(p0, 8, pa1); PK4(p1, 0, pa2); PK4(p1, 8, pa3);
}
__device__ __forceinline__ void decayP(f32x16& p0, f32x16& p1, int e0  , float lgf, float nlgb, bool diag) {
  const float eb = (float)e0;
#pragma unroll
  for (int r = 0; r < 16; ++r) { const float c = (float)((r & 3) + 8 * (r >> 2));
    const float ea = eb - c, ec = eb - 32.f - c;
    float da = __builtin_amdgcn_exp2f(fminf(ea * lgf, ea * nlgb)), dc = __builtin_amdgcn_exp2f(fminf(ec * lgf, ec * nlgb));
    if (diag) { da = ea == 0.f ? 2.f : da; dc = ec == 0.f ? 2.f : dc; }
    p0[r] *= da; p1[r] *= dc; }
}
__device__ __forceinline__ void qkt(f32x16& p0, f32x16& p1, const LAS char* Ks, const bf16x8* qr, int r32, int hi) {
  p0 = f32x16{}; p1 = f32x16{};
#pragma unroll
  for (int d0 = 0; d0 < 8; ++d0) { int cb = (d0 * 16 + hi * 8) * 2;
    bf16x8 b0 = *reinterpret_cast<const LAS bf16x8*>(Ks + KSWZ(r32, cb));
    bf16x8 b1 = *reinterpret_cast<const LAS bf16x8*>(Ks + KSWZ(32 + r32, cb));
    p0 = __builtin_amdgcn_mfma_f32_32x32x16_bf16(b0, qr[d0], p0, 0, 0, 0);
    p1 = __builtin_amdgcn_mfma_f32_32x32x16_bf16(b1, qr[d0], p1, 0, 0, 0); }
}
__device__ __forceinline__ int v_st(int k, int c) { const int kk = (k & ~0xC) | ((k & 4) << 1) | ((k & 8) >> 1); return ((kk >> 3) * 4 + (c >> 5)) * 512 + ((kk & 7) * 32 + (c & 31)) * 2; }
__device__ __forceinline__ int v_rd_base(int lane) { return ((lane & 3) << 3) | (((lane >> 2) & 3) << 6) | (((lane >> 4) & 1) << 5) | (((lane >> 5) & 1) << 8); }
constexpr int v_rd_off(int d0, int ks, int half) { return d0 * 512 + ks * 4096 + half * 2048; }
template <int OFF> __device__ __forceinline__ s16x4 tr_read(int vb) {
  s16x4 r; asm volatile("ds_read_b64_tr_b16 %0, %1 offset:%2" : "=&v"(r) : "v"(vb), "i"(OFF) : "memory"); return r;
}
#define PKLH(L, H) (bf16x8){L[0], L[1], L[2], L[3], H[0], H[1], H[2], H[3]}
template <int D0> __device__ __forceinline__ void pv_one(f32x16& od, int vb, bf16x8 pa0, bf16x8 pa1, bf16x8 pa2, bf16x8 pa3) {
  const s16x4 l0 = tr_read<v_rd_off(D0, 0, 0)>(vb), h0 = tr_read<v_rd_off(D0, 0, 1)>(vb), l1 = tr_read<v_rd_off(D0, 1, 0)>(vb), h1 = tr_read<v_rd_off(D0, 1, 1)>(vb);
  const s16x4 l2 = tr_read<v_rd_off(D0, 2, 0)>(vb), h2 = tr_read<v_rd_off(D0, 2, 1)>(vb), l3 = tr_read<v_rd_off(D0, 3, 0)>(vb), h3 = tr_read<v_rd_off(D0, 3, 1)>(vb);
  asm volatile("s_waitcnt lgkmcnt(0)" ::: "memory"); SBAR();
  od = __builtin_amdgcn_mfma_f32_32x32x16_bf16(pa0, PKLH(l0, h0), od, 0, 0, 0);
  od = __builtin_amdgcn_mfma_f32_32x32x16_bf16(pa1, PKLH(l1, h1), od, 0, 0, 0);
  od = __builtin_amdgcn_mfma_f32_32x32x16_bf16(pa2, PKLH(l2, h2), od, 0, 0, 0);
  od = __builtin_amdgcn_mfma_f32_32x32x16_bf16(pa3, PKLH(l3, h3), od, 0, 0, 0);
}
__device__ __forceinline__ void pv_d0(f32x16* o, int vb, bf16x8 pa0, bf16x8 pa1, bf16x8 pa2, bf16x8 pa3) {
  pv_one<0>(o[0], vb, pa0, pa1, pa2, pa3); pv_one<1>(o[1], vb, pa0, pa1, pa2, pa3); pv_one<2>(o[2], vb, pa0, pa1, pa2, pa3); pv_one<3>(o[3], vb, pa0, pa1, pa2, pa3);
}

template <bool GN> __device__ __forceinline__ void store_tile(const f32x16* o, const float* rowscale  , LAS float* stg, bf16* Ow, int ldo, const bf16* Gw, int ldg, int lane) {
  const int r32 = lane & 31, hi = lane >> 5;
#pragma unroll
  for (int r = 0; r < 16; ++r) { const int orow = crow(r, hi);
#pragma unroll
    for (int d0 = 0; d0 < 4; ++d0) stg[orow * 128 + d0 * 32 + r32] = rowscale ? o[d0][r] * rowscale[r] : o[d0][r]; }
  asm volatile("s_waitcnt lgkmcnt(0)" ::: "memory");
  const int ch = lane & 15;
#pragma unroll
  for (int i = 0; i < 8; ++i) { const int row = (lane >> 4) + 4 * i;
    f32x4 a = *(const LAS f32x4*)(stg + row * 128 + ch * 8), b = *(const LAS f32x4*)(stg + row * 128 + ch * 8 + 4);
    if (GN) {
      float s = (a[0] + a[1]) + (a[2] + a[3]) + (b[0] + b[1]) + (b[2] + b[3]);
      s += shx<1>(s); s += shx<2>(s); s += shx<4>(s); s += shx<8>(s);
      const float mean = s * (1.f / 128.f); a = a - mean; b = b - mean;
      float q = (a[0] * a[0] + a[1] * a[1]) + (a[2] * a[2] + a[3] * a[3]) + (b[0] * b[0] + b[1] * b[1]) + (b[2] * b[2] + b[3] * b[3]);
      q += shx<1>(q); q += shx<2>(q); q += shx<4>(q); q += shx<8>(q);
      const float rs = 1.0f / sqrtf(q * (1.f / 128.f) + EPS);
      const v4u gw = *(const GAS v4u*)(Gw + (size_t)row * ldg + ch * 8);
      const float g0 = bflo(gw.x), g1 = bfhi(gw.x), g2 = bflo(gw.y), g3 = bfhi(gw.y), g4 = bflo(gw.z), g5 = bfhi(gw.z), g6 = bflo(gw.w), g7 = bfhi(gw.w);
      a[0] *= rs * g0 * pg8::fast_sigmoid(g0); a[1] *= rs * g1 * pg8::fast_sigmoid(g1); a[2] *= rs * g2 * pg8::fast_sigmoid(g2); a[3] *= rs * g3 * pg8::fast_sigmoid(g3);
      b[0] *= rs * g4 * pg8::fast_sigmoid(g4); b[1] *= rs * g5 * pg8::fast_sigmoid(g5); b[2] *= rs * g6 * pg8::fast_sigmoid(g6); b[3] *= rs * g7 * pg8::fast_sigmoid(g7);
    }
    u32x4 w = {cvtpk(a[0], a[1]), cvtpk(a[2], a[3]), cvtpk(b[0], b[1]), cvtpk(b[2], b[3])};
    *(GAS u32x4*)(Ow + (size_t)row * ldo + ch * 8) = w; }
  asm volatile("s_waitcnt lgkmcnt(0)" ::: "memory");
}

template <bool RET, int LDQ, int LDK, int LDV, int LDO>
__device__ __forceinline__ void unit_body(const bf16* __restrict__ Qb, const bf16* __restrict__ Kh, const bf16* __restrict__ Vh, bf16* __restrict__ Ob, int seq, LAS char* lds,
                                          int q0  , float lgf, float lgb, const float* S0f, const float* S0b, const bf16* Gb  , int tid0) {
  int tid_ = tid0; asm volatile("" : "+v"(tid_));
  const int tid = tid_, wid = __builtin_amdgcn_readfirstlane(tid >> 6), lane = tid & 63, r32 = lane & 31, hi = lane >> 5;
  LAS char* V_lds = lds; LAS char* K_lds = lds + 2 * SHM_V;
  LAS float* wsf = (LAS float*)(lds + 2 * SHM_V + 2 * SHM_K) + wid * 64; LAS float* li_l = wsf; LAS float* al_l = wsf + 32;
  float m_reg = -1e30f, l_reg = 0; f32x16 o[4] = {}; bf16x8 qr[8];
  const bf16* Qw = Qb + (long)(wid * QBLK + r32) * LDQ + hi * 8;
#pragma unroll
  for (int d0 = 0; d0 < 8; ++d0) qr[d0] = ld8(Qw + d0 * 16);
  const int sr = tid >> 4, sc = (tid & 15) * 8, vst0 = v_st(sr, sc), vst1 = v_st(32 + sr, sc);
  const int vb0 = (int)(unsigned)(size_t)V_lds + v_rd_base(lane);
  const float nlgb = -lgb;
  const int trow = q0 + wid * QBLK + r32;

  if (RET && S0f != nullptr) {
    f32x16 o2[4];
#pragma unroll
    for (int pass = 0; pass < 2; ++pass) {
      const float* S0 = pass == 0 ? S0f : S0b;
#pragma unroll
      for (int half = 0; half < 2; ++half) {
        const f32x8 x0 = *reinterpret_cast<const f32x8*>(S0 + (size_t)(half * 64 + sr) * 128 + sc), x1 = *reinterpret_cast<const f32x8*>(S0 + (size_t)(half * 64 + 32 + sr) * 128 + sc);
        *(LAS bf16x8*)(V_lds + half * SHM_V + vst0) = cvt8(x0); *(LAS bf16x8*)(V_lds + half * SHM_V + vst1) = cvt8(x1);
      }
      __syncthreads();
      if (pass == 0) { pv_d0(o, vb0, qr[0], qr[1], qr[2], qr[3]); pv_d0(o, vb0 + SHM_V, qr[4], qr[5], qr[6], qr[7]); }
      else { for (int d = 0; d < 4; ++d) o2[d] = f32x16{}; pv_d0(o2, vb0, qr[0], qr[1], qr[2], qr[3]); pv_d0(o2, vb0 + SHM_V, qr[4], qr[5], qr[6], qr[7]); }
      __syncthreads();
    }
#pragma unroll
    for (int r = 0; r < 16; ++r) { const int t = q0 + wid * QBLK + crow(r, hi);
      const float wf = __builtin_amdgcn_exp2f((float)(t + 1) * lgf), wb = __builtin_amdgcn_exp2f((float)(seq - t) * lgb);
#pragma unroll
      for (int d = 0; d < 4; ++d) o[d][r] = o[d][r] * wf + o2[d][r] * wb; }
  }

  struct { bf16x8 vs0, vs1, ks0, ks1; } sr_[2];
#define SLOAD(i, k0) do { sr_[i].vs0 = ld8(&Vh[(long)((k0) + sr) * LDV + sc]); sr_[i].vs1 = ld8(&Vh[(long)((k0) + 32 + sr) * LDV + sc]); \
    sr_[i].ks0 = ld8(&Kh[(long)((k0) + sr) * LDK + sc]); sr_[i].ks1 = ld8(&Kh[(long)((k0) + 32 + sr) * LDK + sc]); } while (0)
#define SWRITE(b, i) do { *(LAS bf16x8*)(V_lds + (b) * SHM_V + vst0) = sr_[i].vs0;          \
    *(LAS bf16x8*)(V_lds + (b) * SHM_V + vst1) = sr_[i].vs1; int kc = sc * 2;               \
    *(LAS bf16x8*)(K_lds + (b) * SHM_K + KSWZ(sr, kc)) = sr_[i].ks0;                       \
    *(LAS bf16x8*)(K_lds + (b) * SHM_K + KSWZ(32 + sr, kc)) = sr_[i].ks1; } while (0)
#define SWAIT() asm volatile("s_waitcnt vmcnt(4)" ::: "memory")
#define RESC(a) do { if (!RET) { if (__any((a) < 1.f)) { if (hi == 0) al_l[r32] = (a); asm volatile("s_waitcnt lgkmcnt(0)" ::: "memory"); \
    for (int d = 0; d < 4; ++d) for (int r = 0; r < 16; ++r) o[d][r] *= al_l[crow(r, hi)]; } } } while (0)
#define SM1(P0, P1, MN, AL, TILE) do { if (RET) { const int k0_ = (TILE) * KVBLK; const bool dg_ = (k0_ <= q0 + wid * QBLK + 31) && (k0_ + 63 >= q0 + wid * QBLK); \
      decayP(P0, P1, trow - k0_ - 4 * hi, lgf, nlgb, dg_); } else partialSM(P0, P1, m_reg, MN, AL); } while (0)
#define SM2(P0, P1, AL) do { if (RET) packP(P0, P1, pa0, pa1, pa2, pa3); else finishSM(P0, P1, AL, l_reg, pa0, pa1, pa2, pa3); } while (0)
  f32x16 pA0, pA1, pB0, pB1; float mnA = 0.f, mnB = 0.f, alA = 1.f, alB = 1.f; bf16x8 pa0, pa1, pa2, pa3; const int NT = seq / KVBLK;
  constexpr int SE = 0, SO = 1;
  SLOAD(SE, 0); asm volatile("s_waitcnt vmcnt(0)" ::: "memory"); SWRITE(0, SE); __syncthreads();
  qkt(pA0, pA1, K_lds, qr, r32, hi); SM1(pA0, pA1, mnA, alA, 0);
  SLOAD(SO, KVBLK); if (2 < NT) SLOAD(SE, 2 * KVBLK);
  SWAIT(); SWRITE(1, SO); __syncthreads();
  for (int j = 1; j + 1 < NT; j += 2) {
    SBAR(); qkt(pB0, pB1, K_lds + SHM_K, qr, r32, hi);
    SM2(pA0, pA1, alA); SBAR();
    SLOAD(SO, (j + 2) * KVBLK); SBAR();
    pv_d0(o, vb0, pa0, pa1, pa2, pa3); SM1(pB0, pB1, mnB, alB, j);
    __syncthreads(); SWAIT(); SWRITE(0, SE);
    RESC(alB); __syncthreads();
    SBAR(); qkt(pA0, pA1, K_lds, qr, r32, hi);
    SM2(pB0, pB1, alB); SBAR();
    if (j + 3 < NT) SLOAD(SE, (j + 3) * KVBLK); SBAR();
    pv_d0(o, vb0 + (int)SHM_V, pa0, pa1, pa2, pa3); SM1(pA0, pA1, mnA, alA, j + 1);
    __syncthreads(); SWAIT(); SWRITE(1, SO);
    RESC(alA); __syncthreads();
  }
  SBAR(); qkt(pB0, pB1, K_lds + SHM_K, qr, r32, hi);
  SM2(pA0, pA1, alA); SBAR();
  pv_d0(o, vb0, pa0, pa1, pa2, pa3); SM1(pB0, pB1, mnB, alB, NT - 1);
  __syncthreads(); RESC(alB);
  SM2(pB0, pB1, alB); SBAR();
  pv_d0(o, vb0 + (int)SHM_V, pa0, pa1, pa2, pa3);
  float rli[16];
  if (!RET) {
    if (hi == 0) li_l[r32] = l_reg; asm volatile("s_waitcnt lgkmcnt(0)" ::: "memory");
#pragma unroll
    for (int r = 0; r < 16; ++r) rli[r] = __builtin_amdgcn_rcpf(li_l[crow(r, hi)]);
  }
  __syncthreads();
  LAS float* stg = (LAS float*)(lds + wid * 16384);
  store_tile<RET>(o, RET ? nullptr : rli, stg, Ob + (size_t)(wid * QBLK) * LDO, LDO, RET ? Gb + (size_t)(wid * QBLK) * INW : nullptr, INW, lane);
  __syncthreads();
#undef SLOAD
#undef SWRITE
#undef SWAIT
#undef RESC
#undef SM1
#undef SM2
}

__device__ __forceinline__ void ret_state_unit(const bf16* __restrict__ Kh  , const bf16* __restrict__ Vh  , float* __restrict__ outF, float* __restrict__ outB, float lgf, float lgb, LAS char* lds, int tid0) {
  int tid_ = tid0; asm volatile("" : "+v"(tid_));
  const int tid = tid_, wid = __builtin_amdgcn_readfirstlane(tid >> 6), lane = tid & 63, r32 = lane & 31, hi = lane >> 5;
  const int sr = tid >> 4, sc = (tid & 15) * 8, vst0 = v_st(sr, sc), vst1 = v_st(32 + sr, sc);
  LAS char* KF = lds; LAS char* KB = lds + 16384; LAS char* VV = lds + 32768;
  const int dir = wid >> 2, Dd = wid & 3;
  const int ab = (int)(unsigned)(size_t)(dir ? KB : KF) + v_rd_base(lane) + Dd * 512;
  const int bb = (int)(unsigned)(size_t)VV + v_rd_base(lane);
  f32x16 acc[4] = {};
  for (int tile = 0; tile < SEQ / 64; ++tile) {
    const int s0 = tile * 64 + sr, s1 = s0 + 32;
    const bf16x8 k0 = ld8(Kh + (size_t)s0 * 512 + sc), k1 = ld8(Kh + (size_t)s1 * 512 + sc), v0 = ld8(Vh + (size_t)s0 * INW + sc), v1 = ld8(Vh + (size_t)s1 * INW + sc);
    const float wf0 = exp2f((float)(SEQ - 1 - s0) * lgf), wf1 = exp2f((float)(SEQ - 1 - s1) * lgf), wb0 = exp2f((float)s0 * lgb), wb1 = exp2f((float)s1 * lgb);
    f32x8 x0, x1;
#pragma unroll
    for (int j = 0; j < 8; ++j) { x0[j] = bf2f((unsigned short)k0[j]); x1[j] = bf2f((unsigned short)k1[j]); }
    *(LAS bf16x8*)(KF + vst0) = cvt8(x0 * wf0); *(LAS bf16x8*)(KF + vst1) = cvt8(x1 * wf1);
    *(LAS bf16x8*)(KB + vst0) = cvt8(x0 * wb0); *(LAS bf16x8*)(KB + vst1) = cvt8(x1 * wb1);
    *(LAS bf16x8*)(VV + vst0) = v0; *(LAS bf16x8*)(VV + vst1) = v1;
    __syncthreads();
#define RS_STEP(KS) do { const s16x4 al = tr_read<v_rd_off(0, KS, 0)>(ab), ah = tr_read<v_rd_off(0, KS, 1)>(ab); \
      const s16x4 l0 = tr_read<v_rd_off(0, KS, 0)>(bb), h0 = tr_read<v_rd_off(0, KS, 1)>(bb), l1 = tr_read<v_rd_off(1, KS, 0)>(bb), h1 = tr_read<v_rd_off(1, KS, 1)>(bb); \
      const s16x4 l2 = tr_read<v_rd_off(2, KS, 0)>(bb), h2 = tr_read<v_rd_off(2, KS, 1)>(bb), l3 = tr_read<v_rd_off(3, KS, 0)>(bb), h3 = tr_read<v_rd_off(3, KS, 1)>(bb); \
      asm volatile("s_waitcnt lgkmcnt(0)" ::: "memory"); SBAR(); const bf16x8 af = PKLH(al, ah); \
      acc[0] = __builtin_amdgcn_mfma_f32_32x32x16_bf16(af, PKLH(l0, h0), acc[0], 0, 0, 0); acc[1] = __builtin_amdgcn_mfma_f32_32x32x16_bf16(af, PKLH(l1, h1), acc[1], 0, 0, 0); \
      acc[2] = __builtin_amdgcn_mfma_f32_32x32x16_bf16(af, PKLH(l2, h2), acc[2], 0, 0, 0); acc[3] = __builtin_amdgcn_mfma_f32_32x32x16_bf16(af, PKLH(l3, h3), acc[3], 0, 0, 0); } while (0)
    RS_STEP(0); RS_STEP(1); RS_STEP(2); RS_STEP(3);
#undef RS_STEP
    __syncthreads();
  }
  float* out = dir ? outB : outF;
#pragma unroll
  for (int r = 0; r < 16; ++r) { const int d = Dd * 32 + crow(r, hi);
#pragma unroll
    for (int e = 0; e < 4; ++e) out[(size_t)d * 128 + e * 32 + r32] = acc[e][r]; }
}

#ifndef S5_OLD_FMA
#define S5_OLD_FMA 0
#endif
#ifndef S5_OLD_ADDR
#define S5_OLD_ADDR 0
#endif
using f32x4m = __attribute__((ext_vector_type(4))) float;
__device__ __forceinline__ unsigned cvtpk_s(float lo, float hi) { return pg8::cvt_pk_bf16(lo, hi); }
__device__ __forceinline__ float gelu_fast(float x) { const float u = 0.7978845608028654f * (x + 0.044715f * x * x * x); return x * pg8::fast_sigmoid(2.0f * u); }
template <bool OUT, int DIR>
__device__ __forceinline__ void s5_seg_d(KA a, int l, int m0, int t_lo, int len, int g, float& hr, float& hi_, LAS char* wl, int lane) {
  unsigned char* ws = a->ws;
  const bf16* proj = (const bf16*)(ws + WS_PROJ);
  float* YS = (float*)(ws + WS_YS); bf16* YSB = (bf16*)(ws + WS_YSB);
  const int r32 = lane & 31, hi = lane >> 5, fr = lane & 15, q = lane >> 4;
  LAS float* BU = (LAS float*)wl;
  const int ldg = (l * 2 + DIR) * 32 + g;
  const float* lamT = (const float*)(ws + WS_LAM) + ((size_t)ldg * 64 + lane) * 2;
  const float lr = lamT[0], li = lamT[1], nli = -li;
  bf16x8 bfr[4], cfr[4]; float dcoef = 0.f;
  {
    const float* bbT = (const float*)(ws + WS_BBAR);
#pragma unroll
    for (int pb = 0; pb < 2; ++pb) { const GAS f32x4* bp = (const GAS f32x4*)(bbT + (((size_t)ldg * 64 + 32 * pb + r32) * 16 + 8 * hi) * 2);
      const f32x4 w0 = bp[0], w1 = bp[1], w2 = bp[2], w3 = bp[3];
      bfr[pb] = cvt8((f32x8){w0[0], w0[2], w1[0], w1[2], w2[0], w2[2], w3[0], w3[2]});
      bfr[2 + pb] = cvt8((f32x8){w0[1], w0[3], w1[1], w1[3], w2[1], w2[3], w3[1], w3[3]}); }
    if (OUT) {
      dcoef = a->in[I_SSMD][l * 512 + g * 16 + fr];
      const float* cre = a->in[I_CRE] + ((size_t)ldg * 16 + fr) * 64 + 4 * q; const float* cim = a->in[I_CIM] + ((size_t)ldg * 16 + fr) * 64 + 4 * q;
#pragma unroll
      for (int ks = 0; ks < 4; ++ks) { const f32x4 cr = *(const GAS f32x4*)(cre + 16 * ks), ci = *(const GAS f32x4*)(cim + 16 * ks);
        cfr[ks] = cvt8((f32x8){cr[0], -ci[0], cr[1], -ci[1], cr[2], -ci[2], cr[3], -ci[3]}); }
    }
  }
  LAS unsigned* hw[16];
#pragma unroll
  for (int j = 0; j < 16; ++j) hw[j] = (LAS unsigned*)BU + (lane ^ (4 * j));
  const LAS bf16x8* hrd[4];
#pragma unroll
  for (int ks = 0; ks < 4; ++ks) hrd[ks] = (const LAS bf16x8*)((LAS unsigned*)BU + fr * 128 + ((16 * ks + 4 * q) ^ (4 * fr)));
  const LAS float* brd = BU + lane;
  const int NC = len / 32;
  const bf16* ubase = proj + (size_t)m0 * INW + C_US + g * 16;
#define S5_T0(c) (DIR == 0 ? t_lo + 32 * (c) : t_lo + len - 32 * ((c) + 1))
  bf16x8 ua_next = ld8(ubase + (size_t)(S5_T0(0) + r32) * INW + 8 * hi);
#pragma unroll 1
  for (int c = 0; c < NC; ++c) {
    const int T0 = S5_T0(c);
    const bf16x8 ua = ua_next;
    if (c + 1 < NC) ua_next = ld8(ubase + (size_t)(S5_T0(c + 1) + r32) * INW + 8 * hi);
    float ysv[8]; unsigned short uv[8];
    const size_t mrow = (size_t)(m0 + T0 + 4 * q);
    if (OUT && DIR == 0) {
#pragma unroll
      for (int k = 0; k < 8; ++k) { const size_t m = mrow + 16 * (k >> 2) + (k & 3); ysv[k] = YS[m * 512 + g * 16 + fr]; uv[k] = proj[m * INW + C_US + g * 16 + fr]; }
    }
#pragma unroll
    for (int tile = 0; tile < 4; ++tile) {
      const f32x16 d = __builtin_amdgcn_mfma_f32_32x32x16_bf16(ua, bfr[tile], f32x16{}, 0, 0, 0);
#pragma unroll
      for (int r = 0; r < 16; ++r) BU[crow(r, hi) * 128 + tile * 32 + r32] = d[r];
    }
    asm volatile("s_waitcnt lgkmcnt(0)" ::: "memory");
#pragma unroll
    for (int half = 0; half < 2; ++half) {
      float bre[16], bim[16];
#pragma unroll
      for (int k = 0; k < 16; ++k) { constexpr int dummy = 0; const int i = DIR == 0 ? half * 16 + k : 31 - half * 16 - k; bre[k] = brd[i * 128]; bim[k] = brd[i * 128 + 64]; }
      asm volatile("s_waitcnt lgkmcnt(0)" ::: "memory");
#pragma unroll
      for (int k = 0; k < 16; ++k) { const int i = DIR == 0 ? half * 16 + k : 31 - half * 16 - k;
#if S5_OLD_FMA
        const float nr = lr * hr - li * hi_ + bre[k], ni = lr * hi_ + li * hr + bim[k]; hr = nr; hi_ = ni;
#else
        const float nr = fmaf(lr, hr, fmaf(nli, hi_, bre[k])), ni = fmaf(lr, hi_, fmaf(li, hr, bim[k])); hr = nr; hi_ = ni;
#endif
#if S5_OLD_ADDR
        if (OUT) ((LAS unsigned*)BU)[i * 128 + (lane ^ (4 * (i & 15)))] = cvtpk(hr, hi_); }
#else
        if (OUT) hw[i & 15][i * 128] = cvtpk_s(hr, hi_); }
#endif
    }
    if (OUT) {
      asm volatile("s_waitcnt lgkmcnt(0)" ::: "memory");
#pragma unroll
      for (int mt = 0; mt < 2; ++mt) {
        f32x4m y = {0.f, 0.f, 0.f, 0.f};
#pragma unroll
        for (int ks = 0; ks < 4; ++ks) {
#if S5_OLD_ADDR
          const int i_ = 16 * mt + fr; const bf16x8 hf = *(const LAS bf16x8*)((LAS unsigned*)BU + i_ * 128 + ((16 * ks + 4 * q) ^ (4 * (i_ & 15))));
#else
          const bf16x8 hf = hrd[ks][mt * 16 * 32];
#endif
          y = __builtin_amdgcn_mfma_f32_16x16x32_bf16(hf, cfr[ks], y, 0, 0, 0); }
#pragma unroll
        for (int rg = 0; rg < 4; ++rg) { const size_t m = mrow + 16 * mt + rg;
          if (DIR == 1) YS[m * 512 + g * 16 + fr] = y[rg];
          else { const float yt = y[rg] + ysv[mt * 4 + rg] + dcoef * bf2f(uv[mt * 4 + rg]);
            YSB[m * 512 + g * 16 + fr] = (bf16)f2bf(gelu_fast(yt)); } }
      }
    }
    asm volatile("s_waitcnt lgkmcnt(0)" ::: "memory");
  }
  asm volatile("s_waitcnt vmcnt(0)" ::: "memory");
#undef S5_T0
}
template <bool OUT>
__device__ __forceinline__ void s5_seg(KA a, int l, int m0, int t_lo, int len, int g, int dir, float& hr, float& hi_, LAS char* wl, int lane) {
  if (dir == 0) s5_seg_d<OUT, 0>(a, l, m0, t_lo, len, g, hr, hi_, wl, lane); else s5_seg_d<OUT, 1>(a, l, m0, t_lo, len, g, hr, hi_, wl, lane);
}
__device__ __forceinline__ void s5_ctx_wave(KA a, int l, int b, int g, LAS char* lds, int tid0) {
  int tid_ = tid0; asm volatile("" : "+v"(tid_));
  const int lane = tid_ & 63; LAS char* wl = lds + __builtin_amdgcn_readfirstlane(tid_ >> 6) * 16384;
#pragma unroll 1
  for (int dir = 1; dir >= 0; --dir) {
    float hr = 0.f, hi_ = 0.f;
    s5_seg<true>(a, l, b * SEQ, 0, SEQ, g, dir, hr, hi_, wl, lane);
    float* o = a->out + O_SSM + (((((size_t)b * NLAYER + l) * 2 + dir) * 32 + g) * 64 + lane) * 2; o[0] = hr; o[1] = hi_;
  }
}
constexpr int S5X_OFF = RING_BYTES + 1024;
__device__ __forceinline__ void s5_lat_unit(KA a, int l, int v  , LAS char* lds, int tid0) {
  int tid_ = tid0; asm volatile("" : "+v"(tid_));
  const int lane = tid_ & 63, wid = __builtin_amdgcn_readfirstlane(tid_ >> 6); LAS char* wl = lds + wid * 16384;
  const int pr = wid >> 2, seg = wid & 3, bg = 2 * v + pr, b = bg >> 5, g = bg & 31;
  const int m0 = NPR + b * DSEQ;
  LAS float* X = (LAS float*)(lds + S5X_OFF);
#pragma unroll 1
  for (int dir = 1; dir >= 0; --dir) {
    float hr = 0.f, hi_ = 0.f;
    const bool last = dir == 0 ? seg == 3 : seg == 0;
    if (!last) s5_seg<false>(a, l, m0, seg * 256, 256, g, dir, hr, hi_, wl, lane);
    X[(((pr * 2 + dir) * 4 + seg) * 64 + lane) * 2] = hr; X[(((pr * 2 + dir) * 4 + seg) * 64 + lane) * 2 + 1] = hi_;
  }
  __syncthreads();
#pragma unroll 1
  for (int dir = 1; dir >= 0; --dir) {
    const int ldg = (l * 2 + dir) * 32 + g;
    const float* lamT = (const float*)(a->ws + WS_LAM) + ((size_t)ldg * 64 + lane) * 2;
    float pr_ = lamT[0], pi_ = lamT[1];
#pragma unroll
    for (int k = 0; k < 8; ++k) { const float nr = pr_ * pr_ - pi_ * pi_, ni = 2.f * pr_ * pi_; pr_ = nr; pi_ = ni; }
    const float* h0 = a->in[I_SSSM] + (((((size_t)b * NLAYER + l) * 2 + dir) * 32 + g) * 64 + lane) * 2;
    float hr = h0[0], hi_ = h0[1];
    const int nprev = dir == 0 ? seg : 3 - seg;
    for (int k = 0; k < nprev; ++k) { const int sk = dir == 0 ? k : 3 - k;
      const float fr_ = X[(((pr * 2 + dir) * 4 + sk) * 64 + lane) * 2], fi_ = X[(((pr * 2 + dir) * 4 + sk) * 64 + lane) * 2 + 1];
      const float nr = pr_ * hr - pi_ * hi_ + fr_, ni = pr_ * hi_ + pi_ * hr + fi_; hr = nr; hi_ = ni; }
    s5_seg<true>(a, l, m0, seg * 256, 256, g, dir, hr, hi_, wl, lane);
  }
}
#undef KSWZ
#undef SBAR
#undef PK4
#undef PKLH
}

__device__ __forceinline__ void decay_log2(KA a, int l, int h, float& lgf, float& lgb) {
    const float xf = a->in[I_DECAY][(l * 2 + 0) * 4 + h], xb = a->in[I_DECAY][(l * 2 + 1) * 4 + h];
    lgf = -log1pf(expf(-xf)) * 1.4426950408889634f; lgb = -log1pf(expf(-xb)) * 1.4426950408889634f;
}

constexpr int MX_NBIG = 128, MX_NUNITS = 448;
__device__ __forceinline__ void mixer_unit(const Frame& F, KA a, int l, int u, int kmask) {
  unsigned char* ws = a->ws; LAS char* lds = (LAS char*)F.lds;
  const bf16* proj = (const bf16*)(ws + WS_PROJ);
  int kind, lat, b, h = 0, qb = 0, v;
  const int wv_ = F.wave;
  if (u < 64) { kind = 0; lat = 1; qb = u & 3; h = (u >> 2) & 7; b = u >> 5; }
  else if (u < 96) { v = u - 64; kind = 1; lat = 1; qb = v & 3; h = (v >> 2) & 3; b = v >> 4; }
  else if (u < 128) { v = u - 96; kind = 2; lat = 1; b = 0; h = v; }
  else if (u < 256) { v = u - 128; kind = 0; lat = 0; h = v & 7; b = v >> 3; }
  else if (u < 320) { v = u - 256; kind = 1; lat = 0; h = v & 3; b = v >> 2; }
  else if (u < 384) { v = (u - 320) * 8 + wv_; kind = 2; lat = 0; b = v >> 5; h = v & 31; }
  else { v = u - 384; kind = 3; lat = 0; h = v & 3; b = v >> 2; }
  if (!((kmask >> (kind + 4 * lat)) & 1)) return;
  const size_t m0 = lat ? NPR + (size_t)b * DSEQ : (size_t)b * SEQ;
  const size_t m = m0 + (size_t)qb * 256;
  const int L = lat ? DSEQ : SEQ;
#ifndef MXK
#define MXK 15
#endif
  if (kind == 0) { if (MXK & 1) {
    const bf16* Kb = lat ? (const bf16*)(ws + WS_KS) + (size_t)b * KALL * 256 : (const bf16*)(ws + WS_KP) + m0 * 256;
    const bf16* Vb = lat ? (const bf16*)(ws + WS_VS) + (size_t)b * KALL * 256 : (const bf16*)(ws + WS_VP) + m0 * 256;
    mx::unit_body<false, 1024, 256, 256, DM>((const bf16*)(ws + WS_QB) + m * 1024 + h * 128, Kb + (h >> 2) * 128, Vb + (h >> 2) * 128, (bf16*)(ws + WS_MIX) + m * DM + h * 128,
        lat ? KALL : SEQ, lds, 0, 0.f, 0.f, nullptr, nullptr, nullptr, F.tid); }
  } else if (kind == 1) { if (MXK & 2) {
    float lgf, lgb; decay_log2(a, l, h, lgf, lgb);
    const float* S0f = lat ? a->in[I_SRET] + ((((size_t)b * NLAYER + l) * 2 + 0) * 4 + h) * 16384 : nullptr;
    const float* S0b = lat ? a->in[I_SRET] + ((((size_t)b * NLAYER + l) * 2 + 1) * 4 + h) * 16384 : nullptr;
    mx::unit_body<true, 512, 512, INW, DM>((const bf16*)(ws + WS_QR) + m * 512 + h * 128, (const bf16*)(ws + WS_KR) + m0 * 512 + h * 128, proj + m0 * INW + C_VR + h * 128,
        (bf16*)(ws + WS_MIX) + m * DM + 1536 + h * 128, L, lds, qb * 256, lgf, lgb, S0f, S0b, proj + m * INW + C_GR + h * 128, F.tid); }
  } else if (kind == 2) { if (MXK & 4)
    if (lat) mx::s5_lat_unit(a, l, h, lds, F.tid); else mx::s5_ctx_wave(a, l, b, h, lds, F.tid);
  } else if (MXK & 8) {
    float lgf, lgb; decay_log2(a, l, h, lgf, lgb);
    float* oF = a->out + O_RET + ((((size_t)b * NLAYER + l) * 2 + 0) * 4 + h) * 16384; float* oB = a->out + O_RET + ((((size_t)b * NLAYER + l) * 2 + 1) * 4 + h) * 16384;
    mx::ret_state_unit((const bf16*)(ws + WS_KR) + m0 * 512 + h * 128, proj + m0 * INW + C_VR + h * 128, oF, oB, lgf, lgb, lds, F.tid);
  }
}
__device__ __forceinline__ void phase_mixer(const Frame& F, KA a, int l, int kmask = 255) {
  const int w = blockIdx.x;
  if (F.G == 256) {
    if (w < MX_NBIG) { mixer_unit(F, a, l, w, kmask); __syncthreads(); }
    else { for (int u = w; u < MX_NUNITS; u += 256 - MX_NBIG) { mixer_unit(F, a, l, u, kmask); __syncthreads(); } }
  } else { for (int u = w; u < MX_NUNITS; u += F.G) { mixer_unit(F, a, l, u, kmask); __syncthreads(); } }
}

constexpr int N_PHASES = 26;

__device__ __forceinline__ int cur_tid(int widS) { unsigned z = 0; asm volatile("" : "+s"(z)); const int lane = (int)__builtin_amdgcn_mbcnt_hi(~0u, __builtin_amdgcn_mbcnt_lo(~0u, z)); return widS * 64 + lane; }
__device__ __forceinline__ Frame mkframe(LAS unsigned char* lds, int widS) {
    Frame F; F.tid = cur_tid(widS);
    F.lds = lds; F.lane = F.tid & 63; F.wave = widS;
    F.G = gridDim.x; F.gw = blockIdx.x * NWAVES + F.wave; F.NGW = F.G * NWAVES; return F;
}
template <class Epi> __device__ __forceinline__ void run_gemm(LAS unsigned char* lds, int widS, KA a, const bf16* A, const bf16* Bt, int N, int K, const Epi& E, int slot) {
    { pg8::Gemm g{A, Bt, MT, N, K}; pg8::StaticOrder S; S.init(MT, N, (int)gridDim.x, (int)blockIdx.x);
      pg8::gemm_phase<Epi, pg8::StaticOrder, true, true>(lds, g, S, E, cur_tid(widS)); }
    if (slot >= 0) { const Frame F = mkframe(lds, widS); side_jobs(F, a, slot); }
}
#define FR mkframe((LAS unsigned char*)lds, widS)
__global__ void __launch_bounds__(NWAVES * 64, 2) trunk_fwd(KArgs args) {
    extern __shared__ __attribute__((aligned(16))) unsigned char lds[];
    const int widS = __builtin_amdgcn_readfirstlane((int)threadIdx.x >> 6);
    volatile LAS unsigned* MISC = (volatile LAS unsigned*)((LAS unsigned char*)lds + MISC_OFF);
    for (int u = threadIdx.x; u < (LDS_BYTES - LDSCTL_OFF) / 4; u += NWAVES * 64) ((LAS unsigned*)((LAS unsigned char*)lds + LDSCTL_OFF))[u] = 0u;
    __syncthreads();
    unsigned* ctl = (unsigned*)(args.ws + WS_CTL);
    XcdBarrier bar; bar.bar = ctl + CW_BAR; bar.x = 0; bar.st = nullptr;
    const bool multi = (args.ph_hi - args.ph_lo) > 1;
    if (multi) bar = xcd_barrier_post(ctl + CW_BAR, MISC + 8);

    for (int ph = args.ph_lo; ph < args.ph_hi; ++ph) {
        KA ap; { unsigned long long p_ = (unsigned long long)__builtin_amdgcn_kernarg_segment_ptr(); asm volatile("" : "+s"(p_)); ap = (KA)p_; }
        unsigned char* ws = ap->ws;
#ifndef PH_MASK
#define PH_MASK 0xFFFF
#endif
#ifndef MIXER_DUP_KMASK
#define MIXER_DUP_KMASK 255
#endif
#ifndef DUP_MASK
#define DUP_MASK 0
#endif
#define SLOT(x) (rep_ == 1 ? (x) : -1)
#define DUPB(bit, stmt) for (int rep_ = (DUP_MASK & (bit)) ? 0 : 1; rep_ < 2; ++rep_) { stmt; if (rep_ == 0) xcd_barrier(bar, cur_tid(widS)); }
        if (ph == 0) { if (DUP_MASK & 512) { phase_prologue(FR, ap, 4); xcd_barrier(bar, cur_tid(widS)); } if (PH_MASK & 1) phase_prologue(FR, ap); }
        else if (ph == N_PHASES - 1) { DUPB(2, phase_prenorm(FR, ap, 0, 3)) }
        else {
            const int l = (ph - 1) / 12, s = (ph - 1) % 12;
            const float* modl = (const float*)(ws + WS_MOD) + (size_t)l * 3 * MODW;
            switch (s) {
                case 0: DUPB(2, phase_prenorm(FR, ap, l, 0)); break;
                case 3: DUPB(2, phase_prenorm(FR, ap, l, 1)); break;
                case 9: DUPB(2, phase_prenorm(FR, ap, l, 2)); break;
                case 1: case 10: {
                    const int i = s == 1 ? 0 : 1;
                    pg8::EpiPair<0> E{(bf16*)(ws + WS_ACT), DFF, 0};
                    DUPB(4, run_gemm((LAS unsigned char*)lds, widS, ap, (const bf16*)(ws + WS_H), (const bf16*)(ws + WS_WFI) + (size_t)(l * 2 + i) * 2 * DFF * DM, 2 * DFF, DM, E, SLOT(l == 0 ? (i == 0 ? 1 : 5) : (i == 0 ? 7 : -1)))); break; }
                case 2: case 11: {
                    const int i = s == 2 ? 0 : 1, sub = s == 2 ? 0 : 2;
                    pg8::EpiResid E{(float*)(ws + WS_XR), modl + sub * 3 * DM + 2 * DM, MODW, 0.5f};
                    DUPB(8, { pg8::EpiResid E0 = E; if (rep_ == 0) E0.s = 0.f; run_gemm((LAS unsigned char*)lds, widS, ap, (const bf16*)(ws + WS_ACT), (const bf16*)(ws + WS_WFO) + (size_t)(l * 2 + i) * DM * DFF, DM, DFF, E0, SLOT(l == 0 ? (i == 0 ? 2 : 6) : -1)); }); break; }
                case 4: {
                    pg8::EpiBf16 E{(bf16*)(ws + WS_PROJ), INW};
                    DUPB(16, run_gemm((LAS unsigned char*)lds, widS, ap, (const bf16*)(ws + WS_H), (const bf16*)(ws + WS_WIN) + (size_t)l * INW * DM, INW, DM, E, SLOT(l == 0 ? 3 : -1))); break; }
                case 5: DUPB(32, phase_qkvpost(FR, ap, l)); break;
                case 6: DUPB(64, phase_mixer(FR, ap, l, rep_ == 0 ? MIXER_DUP_KMASK : 255)); break;
                case 7: {
                    pg8::EpiPair<1> E{(bf16*)(ws + WS_MIX), DM, 1024};
                    DUPB(128, run_gemm((LAS unsigned char*)lds, widS, ap, (const bf16*)(ws + WS_YSB), (const bf16*)(ws + WS_WGLU) + (size_t)l * 1024 * 512, 1024, 512, E, -1)); break; }
                case 8: {
                    pg8::EpiResid E{(float*)(ws + WS_XR), modl + 1 * 3 * DM + 2 * DM, MODW, 1.0f};
                    DUPB(256, { pg8::EpiResid E0 = E; if (rep_ == 0) E0.s = 0.f; run_gemm((LAS unsigned char*)lds, widS, ap, (const bf16*)(ws + WS_MIX), (const bf16*)(ws + WS_WOUT) + (size_t)l * DM * DM, DM, DM, E0, SLOT(l == 0 ? 4 : -1)); }); break; }
                default: break;
            }
        }
        if (ph + 1 < args.ph_hi) xcd_barrier(bar, cur_tid(widS));
    }
}

extern "C" void kernel_launch(void* const* d_in, const int* in_sizes, int n_in, void* d_out, int out_size, void* d_ws, size_t ws_size, hipStream_t stream) {
    static int grid = 0;
    if (grid == 0) {
        if (n_in != 28 || out_size != (int)O_END || ws_size < WS_END) { fprintf(stderr, "kernel_launch: unexpected shapes: n_in %d out %d ws %zu (need >= %zu)\n", n_in, out_size, ws_size, (size_t)WS_END); grid = -1; return; }
        int dev = 0, cus = 0, per_cu = 0;
        if (hipGetDevice(&dev) != hipSuccess || hipDeviceGetAttribute(&cus, hipDeviceAttributeMultiprocessorCount, dev) != hipSuccess) { fprintf(stderr, "kernel_launch: device query failed\n"); grid = -1; return; }
        if (hipFuncSetAttribute((const void*)trunk_fwd, hipFuncAttributeMaxDynamicSharedMemorySize, LDS_BYTES) != hipSuccess) { fprintf(stderr, "kernel_launch: hipFuncSetAttribute failed\n"); grid = -1; return; }
        if (hipOccupancyMaxActiveBlocksPerMultiprocessor(&per_cu, (const void*)trunk_fwd, NWAVES * 64, LDS_BYTES) != hipSuccess || per_cu < 1) { fprintf(stderr, "kernel_launch: occupancy query says %d blocks per CU\n", per_cu); (void)hipGetLastError(); grid = -1; return; }
        grid = cus;
        if (grid > 256) grid = 256;
    }
    if (grid < 0) return;
    (void)hipMemsetAsync((char*)d_ws + WS_CTL, 0, CTL_ZERO_BYTES, stream);
    KArgs a{};
    for (int i = 0; i < 28; ++i) a.in[i] = (const float*)d_in[i];
    a.out = (float*)d_out; a.ws = (unsigned char*)d_ws;
#if MK_ONE_LAUNCH
    a.ph_lo = 0; a.ph_hi = N_PHASES; a.li = 0;
    hipLaunchKernelGGL(trunk_fwd, dim3(grid), dim3(NWAVES * 64), LDS_BYTES, stream, a);
#else
    for (int ph = 0; ph < N_PHASES; ++ph) { a.ph_lo = ph; a.ph_hi = ph + 1; a.li = ph;
        hipLaunchKernelGGL(trunk_fwd, dim3(grid), dim3(NWAVES * 64), LDS_BYTES, stream, a); }
#endif
    const hipError_t le = hipPeekAtLastError();
    if (le != hipSuccess) fprintf(stderr, "kernel_launch: launch failed: %s\n", hipGetErrorName(le));
}
```

```cpp
#define MK_ONE_LAUNCH 1
#include <hip/hip_runtime.h>
#include <cstdio>
#include <cstdint>
#include <cmath>

constexpr int DM = 2048, NPR = 4096, NSR = 2048, MT = 6144, DFF = 5632, INW = 4096;
constexpr int SEQ = 256, DSEQ = 1024, PAST = 512, NBP = 16, NBS = 2, NLAYER = 2;
constexpr int KALL = PAST + DSEQ;
constexpr int MODW = 9 * DM;
constexpr float EPS = 1e-6f;
constexpr int C_QA = 0, C_KA = 1024, C_VA = 1280, C_US = 1536, C_QR = 2048, C_KR = 2560, C_VR = 3072, C_GR = 3584;
constexpr size_t O_Y = 0, O_CK = 12582912, O_CV = 14680064, O_SSM = 16777216, O_RET = 17039360, O_END = 21233664;

namespace pg8 {
#define PG8_LAS __attribute__((address_space(3)))
typedef unsigned short bf16_t;
typedef short bf16x8 __attribute__((ext_vector_type(8)));
typedef float f32x4 __attribute__((ext_vector_type(4)));
typedef unsigned u32x4 __attribute__((ext_vector_type(4)));
constexpr int BM = 256, BK = 64, HALF = 128, HTB = HALF * BK * 2, STAGE_BYTES = 8 * HTB, NXCD = 8, WGM = 8;

__host__ __device__ __forceinline__ int lds_byte(int r, int c) { const int st = (r >> 4) * 2 + (c >> 5), rr = r & 15, cc = c & 31, ob = rr * 64 + cc * 2; return st * 1024 + (ob ^ (((ob >> 9) & 1) << 5)); }
__host__ __device__ __forceinline__ void stage_rc(int b, int& R, int& C) { const int st = b / 1024, sb = b % 1024, swz = sb ^ (((sb >> 9) & 1) << 5); R = (st >> 1) * 16 + swz / 64; C = (st & 1) * 32 + (swz % 64) / 2; }
__host__ __device__ __forceinline__ int perm32(int rho) { const int n = rho >> 4, i = rho & 15; return 8 * (i >> 2) + 4 * n + (i & 3); }

struct Unit { int pm, pn; };
struct Gemm { const bf16_t* A; const bf16_t* Bt; int M, N, K; };

struct StaticOrder {
    int nM, nN, nwg, G, c;
    __host__ __device__ void init(int M, int N, int G_, int c_) { nM = M / BM; nN = N / BM; nwg = nM * nN; G = G_; c = c_; }
    __host__ __device__ bool next(int i, Unit& u) const {
        const long L = (long)i * G + c; if (L >= nwg) return false;
        int wgid = (int)L; { const int q = nwg / NXCD, r = nwg % NXCD, xcd = wgid % NXCD, off = wgid / NXCD; wgid = (xcd < r ? xcd * (q + 1) : r * (q + 1) + (xcd - r) * q) + off; }
        const int nig = WGM * nN, gid = wgid / nig, fm = gid * WGM, gsz = (nM - fm) < WGM ? (nM - fm) : WGM;
        u.pm = fm + ((wgid % nig) % gsz); u.pn = (wgid % nig) / gsz; return true;
    }
    __device__ __forceinline__ void a_ready(const Unit&) const {}
    __device__ __forceinline__ void done(const Unit&) const {}
};

typedef float f32x2_t __attribute__((ext_vector_type(2))); typedef __bf16 bf16x2_t __attribute__((ext_vector_type(2)));
__device__ __forceinline__ unsigned cvt_pk_bf16(float lo, float hi) { f32x2_t v = {lo, hi}; bf16x2_t b = __builtin_convertvector(v, bf16x2_t); return __builtin_bit_cast(unsigned, b); }
__device__ __forceinline__ float fast_sigmoid(float x) { return __builtin_amdgcn_rcpf(1.0f + __builtin_amdgcn_exp2f(-1.4426950408889634f * x)); }

struct EpiBf16 {
    static constexpr bool PERM = true, AFTER_DRAIN = false;
    bf16_t* O; int ldc;
    __device__ __forceinline__ void operator()(const f32x4 (&acc)[2][2][4][2], const Unit& u, int wr, int wc, int fr, int fq) const {
        const int row0 = u.pm * BM + wr * 64 + fr; const int col0 = u.pn * BM + wc * 32 + 8 * fq;
#pragma unroll
        for (int ai = 0; ai < 2; ++ai)
#pragma unroll
            for (int m = 0; m < 4; ++m) { bf16_t* rowp = O + (size_t)(row0 + ai * HALF + m * 16) * ldc + col0;
#pragma unroll
                for (int bj = 0; bj < 2; ++bj) { const f32x4 v0 = acc[ai][bj][m][0], v1 = acc[ai][bj][m][1];
                    u32x4 w; w.x = cvt_pk_bf16(v0[0], v0[1]); w.y = cvt_pk_bf16(v0[2], v0[3]); w.z = cvt_pk_bf16(v1[0], v1[1]); w.w = cvt_pk_bf16(v1[2], v1[3]);
                    *(u32x4*)(rowp + bj * HALF) = w; } }
    }
};
template <int ACT> struct EpiPair {
    static constexpr bool PERM = true, AFTER_DRAIN = false;
    bf16_t* O; int ldc; int coff;
    __device__ __forceinline__ void operator()(const f32x4 (&acc)[2][2][4][2], const Unit& u, int wr, int wc, int fr, int fq) const {
        const int row0 = u.pm * BM + wr * 64 + fr; const int col0 = coff + u.pn * HALF + wc * 32 + 8 * fq;
#pragma unroll
        for (int ai = 0; ai < 2; ++ai)
#pragma unroll
            for (int m = 0; m < 4; ++m) { bf16_t* rowp = O + (size_t)(row0 + ai * HALF + m * 16) * ldc + col0;
                float r[8];
#pragma unroll
                for (int n = 0; n < 2; ++n)
#pragma unroll
                    for (int j = 0; j < 4; ++j) { const float a = acc[ai][0][m][n][j], g = acc[ai][1][m][n][j];
                        r[n * 4 + j] = (ACT == 0) ? a * fast_sigmoid(a) * g : a * fast_sigmoid(g); }
                u32x4 w; w.x = cvt_pk_bf16(r[0], r[1]); w.y = cvt_pk_bf16(r[2], r[3]); w.z = cvt_pk_bf16(r[4], r[5]); w.w = cvt_pk_bf16(r[6], r[7]);
                *(u32x4*)rowp = w; }
    }
};
struct EpiResid {
    static constexpr bool PERM = false, AFTER_DRAIN = false;
    float* X; const float* gate0; int gstride; float s;
    const float* Xp; const float* Xs;
    __device__ __forceinline__ void operator()(const f32x4 (&acc)[2][2][4][2], const Unit& u, int wr, int wc, int fr, int fq) const {
        const int row0 = u.pm * BM + wr * 64 + fr, col0 = u.pn * BM + wc * 32 + 4 * fq;
        const int var = u.pm < 16 ? 0 : (u.pm < 20 ? 1 : 2);
        const float* gp = gate0 + (size_t)var * gstride + col0;
        const ptrdiff_t srcoff = Xp ? (u.pm < 16 ? Xp - X : (Xs - (size_t)NPR * DM) - X) : 0;
        f32x4 gv[2][2];
#pragma unroll
        for (int bj = 0; bj < 2; ++bj)
#pragma unroll
            for (int n = 0; n < 2; ++n) gv[bj][n] = *(const f32x4*)(gp + bj * HALF + n * 16) * s;
#pragma unroll
        for (int ai = 0; ai < 2; ++ai)
#pragma unroll
            for (int m = 0; m < 4; ++m) { float* rowp = X + (size_t)(row0 + ai * HALF + m * 16) * DM + col0;
#pragma unroll
                for (int bj = 0; bj < 2; ++bj)
#pragma unroll
                    for (int n = 0; n < 2; ++n) { float* p = rowp + bj * HALF + n * 16; const f32x4 x = *(const f32x4*)(p + srcoff); *(f32x4*)p = x + gv[bj][n] * acc[ai][bj][m][n]; } }
    }
};

template <class Epi, class Sched, bool ALIGN_EPI = false, bool SP2 = false>
__device__ __forceinline__ void gemm_phase(PG8_LAS unsigned char* lds, const Gemm g, const Sched& S, const Epi& E, int tid0) {
    int tid_ = tid0; asm volatile("" : "+v"(tid_));
    const int tid = tid_, wid = __builtin_amdgcn_readfirstlane(tid >> 6), lane = tid & 63, wr = wid >> 2, wc = wid & 3, fr = lane & 15, fq = lane >> 4;
    const int K = g.K, nt = K / BK;
    unsigned voffA[2], voffB[2];
#pragma unroll
    for (int i = 0; i < 2; ++i) { int R, C; stage_rc(tid * 16 + i * 8192, R, C); const int Rb = Epi::PERM ? ((R & ~31) + perm32(R & 31)) : R;
        voffA[i] = (unsigned)(R * K + C) * 2u; voffB[i] = (unsigned)(Rb * K + C) * 2u; }
    const size_t kstep = (size_t)(BK * 2);
    const size_t hstep = (size_t)HALF * K * 2;
    const size_t tstep = 2 * hstep;
    const unsigned ldsw = (unsigned)wid * 1024u;
    const int aoff = lds_byte(wr * 64 + fr, fq * 8), boff = lds_byte(wc * 32 + fr, fq * 8);
#define PG8_SA(b, h) (((b) * 2 + (h)) * HTB)
#define PG8_SB(b, h) ((4 + (b) * 2 + (h)) * HTB)
#define PG8_STAGE(bufoff, gbase, voff) do { _Pragma("unroll") for (int _i = 0; _i < 2; ++_i) \
        __builtin_amdgcn_global_load_lds((const unsigned*)((const char*)(gbase) + (voff)[_i]), (PG8_LAS unsigned*)(lds + (bufoff) + ldsw + _i * 8192), 16, 0, 0); } while (0)
#define PG8_LDA(dst, b, h) do { _Pragma("unroll") for (int m = 0; m < 4; ++m) _Pragma("unroll") for (int k = 0; k < 2; ++k) dst[m][k] = *(const PG8_LAS bf16x8*)(lds + PG8_SA(b, h) + aoff + m * 2048 + k * 1024); } while (0)
#define PG8_LDB(dst, b, h) do { _Pragma("unroll") for (int n = 0; n < 2; ++n) _Pragma("unroll") for (int k = 0; k < 2; ++k) dst[n][k] = *(const PG8_LAS bf16x8*)(lds + PG8_SB(b, h) + boff + n * 2048 + k * 1024); } while (0)
#define PG8_MMA(ai, bj, At, Bt) do { __builtin_amdgcn_s_setprio(1); _Pragma("unroll") for (int m = 0; m < 4; ++m) _Pragma("unroll") for (int n = 0; n < 2; ++n) _Pragma("unroll") for (int k = 0; k < 2; ++k) \
        acc[ai][bj][m][n] = __builtin_amdgcn_mfma_f32_16x16x32_bf16(Bt[n][k], At[m][k], acc[ai][bj][m][n], 0, 0, 0); __builtin_amdgcn_s_setprio(0); } while (0)
#define PG8_WAIT_V(n) asm volatile("s_waitcnt vmcnt(" #n ")" ::: "memory")
#define PG8_WAIT_L(n) asm volatile("s_waitcnt lgkmcnt(" #n ")" ::: "memory")
#define PG8_BAR __builtin_amdgcn_s_barrier()
#define PG8_SCHED __builtin_amdgcn_sched_barrier(0)
    Unit cur, nxt; int ui = 0;
    if (!S.next(0, cur)) return;
    f32x4 acc[2][2][4][2];
#pragma unroll
    for (int a = 0; a < 2; ++a)
#pragma unroll
        for (int b = 0; b < 2; ++b)
#pragma unroll
            for (int m = 0; m < 4; ++m)
#pragma unroll
                for (int n = 0; n < 2; ++n) acc[a][b][m][n] = (f32x4){0.f, 0.f, 0.f, 0.f};
    bf16x8 At[4][2], B0[2][2], B1[2][2];
    const char* cA = (const char*)g.A + (size_t)cur.pm * tstep; const char* cB = (const char*)g.Bt + (size_t)cur.pn * tstep;
    S.a_ready(cur);
    if constexpr (SP2) {
        PG8_STAGE(PG8_SB(0, 0), cB, voffB); PG8_STAGE(PG8_SB(0, 1), cB + hstep, voffB); PG8_STAGE(PG8_SA(0, 0), cA, voffA); PG8_STAGE(PG8_SA(0, 1), cA + hstep, voffA);
        if (wr == 1) PG8_BAR;
        PG8_WAIT_V(2); PG8_BAR;
        PG8_STAGE(PG8_SB(1, 0), cB + kstep, voffB); PG8_STAGE(PG8_SA(1, 0), cA + kstep, voffA); PG8_STAGE(PG8_SB(1, 1), cB + hstep + kstep, voffB);
        PG8_WAIT_V(6); PG8_BAR;
    } else {
        PG8_STAGE(PG8_SB(0, 0), cB, voffB); PG8_STAGE(PG8_SA(0, 0), cA, voffA); PG8_STAGE(PG8_SB(0, 1), cB + hstep, voffB); PG8_STAGE(PG8_SA(0, 1), cA + hstep, voffA);
        if (wr == 1) PG8_BAR;
        PG8_WAIT_V(4); PG8_BAR;
        PG8_STAGE(PG8_SB(1, 0), cB + kstep, voffB); PG8_STAGE(PG8_SA(1, 0), cA + kstep, voffA); PG8_STAGE(PG8_SB(1, 1), cB + hstep + kstep, voffB);
        PG8_WAIT_V(6); PG8_BAR;
    }
    for (;;) {
        const bool has_next = S.next(ui + 1, nxt);
        const char* nA = has_next ? (const char*)g.A + (size_t)nxt.pm * tstep : cA; const char* nB = has_next ? (const char*)g.Bt + (size_t)nxt.pn * tstep : cB;
        for (int t = 0; t < nt; t += 2) {
            const bool last = (t == nt - 2);
            const char* a1 = cA + (size_t)(t + 1) * kstep;
            const char* a2 = last ? nA : cA + (size_t)(t + 2) * kstep; const char* b2 = last ? nB : cB + (size_t)(t + 2) * kstep;
            const char* a3 = a2 + kstep; const char* b3 = b2 + kstep;
            if (last && has_next) S.a_ready(nxt);
            if constexpr (SP2) {
            PG8_LDB(B0, 0, 0); PG8_LDB(B1, 0, 1); PG8_SCHED; PG8_LDA(At, 0, 0); PG8_STAGE(PG8_SA(1, 1), a1 + hstep, voffA);
            PG8_WAIT_V(8); PG8_WAIT_L(0); PG8_BAR; PG8_MMA(0, 0, At, B0); PG8_MMA(0, 1, At, B1); PG8_BAR; PG8_SCHED;
            PG8_LDA(At, 0, 1); PG8_STAGE(PG8_SB(0, 0), b2, voffB); PG8_STAGE(PG8_SB(0, 1), b2 + hstep, voffB); PG8_STAGE(PG8_SA(0, 0), a2, voffA);
            PG8_WAIT_V(8); PG8_WAIT_L(0); PG8_BAR; PG8_MMA(1, 0, At, B0); PG8_MMA(1, 1, At, B1); PG8_BAR; PG8_SCHED;
            PG8_LDB(B0, 1, 0); PG8_LDB(B1, 1, 1); PG8_SCHED; PG8_LDA(At, 1, 0); PG8_STAGE(PG8_SA(0, 1), a2 + hstep, voffA);
            PG8_WAIT_V(8); PG8_WAIT_L(0); PG8_BAR; PG8_MMA(0, 0, At, B0); PG8_MMA(0, 1, At, B1); PG8_BAR; PG8_SCHED;
            PG8_LDA(At, 1, 1); PG8_STAGE(PG8_SB(1, 0), b3, voffB); PG8_STAGE(PG8_SB(1, 1), b3 + hstep, voffB); PG8_STAGE(PG8_SA(1, 0), a3, voffA);
            PG8_WAIT_V(8); PG8_WAIT_L(0); PG8_BAR; PG8_MMA(1, 0, At, B0); PG8_MMA(1, 1, At, B1); PG8_BAR; PG8_SCHED;
            } else {
            PG8_LDB(B0, 0, 0); PG8_SCHED; PG8_LDA(At, 0, 0); PG8_STAGE(PG8_SA(1, 1), a1 + hstep, voffA);
            PG8_WAIT_L(8); PG8_BAR; PG8_WAIT_L(0); PG8_MMA(0, 0, At, B0); PG8_BAR; PG8_SCHED;
            PG8_LDB(B1, 0, 1); PG8_STAGE(PG8_SB(0, 0), b2, voffB);
            PG8_BAR; PG8_WAIT_L(0); PG8_MMA(0, 1, At, B1); PG8_BAR;
            PG8_LDA(At, 0, 1); PG8_STAGE(PG8_SA(0, 0), a2, voffA);
            PG8_BAR; PG8_WAIT_L(0); PG8_MMA(1, 0, At, B0); PG8_BAR; PG8_SCHED;
            PG8_STAGE(PG8_SB(0, 1), b2 + hstep, voffB);
            PG8_WAIT_V(6); PG8_BAR; PG8_MMA(1, 1, At, B1); PG8_BAR;
            PG8_LDB(B0, 1, 0); PG8_SCHED; PG8_LDA(At, 1, 0); PG8_STAGE(PG8_SA(0, 1), a2 + hstep, voffA);
            PG8_WAIT_L(8); PG8_BAR; PG8_WAIT_L(0); PG8_MMA(0, 0, At, B0); PG8_BAR; PG8_SCHED;
            PG8_LDB(B1, 1, 1); PG8_STAGE(PG8_SB(1, 0), b3, voffB);
            PG8_BAR; PG8_WAIT_L(0); PG8_MMA(0, 1, At, B1); PG8_BAR;
            PG8_LDA(At, 1, 1); PG8_STAGE(PG8_SA(1, 0), a3, voffA);
            PG8_BAR; PG8_WAIT_L(0); PG8_MMA(1, 0, At, B0); PG8_BAR; PG8_SCHED;
            PG8_STAGE(PG8_SB(1, 1), b3 + hstep, voffB);
            PG8_WAIT_V(6); PG8_BAR; PG8_MMA(1, 1, At, B1); PG8_BAR;
            }
        }
        if constexpr (ALIGN_EPI) { if (wr == 0) PG8_BAR; }
        if constexpr (!Epi::AFTER_DRAIN) { E(acc, cur, wr, wc, fr, fq); S.done(cur); }
        if (!has_next) break;
#pragma unroll
        for (int a = 0; a < 2; ++a)
#pragma unroll
            for (int b = 0; b < 2; ++b)
#pragma unroll
                for (int m = 0; m < 4; ++m)
#pragma unroll
                    for (int n = 0; n < 2; ++n) acc[a][b][m][n] = (f32x4){0.f, 0.f, 0.f, 0.f};
        cur = nxt; cA = nA; cB = nB; ++ui;
        if constexpr (ALIGN_EPI) { if (wr == 1) PG8_BAR; }
    }
    PG8_WAIT_V(0);
    if constexpr (!ALIGN_EPI) { if (wr == 0) PG8_BAR; }
    PG8_BAR;
    if constexpr (Epi::AFTER_DRAIN) { E.fused(acc, cur, wr, wc, fr, fq, lds, wid, lane); S.done(cur); }
#undef PG8_SA
#undef PG8_SB
#undef PG8_STAGE
#undef PG8_LDA
#undef PG8_LDB
#undef PG8_MMA
#undef PG8_WAIT_V
#undef PG8_WAIT_L
#undef PG8_BAR
#undef PG8_SCHED
}
}

typedef unsigned short bf16;
typedef unsigned v4u __attribute__((ext_vector_type(4)));
typedef float f32x4 __attribute__((ext_vector_type(4)));
#define GAS __attribute__((address_space(1)))
#define LAS __attribute__((address_space(3)))
typedef GAS unsigned gu32;
#define RLX_AGENT __ATOMIC_RELAXED, __HIP_MEMORY_SCOPE_AGENT
#define LDS_WAIT() asm volatile("s_waitcnt lgkmcnt(0)" ::: "memory")
#define VM_WAIT() asm volatile("s_waitcnt vmcnt(0)" ::: "memory")

constexpr int NWAVES = 8;
#ifndef MIXER_NAIVE
#define MIXER_NAIVE 0
#endif
#ifndef MK_ONE_LAUNCH
#define MK_ONE_LAUNCH 0
#endif
constexpr size_t MiB = 1u << 20;
constexpr size_t WS_CTL = 0, CTL_ZERO_BYTES = 2 * MiB;
constexpr size_t WS_MOD = 1 * MiB;
constexpr size_t WS_COS = 2 * MiB, WS_SIN = 2 * MiB + 256 * 1024, WS_LAM = 2 * MiB + 512 * 1024, WS_BBAR = 3 * MiB;
constexpr size_t WS_WFI = 8 * MiB, WS_WFO = 184 * MiB, WS_WIN = 272 * MiB, WS_WOUT = 304 * MiB, WS_WGLU = 320 * MiB;
constexpr size_t WS_XR = 322 * MiB, WS_H = 370 * MiB, WS_ACT = 394 * MiB, WS_PROJ = 460 * MiB, WS_QB = 508 * MiB;
constexpr size_t WS_KP = 520 * MiB, WS_VP = 522 * MiB, WS_KS = 524 * MiB, WS_VS = 526 * MiB, WS_QR = 528 * MiB, WS_KR = 534 * MiB;
constexpr size_t WS_MIX = 540 * MiB, WS_YS = 564 * MiB, WS_YSB = 576 * MiB, WS_END = 582 * MiB;
constexpr int CW_BAR = 4096;
constexpr int RING_BYTES = 131072, LDSCTL_OFF = RING_BYTES, MISC_OFF = LDSCTL_OFF + 320, LDS_BYTES = 147456;

__device__ __forceinline__ unsigned f2bf(float f) { unsigned u = __builtin_bit_cast(unsigned, f); return (u + 0x7fffu + ((u >> 16) & 1u)) >> 16; }
__device__ __forceinline__ unsigned pk2(float lo, float hi) { return f2bf(lo) | (f2bf(hi) << 16); }
__device__ __forceinline__ float bf2f(unsigned short h) { return __builtin_bit_cast(float, (unsigned)h << 16); }
__device__ __forceinline__ float bflo(unsigned w) { return __builtin_bit_cast(float, w << 16); }
__device__ __forceinline__ float bfhi(unsigned w) { return __builtin_bit_cast(float, w & 0xffff0000u); }

#define XB_TMO      128
#define XB_XCNT(j)  (256  + 64 * (j))
#define XB_XSUB(j)  (1280 + 64 * (j))
#define XB_XGEN(j)  (2304 + 64 * (j))
#define XB_TOP      3328
#define XB_TOPGEN   3392
#define XCD_BAR_WORDS 3456
#define XB_SPIN_CAP (1u << 18)
__device__ __forceinline__ unsigned xb_ld(unsigned* p)              { return __hip_atomic_load(p, __ATOMIC_RELAXED, __HIP_MEMORY_SCOPE_AGENT); }
__device__ __forceinline__ unsigned xb_add(unsigned* p, unsigned v) { return __hip_atomic_fetch_add(p, v, __ATOMIC_RELAXED, __HIP_MEMORY_SCOPE_AGENT); }
__device__ __forceinline__ unsigned xb_xcc_id() { return (unsigned)__builtin_amdgcn_s_getreg((3 << 11) | 20) & 0xFu; }
#define XB_SPIN(cond, bar) do { unsigned _sp = 0; while (cond) { __builtin_amdgcn_s_sleep(1); \
    if ((++_sp & 255u) == 0u) { if (xb_ld(&(bar)[XB_TMO])) break; if (_sp > XB_SPIN_CAP) { atomicAdd(&(bar)[XB_TMO], 1u); break; } } } } while (0)
struct XcdBarrier { unsigned* bar; unsigned x; volatile LAS unsigned* st; };
__device__ __forceinline__ XcdBarrier xcd_barrier_post(unsigned* bar, volatile LAS unsigned* st) {
    XcdBarrier b; b.bar = bar; b.x = xb_xcc_id(); b.st = st;
    if (threadIdx.x == 0) (void)xb_add(&bar[XB_XCNT(b.x)], 1u);
    return b;
}
__device__ __forceinline__ void xcd_barrier_complete(unsigned* bar, unsigned x, unsigned& nloc, unsigned& nx) {
    const unsigned G = gridDim.x * gridDim.y * gridDim.z;
    unsigned sum, cnt, mine, sp = 0u;
    for (;;) {
        sum = 0u; cnt = 0u; mine = 0u;
#pragma unroll
        for (unsigned j = 0; j < 16; ++j) { const unsigned c = xb_ld(&bar[XB_XCNT(j)]); sum += c; cnt += (c > 0u) ? 1u : 0u; mine = (j == x) ? c : mine; }
        if (sum == G) break;
        __builtin_amdgcn_s_sleep(1);
        if ((++sp & 255u) == 0u) { if (xb_ld(&bar[XB_TMO])) break; if (sp > XB_SPIN_CAP) { atomicAdd(&bar[XB_TMO], 1u); break; } }
    }
    nloc = mine > 0u ? mine : 1u; nx = cnt > 0u ? cnt : 1u;
}
__device__ __forceinline__ void xcd_barrier(const XcdBarrier& b, int tid) {
    asm volatile("s_waitcnt vmcnt(0)" ::: "memory");
    __syncthreads();
    if (tid == 0) {
        unsigned* bar = b.bar; asm volatile("" : "+s"(bar));
        __builtin_amdgcn_s_waitcnt(0);
        unsigned nloc = b.st[0], nx = b.st[1];
        if (nloc == 0u) { xcd_barrier_complete(bar, b.x, nloc, nx); b.st[0] = nloc; b.st[1] = nx; }
        const unsigned old = xb_add(&bar[XB_XSUB(b.x)], 1u);
        const unsigned gen = old / nloc;
        if (old + 1u == (gen + 1u) * nloc) {
            __builtin_amdgcn_fence(__ATOMIC_RELEASE, "agent");
            asm volatile("s_waitcnt vmcnt(0)" ::: "memory");
            const unsigned og = xb_add(&bar[XB_TOP], 1u);
            const unsigned tg = og / nx;
            if (og + 1u == (tg + 1u) * nx) xb_add(&bar[XB_TOPGEN], 1u);
            else XB_SPIN(xb_ld(&bar[XB_TOPGEN]) == tg, bar);
            __builtin_amdgcn_fence(__ATOMIC_ACQUIRE, "agent");
            xb_add(&bar[XB_XGEN(b.x)], 1u);
            asm volatile("s_waitcnt vmcnt(0)" ::: "memory");
        } else {
            XB_SPIN(xb_ld(&bar[XB_XGEN(b.x)]) == gen, bar);
            __builtin_amdgcn_fence(__ATOMIC_ACQUIRE, "agent");
            asm volatile("s_waitcnt vmcnt(0)" ::: "memory");
        }
    }
    __syncthreads();
}

struct KArgs { const float* in[28]; float* out; unsigned char* ws; int ph_lo, ph_hi, li, pad; };
typedef const __attribute__((address_space(4))) KArgs* KA;
enum { I_XP = 0, I_XS, I_CK, I_CV, I_SSSM, I_SRET, I_C, I_CCTX, I_WMOD, I_BMOD, I_NORMG, I_WFI, I_WFO, I_WIN, I_WOUT, I_QNG, I_KNG,
       I_ARE, I_AIM, I_LOGDT, I_BRE, I_BIM, I_CRE, I_CIM, I_SSMD, I_WGLU, I_DECAY, I_FNG };

struct Frame {
    LAS unsigned char* lds;
    int tid, lane, wave, G, gw, NGW;
};

template <int O> __device__ __forceinline__ float shx(float v) { return __builtin_bit_cast(float, __builtin_amdgcn_ds_swizzle(__builtin_bit_cast(int, v), (O << 10) | 0x1f)); }
__device__ __forceinline__ float wave_sum(float v) {
    v += shx<1>(v); v += shx<2>(v); v += shx<4>(v); v += shx<8>(v); v += shx<16>(v);
    const auto rr = __builtin_amdgcn_permlane32_swap(__float_as_uint(v), __float_as_uint(v), false, false);
    return __uint_as_float(rr[0]) + __uint_as_float(rr[1]);
}
__device__ __forceinline__ float wave_max(float v) {
    v = fmaxf(v, shx<1>(v)); v = fmaxf(v, shx<2>(v)); v = fmaxf(v, shx<4>(v)); v = fmaxf(v, shx<8>(v)); v = fmaxf(v, shx<16>(v));
    const auto rr = __builtin_amdgcn_permlane32_swap(__float_as_uint(v), __float_as_uint(v), false, false);
    return fmaxf(__uint_as_float(rr[0]), __uint_as_float(rr[1]));
}
__device__ __forceinline__ float silu_f(float x) { return x / (1.0f + __expf(-x)); }
__device__ __forceinline__ float gelu_tanh(float x) { const float u = 0.7978845608028654f * (x + 0.044715f * x * x * x); return 0.5f * x * (1.0f + tanhf(u)); }

__device__ __forceinline__ void p0_transpose_item(const float* W, int K, int N, bf16* WT, int halfN, LAS float* scr, int item, int lane) {
    const int nblk = N / 32, kb = item / nblk, nb = item % nblk, k0 = 64 * kb, n0 = 32 * nb;
    int R0 = n0;
    if (halfN) { if (n0 < halfN) R0 = 256 * (n0 >> 7) + (n0 & 127); else { const int n1 = n0 - halfN; R0 = 256 * (n1 >> 7) + 128 + (n1 & 127); } }
    float wv[32];
    const float* wsrc = W + (size_t)(k0 + (lane >> 5)) * N + n0 + (lane & 31);
#pragma unroll
    for (int i = 0; i < 32; ++i) wv[i] = __builtin_nontemporal_load(wsrc + (size_t)(2 * i) * N);
#pragma unroll
    for (int i = 0; i < 32; ++i) scr[(2 * i + (lane >> 5)) * 33 + (lane & 31)] = wv[i];
    LDS_WAIT(); asm volatile("" ::: "memory");
    const int c = lane & 7;
#pragma unroll
    for (int j = 0; j < 4; ++j) { const int n = (lane >> 3) + 8 * j; const LAS float* s = scr + (8 * c) * 33 + n;
        v4u o; o.x = pk2(s[0 * 33], s[1 * 33]); o.y = pk2(s[2 * 33], s[3 * 33]); o.z = pk2(s[4 * 33], s[5 * 33]); o.w = pk2(s[6 * 33], s[7 * 33]);
        __builtin_nontemporal_store(o, (GAS v4u*)(WT + (size_t)(R0 + n) * K + k0 + 8 * c)); }
    LDS_WAIT(); asm volatile("" ::: "memory");
}

__device__ __forceinline__ void mod_stage(const Frame& F, KA a) {
    LAS float* cs = (LAS float*)(F.lds);
    for (int i = F.tid; i < 3 * DM; i += 512) { const int v = i / DM, k = i % DM; const float c = v == 0 ? a->in[I_CCTX][k] : a->in[I_C][(v - 1) * DM + k]; cs[i] = silu_f(c); }
    __syncthreads();
}
__device__ __forceinline__ void mod_task(const Frame& F, KA a, int task) {
    LAS float* cs = (LAS float*)(F.lds); LAS float* red = (LAS float*)(F.lds + 24576);
    float* modb = (float*)(a->ws + WS_MOD);
    const int l = task / 576, r = task % 576, cb = r / 8, kc = r % 8;
    const int kbase = kc * 256 + F.wave * 32, col = cb * 256 + F.lane * 4;
    const float* wp = a->in[I_WMOD] + ((size_t)l * DM + kbase) * MODW + col;
    f32x4 s0 = {0, 0, 0, 0}, s1 = s0, s2 = s0;
#pragma unroll 8
    for (int k = 0; k < 32; ++k) { const f32x4 w = __builtin_nontemporal_load((const GAS f32x4*)(wp + (size_t)k * MODW));
        s0 += w * cs[kbase + k]; s1 += w * cs[DM + kbase + k]; s2 += w * cs[2 * DM + kbase + k]; }
    LAS float* rp = red + (F.wave * 64 + F.lane) * 12;
#pragma unroll
    for (int j = 0; j < 4; ++j) { rp[j] = s0[j]; rp[4 + j] = s1[j]; rp[8 + j] = s2[j]; }
    __syncthreads();
    for (int o = F.tid; o < 768; o += 512) { const int v = o >> 8, c = o & 255; float s = 0.f;
#pragma unroll
        for (int w = 0; w < 8; ++w) s += red[(w * 64 + (c >> 2)) * 12 + v * 4 + (c & 3)];
        if (kc == 0) s += a->in[I_BMOD][l * MODW + cb * 256 + c];
        unsafeAtomicAdd(modb + ((size_t)l * 3 + v) * MODW + cb * 256 + c, s); }
    __syncthreads();
}
constexpr int I_FI = (DM / 64) * (2 * DFF / 32), I_FO = (DFF / 64) * (DM / 32), I_IN = (DM / 64) * (INW / 32), I_OUT = (DM / 64) * (DM / 32), I_GL = (512 / 64) * (1024 / 32);
__device__ __forceinline__ int conv_items(int id) { return id < 4 ? I_FI : id < 8 ? I_FO : id < 10 ? I_IN : id < 12 ? I_OUT : I_GL; }
__device__ __forceinline__ void conv_item(KA a, int id, int it, LAS float* scr, int lane) {
    unsigned char* ws = a->ws;
    if (id < 4) p0_transpose_item(a->in[I_WFI] + (size_t)id * DM * 2 * DFF, DM, 2 * DFF, (bf16*)(ws + WS_WFI) + (size_t)id * 2 * DFF * DM, DFF, scr, it, lane);
    else if (id < 8) p0_transpose_item(a->in[I_WFO] + (size_t)(id - 4) * DFF * DM, DFF, DM, (bf16*)(ws + WS_WFO) + (size_t)(id - 4) * DM * DFF, 0, scr, it, lane);
    else if (id < 10) p0_transpose_item(a->in[I_WIN] + (size_t)(id - 8) * DM * INW, DM, INW, (bf16*)(ws + WS_WIN) + (size_t)(id - 8) * INW * DM, 0, scr, it, lane);
    else if (id < 12) p0_transpose_item(a->in[I_WOUT] + (size_t)(id - 10) * DM * DM, DM, DM, (bf16*)(ws + WS_WOUT) + (size_t)(id - 10) * DM * DM, 0, scr, it, lane);
    else p0_transpose_item(a->in[I_WGLU] + (size_t)(id - 12) * 512 * 1024, 512, 1024, (bf16*)(ws + WS_WGLU) + (size_t)(id - 12) * 1024 * 512, 512, scr, it, lane);
}
constexpr int CW_Q = 8192;
__device__ __forceinline__ int slot_mat(int slot, int j) {
    switch (slot) {
        case 0: return j == 0 ? 0 : -1;
        case 1: return j == 0 ? 4 : j == 1 ? 8 : j == 2 ? 10 : 12;
        case 2: return j == 0 ? 1 : j == 1 ? 5 : -1;
        case 4: return j == 0 ? 9 : j == 1 ? 11 : j == 2 ? 13 : -1;
        case 5: return j == 0 ? 2 : -1;
        case 6: return j == 0 ? 6 : j == 1 ? 3 : -1;
        case 7: return j == 0 ? 7 : -1;
        default: return -1;
    }
}
__device__ __forceinline__ void side_jobs(const Frame& F, KA a, int slot) {
    if (slot < 0) return;
    LAS unsigned* qb = (LAS unsigned*)(F.lds + 126976);
    unsigned* qc = (unsigned*)(a->ws + WS_CTL) + CW_Q + 64 * slot;
    if (slot == 3) {
        mod_stage(F, a);
        for (;;) {
            if (F.tid == 0) *qb = __hip_atomic_fetch_add(qc, 1u, __ATOMIC_RELAXED, __HIP_MEMORY_SCOPE_AGENT);
            __syncthreads();
            const unsigned t = *qb;
            if (t >= 576u) break;
            mod_task(F, a, 576 + (int)t);
        }
        __syncthreads();
        return;
    }
    int n0 = 0, n1 = 0, n2 = 0, n3 = 0;
    { const int m0 = slot_mat(slot, 0), m1 = slot_mat(slot, 1), m2 = slot_mat(slot, 2), m3 = slot_mat(slot, 3);
      n0 = m0 >= 0 ? conv_items(m0) : 0; n1 = n0 + (m1 >= 0 ? conv_items(m1) : 0); n2 = n1 + (m2 >= 0 ? conv_items(m2) : 0); n3 = n2 + (m3 >= 0 ? conv_items(m3) : 0); }
    LAS float* scr = (LAS float*)(F.lds + 49152 + F.wave * 8704);
    for (;;) {
        if (F.tid == 0) *qb = __hip_atomic_fetch_add(qc, 64u, __ATOMIC_RELAXED, __HIP_MEMORY_SCOPE_AGENT);
        __syncthreads();
        const int base = (int)*qb;
        if (base >= n3) break;
        const int end = base + 64 < n3 ? base + 64 : n3;
        for (int it = base + F.wave; it < end; it += 8) {
            const int j = it < n0 ? 0 : it < n1 ? 1 : it < n2 ? 2 : 3;
            conv_item(a, slot_mat(slot, j), it - (j == 0 ? 0 : j == 1 ? n0 : j == 2 ? n1 : n2), scr, F.lane);
        }
        __syncthreads();
    }
    __syncthreads();
}

__device__ __forceinline__ void phase_prologue(const Frame& F, KA a, int parts = 15) {
    unsigned char* ws = a->ws;
    if (parts & 1) {
        mod_stage(F, a);
        for (int task = blockIdx.x; task < 576; task += F.G) mod_task(F, a, task);
    }
    if (parts & 2) {
        float* cosT = (float*)(ws + WS_COS); float* sinT = (float*)(ws + WS_SIN);
        for (int i = blockIdx.x * 512 + F.tid; i < DSEQ * 64; i += F.G * 512) { const int t = i >> 6, j = i & 63, ax = j >> 5, f = j & 31;
            const float pos = (float)(ax == 0 ? (t >> 6) : (t & 63)); const float inv = powf(10000.0f, -(float)f / 32.0f); const float ang = pos * inv;
            float sn, cn; sincosf(ang, &sn, &cn); cosT[i] = cn; sinT[i] = sn; }
        float* lamT = (float*)(ws + WS_LAM); float* bbT = (float*)(ws + WS_BBAR);
        for (int i = blockIdx.x * 512 + F.tid; i < NLAYER * 2 * 32 * 64; i += F.G * 512) {
            const int ldg = i >> 6;
            const float dt = expf(a->in[I_LOGDT][ldg]); const float ar = a->in[I_ARE][i], ai = a->in[I_AIM][i];
            const float x = ar * dt, y = ai * dt; float sn, cn; sincosf(y, &sn, &cn); const float ex = expf(x);
            lamT[2 * i] = ex * cn; lamT[2 * i + 1] = ex * sn;
            const float sh = sinf(0.5f * y); const float nr = expm1f(x) * cn - 2.0f * sh * sh, ni = ex * sn;
            const float d2 = ar * ar + ai * ai; const float cr = (nr * ar + ni * ai) / d2, ci = (ni * ar - nr * ai) / d2;
#pragma unroll
            for (int j = 0; j < 16; ++j) { const float br = a->in[I_BRE][(size_t)i * 16 + j], bi = a->in[I_BIM][(size_t)i * 16 + j];
                bbT[((size_t)i * 16 + j) * 2] = cr * br - ci * bi; bbT[((size_t)i * 16 + j) * 2 + 1] = cr * bi + ci * br; }
        }
    }
    if (parts & 4) {
        GAS f32x4* xr = (GAS f32x4*)(ws + WS_XR);
        const GAS f32x4* xp = (const GAS f32x4*)a->in[I_XP]; const GAS f32x4* xs = (const GAS f32x4*)a->in[I_XS];
        const int NP4 = NPR * DM / 4, NT4 = MT * DM / 4;
        for (int i = blockIdx.x * 512 + F.tid; i < NT4; i += F.G * 512) xr[i] = i < NP4 ? xp[i] : xs[i - NP4];
    }
    if (parts & 8) { __syncthreads(); side_jobs(F, a, 0); }
}

__device__ __forceinline__ void phase_prenorm(const Frame& F, KA a, int l, int sub) {
    unsigned char* ws = a->ws;
    const float* xr = (const float*)(ws + WS_XR);
    const bool from_in = (l == 0 && sub == 0);
    auto rowptr = [&](int m) -> const GAS f32x4* { const float* p = from_in ? (m < NPR ? a->in[I_XP] + (size_t)m * DM : a->in[I_XS] + (size_t)(m - NPR) * DM) : xr + (size_t)m * DM; return (const GAS f32x4*)p + F.lane; };
    f32x4 v[8], nx[8];
    int m = F.gw;
    if (m < MT) { const GAS f32x4* xp = rowptr(m);
#pragma unroll
        for (int j = 0; j < 8; ++j) nx[j] = xp[64 * j]; }
    for (; m < MT; m += F.NGW) {
        float s = 0.f;
#pragma unroll
        for (int j = 0; j < 8; ++j) { v[j] = nx[j]; s += (v[j].x * v[j].x + v[j].y * v[j].y) + (v[j].z * v[j].z + v[j].w * v[j].w); }
        if (m + F.NGW < MT) { const GAS f32x4* xp = rowptr(m + F.NGW);
#pragma unroll
            for (int j = 0; j < 8; ++j) nx[j] = xp[64 * j]; }
        const float rstd = 1.0f / sqrtf(wave_sum(s) * (1.0f / DM) + EPS);
        if (sub == 3) {
            const GAS f32x4* gp = (const GAS f32x4*)a->in[I_FNG] + F.lane; GAS f32x4* op = (GAS f32x4*)(a->out + O_Y + (size_t)m * DM) + F.lane;
#pragma unroll
            for (int j = 0; j < 8; ++j) op[64 * j] = v[j] * rstd * gp[64 * j];
        } else {
            const int var = m < NPR ? 0 : 1 + (m - NPR) / DSEQ;
            const float* mod = (const float*)(ws + WS_MOD) + ((size_t)l * 3 + var) * MODW + sub * 3 * DM;
            const GAS f32x4* gp = (const GAS f32x4*)(a->in[I_NORMG] + ((size_t)l * 3 + sub) * DM) + F.lane;
            const GAS f32x4* shp = (const GAS f32x4*)mod + F.lane; const GAS f32x4* scp = (const GAS f32x4*)(mod + DM) + F.lane;
            GAS unsigned long long* o8 = (GAS unsigned long long*)((bf16*)(ws + WS_H) + (size_t)m * DM) + F.lane;
#pragma unroll
            for (int j = 0; j < 8; ++j) { const f32x4 y = v[j] * rstd * gp[64 * j] * (scp[64 * j] + 1.0f) + shp[64 * j];
                o8[64 * j] = (unsigned long long)pk2(y.x, y.y) | ((unsigned long long)pk2(y.z, y.w) << 32); }
        }
    }
}

__device__ __forceinline__ void phase_qkvpost(const Frame& F, KA a, int l) {
    unsigned char* ws = a->ws;
    const bf16* proj = (const bf16*)(ws + WS_PROJ);
    const float* cosT = (const float*)(ws + WS_COS); const float* sinT = (const float*)(ws + WS_SIN);
    const int i = F.lane, e0 = (i & 31) + 64 * (i >> 5), e1 = e0 + 32;
    const float qg0 = a->in[I_QNG][l * 128 + e0], qg1 = a->in[I_QNG][l * 128 + e1], kg0 = a->in[I_KNG][l * 128 + e0], kg1 = a->in[I_KNG][l * 128 + e1];
    for (int r0 = F.gw * 4; r0 < NBS * PAST * 2 * 2; r0 += F.NGW * 4) {
        float c0[4], c1[4];
#pragma unroll
        for (int j = 0; j < 4; ++j) { const int r = r0 + j; const int isv = r & 1, kvh = (r >> 1) & 1, t = (r >> 2) % PAST, b = (r >> 2) / PAST;
            const float* src = a->in[isv ? I_CV : I_CK] + ((((size_t)b * NLAYER + l) * PAST + t) * 2 + kvh) * 128; c0[j] = src[e0]; c1[j] = src[e1]; }
#pragma unroll
        for (int j = 0; j < 4; ++j) { const int r = r0 + j; const int isv = r & 1, kvh = (r >> 1) & 1, t = (r >> 2) % PAST, b = (r >> 2) / PAST;
            bf16* dst = (bf16*)(ws + (isv ? WS_VS : WS_KS)) + ((size_t)b * KALL + t) * 256 + kvh * 128; dst[e0] = (bf16)f2bf(c0[j]); dst[e1] = (bf16)f2bf(c1[j]); }
    }
    for (int m = F.gw; m < MT; m += F.NGW) {
        const bool lat = m >= NPR; const int b = lat ? (m - NPR) / DSEQ : m / SEQ, t = lat ? (m - NPR) % DSEQ : m % SEQ;
        const bf16* prow = proj + (size_t)m * INW;
        float x0[20], x1[20];
#pragma unroll
        for (int ch = 0; ch < 20; ++ch) { const int scol = ch < 12 ? ch * 128 : (ch < 16 ? C_QR + (ch - 12) * 128 : C_KR + (ch - 16) * 128); x0[ch] = bf2f(prow[scol + e0]); x1[ch] = bf2f(prow[scol + e1]); }
        float cs = 1.f, sn = 0.f; if (lat) { cs = cosT[t * 64 + i]; sn = sinT[t * 64 + i]; }
#pragma unroll
        for (int ch = 0; ch < 20; ++ch) {
            float v0 = x0[ch], v1 = x1[ch];
            if (ch < 10) { const float ss = wave_sum(v0 * v0 + v1 * v1); const float r = 1.0f / sqrtf(ss * (1.0f / 128.0f) + EPS); v0 *= r * (ch < 8 ? qg0 : kg0); v1 *= r * (ch < 8 ? qg1 : kg1); }
            if (ch >= 16) { v0 *= 0.08838834764831845f; v1 *= 0.08838834764831845f; }
            if (lat && (ch < 10 || ch >= 12)) { const float y0 = v0 * cs - v1 * sn, y1 = v1 * cs + v0 * sn; v0 = y0; v1 = y1; }
            if (ch < 8) { bf16* d = (bf16*)(ws + WS_QB) + (size_t)m * 1024 + ch * 128; d[e0] = (bf16)f2bf(v0); d[e1] = (bf16)f2bf(v1); }
            else if (ch < 12) { const int isv = ch >= 10, kvh = (ch - 8) & 1;
                if (!lat) { float* o = a->out + (isv ? O_CV : O_CK) + ((((size_t)b * NLAYER + l) * SEQ + t) * 2 + kvh) * 128; o[e0] = v0; o[e1] = v1;
                    bf16* d = (bf16*)(ws + (isv ? WS_VP : WS_KP)) + (size_t)m * 256 + kvh * 128; d[e0] = (bf16)f2bf(v0); d[e1] = (bf16)f2bf(v1); }
                else { bf16* d = (bf16*)(ws + (isv ? WS_VS : WS_KS)) + ((size_t)b * KALL + PAST + t) * 256 + kvh * 128; d[e0] = (bf16)f2bf(v0); d[e1] = (bf16)f2bf(v1); } }
            else if (ch < 16) { bf16* d = (bf16*)(ws + WS_QR) + (size_t)m * 512 + (ch - 12) * 128; d[e0] = (bf16)f2bf(v0); d[e1] = (bf16)f2bf(v1); }
            else { bf16* d = (bf16*)(ws + WS_KR) + (size_t)m * 512 + (ch - 16) * 128; d[e0] = (bf16)f2bf(v0); d[e1] = (bf16)f2bf(v1); }
        }
    }
}

namespace mx {
using bf16x8 = __attribute__((ext_vector_type(8))) short;
using s16x4  = __attribute__((ext_vector_type(4))) short;
using f32x16 = __attribute__((ext_vector_type(16))) float;
using f32x8  = __attribute__((ext_vector_type(8))) float;
using u32x4  = __attribute__((ext_vector_type(4))) unsigned;
constexpr int D = 128, NW = 8, QBLK = 32, KVBLK = 64;
constexpr float SCALE = 0.088388347648318440f;
constexpr float THR = 8.f;
constexpr int SHM_V = KVBLK * D * 2, SHM_K = KVBLK * D * 2;
#define KSWZ(row, colB) ((row) * 256 + ((colB) ^ (((row) & 7) << 4)))
#define SBAR() __builtin_amdgcn_sched_barrier(0)
__device__ __forceinline__ int crow(int r, int hi) { return (r & 3) + 8 * (r >> 2) + 4 * hi; }
__device__ __forceinline__ unsigned cvtpk(float lo, float hi) { return pg8::cvt_pk_bf16(lo, hi); }
__device__ __forceinline__ bf16x8 ld8(const bf16* p) { return *reinterpret_cast<const bf16x8*>(p); }
__device__ __forceinline__ bf16x8 cvt8(f32x8 x) { u32x4 w = {cvtpk(x[0], x[1]), cvtpk(x[2], x[3]), cvtpk(x[4], x[5]), cvtpk(x[6], x[7])}; return *reinterpret_cast<bf16x8*>(&w); }

__device__ __forceinline__ void partialSM(f32x16& p0, f32x16& p1, float& m_reg, float& mn, float& alpha) {
  constexpr float C = SCALE * 1.4426950408889634f;
  float pmax = p0[0]; for (int r = 1; r < 16; ++r) pmax = fmaxf(pmax, p0[r]); for (int r = 0; r < 16; ++r) pmax = fmaxf(pmax, p1[r]);
  { auto rr = __builtin_amdgcn_permlane32_swap(__float_as_uint(pmax), __float_as_uint(pmax), false, false);
    pmax = fmaxf(__uint_as_float(rr[0]), __uint_as_float(rr[1])); }
  if (__builtin_expect(__all(pmax - m_reg <= THR / SCALE), 1)) { mn = m_reg; alpha = 1.f; }
  else { mn = fmaxf(m_reg, pmax); alpha = __builtin_amdgcn_exp2f((m_reg - mn) * C); m_reg = mn; }
  float mnC = -mn * C;
  for (int r = 0; r < 16; ++r) p0[r] = fmaf(p0[r], C, mnC); for (int r = 0; r < 16; ++r) p1[r] = fmaf(p1[r], C, mnC);
  for (int r = 0; r < 16; ++r) p0[r] = __builtin_amdgcn_exp2f(p0[r]);
}
#define PK4(P, BASE, OUT) do { unsigned a0 = cvtpk(P[BASE + 0], P[BASE + 1]), a1 = cvtpk(P[BASE + 2], P[BASE + 3]);   \
    unsigned b0 = cvtpk(P[BASE + 4], P[BASE + 5]), b1 = cvtpk(P[BASE + 6], P[BASE + 7]);                              \
    auto r0 = __builtin_amdgcn_permlane32_swap(a0, b0, false, false); auto r1 = __builtin_amdgcn_permlane32_swap(a1, b1, false, false); \
    u32x4 w = {r0[0], r1[0], r0[1], r1[1]}; OUT = *reinterpret_cast<bf16x8*>(&w); } while (0)
__device__ __forceinline__ void finishSM(f32x16& p0, f32x16& p1, float alpha, float& l_reg, bf16x8& pa0, bf16x8& pa1, bf16x8& pa2, bf16x8& pa3) {
  for (int r = 0; r < 16; ++r) p1[r] = __builtin_amdgcn_exp2f(p1[r]);
  float ps = 0; for (int r = 0; r < 16; ++r) ps += p0[r]; for (int r = 0; r < 16; ++r) ps += p1[r];
  { auto rr = __builtin_amdgcn_permlane32_swap(__float_as_uint(ps), __float_as_uint(ps), false, false);
    ps = __uint_as_float(rr[0]) + __uint_as_float(rr[1]); }
  l_reg = l_reg * alpha + ps;
  PK4(p0, 0, pa0); PK4(p0, 8, pa1); PK4(p1, 0, pa2); PK4(p1, 8, pa3);
}
__device__ __forceinline__ void packP(f32x16& p0, f32x16& p1, bf16x8& pa0, bf16x8& pa1, bf16x8& pa2, bf16x8& pa3) {
  PK4(p0, 0, pa0); PK4(p0, 8, pa1); PK4(p1, 0, pa2); PK4(p1, 8, pa3);
}
__device__ __forceinline__ void decayP(f32x16& p0, f32x16& p1, int e0  , float lgf, float nlgb, bool diag) {
  const float eb = (float)e0;
#pragma unroll
  for (int r = 0; r < 16; ++r) { const float c = (float)((r & 3) + 8 * (r >> 2));
    const float ea = eb - c, ec = eb - 32.f - c;
    float da = __builtin_amdgcn_exp2f(fminf(ea * lgf, ea * nlgb)), dc = __builtin_amdgcn_exp2f(fminf(ec * lgf, ec * nlgb));
    if (diag) { da = ea == 0.f ? 2.f : da; dc = ec == 0.f ? 2.f : dc; }
    p0[r] *= da; p1[r] *= dc; }
}
__device__ __forceinline__ void qkt(f32x16& p0, f32x16& p1, const LAS char* Ks, const bf16x8* qr, int r32, int hi) {
  p0 = f32x16{}; p1 = f32x16{};
#pragma unroll
  for (int d0 = 0; d0 < 8; ++d0) { int cb = (d0 * 16 + hi * 8) * 2;
    bf16x8 b0 = *reinterpret_cast<const LAS bf16x8*>(Ks + KSWZ(r32, cb));
    bf16x8 b1 = *reinterpret_cast<const LAS bf16x8*>(Ks + KSWZ(32 + r32, cb));
    p0 = __builtin_amdgcn_mfma_f32_32x32x16_bf16(b0, qr[d0], p0, 0, 0, 0);
    p1 = __builtin_amdgcn_mfma_f32_32x32x16_bf16(b1, qr[d0], p1, 0, 0, 0); }
}
__device__ __forceinline__ int v_st(int k, int c) { const int kk = (k & ~0xC) | ((k & 4) << 1) | ((k & 8) >> 1); return ((kk >> 3) * 4 + (c >> 5)) * 512 + ((kk & 7) * 32 + (c & 31)) * 2; }
__device__ __forceinline__ int v_rd_base(int lane) { return ((lane & 3) << 3) | (((lane >> 2) & 3) << 6) | (((lane >> 4) & 1) << 5) | (((lane >> 5) & 1) << 8); }
constexpr int v_rd_off(int d0, int ks, int half) { return d0 * 512 + ks * 4096 + half * 2048; }
template <int OFF> __device__ __forceinline__ s16x4 tr_read(int vb) {
  s16x4 r; asm volatile("ds_read_b64_tr_b16 %0, %1 offset:%2" : "=&v"(r) : "v"(vb), "i"(OFF) : "memory"); return r;
}
#define PKLH(L, H) (bf16x8){L[0], L[1], L[2], L[3], H[0], H[1], H[2], H[3]}
template <int D0> __device__ __forceinline__ void pv_one(f32x16& od, int vb, bf16x8 pa0, bf16x8 pa1, bf16x8 pa2, bf16x8 pa3) {
  const s16x4 l0 = tr_read<v_rd_off(D0, 0, 0)>(vb), h0 = tr_read<v_rd_off(D0, 0, 1)>(vb), l1 = tr_read<v_rd_off(D0, 1, 0)>(vb), h1 = tr_read<v_rd_off(D0, 1, 1)>(vb);
  const s16x4 l2 = tr_read<v_rd_off(D0, 2, 0)>(vb), h2 = tr_read<v_rd_off(D0, 2, 1)>(vb), l3 = tr_read<v_rd_off(D0, 3, 0)>(vb), h3 = tr_read<v_rd_off(D0, 3, 1)>(vb);
  asm volatile("s_waitcnt lgkmcnt(0)" ::: "memory"); SBAR();
  od = __builtin_amdgcn_mfma_f32_32x32x16_bf16(pa0, PKLH(l0, h0), od, 0, 0, 0);
  od = __builtin_amdgcn_mfma_f32_32x32x16_bf16(pa1, PKLH(l1, h1), od, 0, 0, 0);
  od = __builtin_amdgcn_mfma_f32_32x32x16_bf16(pa2, PKLH(l2, h2), od, 0, 0, 0);
  od = __builtin_amdgcn_mfma_f32_32x32x16_bf16(pa3, PKLH(l3, h3), od, 0, 0, 0);
}
__device__ __forceinline__ void pv_d0(f32x16* o, int vb, bf16x8 pa0, bf16x8 pa1, bf16x8 pa2, bf16x8 pa3) {
  pv_one<0>(o[0], vb, pa0, pa1, pa2, pa3); pv_one<1>(o[1], vb, pa0, pa1, pa2, pa3); pv_one<2>(o[2], vb, pa0, pa1, pa2, pa3); pv_one<3>(o[3], vb, pa0, pa1, pa2, pa3);
}

template <bool GN> __device__ __forceinline__ void store_tile(const f32x16* o, const float* rowscale  , LAS float* stg, bf16* Ow, int ldo, const bf16* Gw, int ldg, int lane) {
  const int r32 = lane & 31, hi = lane >> 5;
#pragma unroll
  for (int r = 0; r < 16; ++r) { const int orow = crow(r, hi);
#pragma unroll
    for (int d0 = 0; d0 < 4; ++d0) stg[orow * 128 + d0 * 32 + r32] = rowscale ? o[d0][r] * rowscale[r] : o[d0][r]; }
  asm volatile("s_waitcnt lgkmcnt(0)" ::: "memory");
  const int ch = lane & 15;
#pragma unroll
  for (int i = 0; i < 8; ++i) { const int row = (lane >> 4) + 4 * i;
    f32x4 a = *(const LAS f32x4*)(stg + row * 128 + ch * 8), b = *(const LAS f32x4*)(stg + row * 128 + ch * 8 + 4);
    if (GN) {
      float s = (a[0] + a[1]) + (a[2] + a[3]) + (b[0] + b[1]) + (b[2] + b[3]);
      s += shx<1>(s); s += shx<2>(s); s += shx<4>(s); s += shx<8>(s);
      const float mean = s * (1.f / 128.f); a = a - mean; b = b - mean;
      float q = (a[0] * a[0] + a[1] * a[1]) + (a[2] * a[2] + a[3] * a[3]) + (b[0] * b[0] + b[1] * b[1]) + (b[2] * b[2] + b[3] * b[3]);
      q += shx<1>(q); q += shx<2>(q); q += shx<4>(q); q += shx<8>(q);
      const float rs = 1.0f / sqrtf(q * (1.f / 128.f) + EPS);
      const v4u gw = *(const GAS v4u*)(Gw + (size_t)row * ldg + ch * 8);
      const float g0 = bflo(gw.x), g1 = bfhi(gw.x), g2 = bflo(gw.y), g3 = bfhi(gw.y), g4 = bflo(gw.z), g5 = bfhi(gw.z), g6 = bflo(gw.w), g7 = bfhi(gw.w);
      a[0] *= rs * g0 * pg8::fast_sigmoid(g0); a[1] *= rs * g1 * pg8::fast_sigmoid(g1); a[2] *= rs * g2 * pg8::fast_sigmoid(g2); a[3] *= rs * g3 * pg8::fast_sigmoid(g3);
      b[0] *= rs * g4 * pg8::fast_sigmoid(g4); b[1] *= rs * g5 * pg8::fast_sigmoid(g5); b[2] *= rs * g6 * pg8::fast_sigmoid(g6); b[3] *= rs * g7 * pg8::fast_sigmoid(g7);
    }
    u32x4 w = {cvtpk(a[0], a[1]), cvtpk(a[2], a[3]), cvtpk(b[0], b[1]), cvtpk(b[2], b[3])};
    *(GAS u32x4*)(Ow + (size_t)row * ldo + ch * 8) = w; }
  asm volatile("s_waitcnt lgkmcnt(0)" ::: "memory");
}

template <bool RET, int LDQ, int LDK, int LDV, int LDO>
__device__ __forceinline__ void unit_body(const bf16* __restrict__ Qb, const bf16* __restrict__ Kh, const bf16* __restrict__ Vh, bf16* __restrict__ Ob, int seq, LAS char* lds,
                                          int q0  , float lgf, float lgb, const float* S0f, const float* S0b, const bf16* Gb  , int tid0) {
  int tid_ = tid0; asm volatile("" : "+v"(tid_));
  const int tid = tid_, wid = __builtin_amdgcn_readfirstlane(tid >> 6), lane = tid & 63, r32 = lane & 31, hi = lane >> 5;
  LAS char* V_lds = lds; LAS char* K_lds = lds + 2 * SHM_V;
  LAS float* wsf = (LAS float*)(lds + 2 * SHM_V + 2 * SHM_K) + wid * 64; LAS float* li_l = wsf; LAS float* al_l = wsf + 32;
  float m_reg = -1e30f, l_reg = 0; f32x16 o[4] = {}; bf16x8 qr[8];
  const bf16* Qw = Qb + (long)(wid * QBLK + r32) * LDQ + hi * 8;
#pragma unroll
  for (int d0 = 0; d0 < 8; ++d0) qr[d0] = ld8(Qw + d0 * 16);
  const int sr = tid >> 4, sc = (tid & 15) * 8, vst0 = v_st(sr, sc), vst1 = v_st(32 + sr, sc);
  const int vb0 = (int)(unsigned)(size_t)V_lds + v_rd_base(lane);
  const float nlgb = -lgb;
  const int trow = q0 + wid * QBLK + r32;

  if (RET && S0f != nullptr) {
    f32x16 o2[4];
#pragma unroll
    for (int pass = 0; pass < 2; ++pass) {
      const float* S0 = pass == 0 ? S0f : S0b;
#pragma unroll
      for (int half = 0; half < 2; ++half) {
        const f32x8 x0 = *reinterpret_cast<const f32x8*>(S0 + (size_t)(half * 64 + sr) * 128 + sc), x1 = *reinterpret_cast<const f32x8*>(S0 + (size_t)(half * 64 + 32 + sr) * 128 + sc);
        *(LAS bf16x8*)(V_lds + half * SHM_V + vst0) = cvt8(x0); *(LAS bf16x8*)(V_lds + half * SHM_V + vst1) = cvt8(x1);
      }
      __syncthreads();
      if (pass == 0) { pv_d0(o, vb0, qr[0], qr[1], qr[2], qr[3]); pv_d0(o, vb0 + SHM_V, qr[4], qr[5], qr[6], qr[7]); }
      else { for (int d = 0; d < 4; ++d) o2[d] = f32x16{}; pv_d0(o2, vb0, qr[0], qr[1], qr[2], qr[3]); pv_d0(o2, vb0 + SHM_V, qr[4], qr[5], qr[6], qr[7]); }
      __syncthreads();
    }
#pragma unroll
    for (int r = 0; r < 16; ++r) { const int t = q0 + wid * QBLK + crow(r, hi);
      const float wf = __builtin_amdgcn_exp2f((float)(t + 1) * lgf), wb = __builtin_amdgcn_exp2f((float)(seq - t) * lgb);
#pragma unroll
      for (int d = 0; d < 4; ++d) o[d][r] = o[d][r] * wf + o2[d][r] * wb; }
  }

  struct { bf16x8 vs0, vs1, ks0, ks1; } sr_[2];
#define SLOAD(i, k0) do { sr_[i].vs0 = ld8(&Vh[(long)((k0) + sr) * LDV + sc]); sr_[i].vs1 = ld8(&Vh[(long)((k0) + 32 + sr) * LDV + sc]); \
    sr_[i].ks0 = ld8(&Kh[(long)((k0) + sr) * LDK + sc]); sr_[i].ks1 = ld8(&Kh[(long)((k0) + 32 + sr) * LDK + sc]); } while (0)
#define SWRITE(b, i) do { *(LAS bf16x8*)(V_lds + (b) * SHM_V + vst0) = sr_[i].vs0;          \
    *(LAS bf16x8*)(V_lds + (b) * SHM_V + vst1) = sr_[i].vs1; int kc = sc * 2;               \
    *(LAS bf16x8*)(K_lds + (b) * SHM_K + KSWZ(sr, kc)) = sr_[i].ks0;                       \
    *(LAS bf16x8*)(K_lds + (b) * SHM_K + KSWZ(32 + sr, kc)) = sr_[i].ks1; } while (0)
#define SWAIT() asm volatile("s_waitcnt vmcnt(4)" ::: "memory")
#define RESC(a) do { if (!RET) { if (__any((a) < 1.f)) { if (hi == 0) al_l[r32] = (a); asm volatile("s_waitcnt lgkmcnt(0)" ::: "memory"); \
    for (int d = 0; d < 4; ++d) for (int r = 0; r < 16; ++r) o[d][r] *= al_l[crow(r, hi)]; } } } while (0)
#define SM1(P0, P1, MN, AL, TILE) do { if (RET) { const int k0_ = (TILE) * KVBLK; const bool dg_ = (k0_ <= q0 + wid * QBLK + 31) && (k0_ + 63 >= q0 + wid * QBLK); \
      decayP(P0, P1, trow - k0_ - 4 * hi, lgf, nlgb, dg_); } else partialSM(P0, P1, m_reg, MN, AL); } while (0)
#define SM2(P0, P1, AL) do { if (RET) packP(P0, P1, pa0, pa1, pa2, pa3); else finishSM(P0, P1, AL, l_reg, pa0, pa1, pa2, pa3); } while (0)
  f32x16 pA0, pA1, pB0, pB1; float mnA = 0.f, mnB = 0.f, alA = 1.f, alB = 1.f; bf16x8 pa0, pa1, pa2, pa3; const int NT = seq / KVBLK;
  constexpr int SE = 0, SO = 1;
  SLOAD(SE, 0); asm volatile("s_waitcnt vmcnt(0)" ::: "memory"); SWRITE(0, SE); __syncthreads();
  qkt(pA0, pA1, K_lds, qr, r32, hi); SM1(pA0, pA1, mnA, alA, 0);
  SLOAD(SO, KVBLK); if (2 < NT) SLOAD(SE, 2 * KVBLK);
  SWAIT(); SWRITE(1, SO); __syncthreads();
  for (int j = 1; j + 1 < NT; j += 2) {
    SBAR(); qkt(pB0, pB1, K_lds + SHM_K, qr, r32, hi);
    SM2(pA0, pA1, alA); SBAR();
    SLOAD(SO, (j + 2) * KVBLK); SBAR();
    pv_d0(o, vb0, pa0, pa1, pa2, pa3); SM1(pB0, pB1, mnB, alB, j);
    __syncthreads(); SWAIT(); SWRITE(0, SE);
    RESC(alB); __syncthreads();
    SBAR(); qkt(pA0, pA1, K_lds, qr, r32, hi);
    SM2(pB0, pB1, alB); SBAR();
    if (j + 3 < NT) SLOAD(SE, (j + 3) * KVBLK); SBAR();
    pv_d0(o, vb0 + (int)SHM_V, pa0, pa1, pa2, pa3); SM1(pA0, pA1, mnA, alA, j + 1);
    __syncthreads(); SWAIT(); SWRITE(1, SO);
    RESC(alA); __syncthreads();
  }
  SBAR(); qkt(pB0, pB1, K_lds + SHM_K, qr, r32, hi);
  SM2(pA0, pA1, alA); SBAR();
  pv_d0(o, vb0, pa0, pa1, pa2, pa3); SM1(pB0, pB1, mnB, alB, NT - 1);
  __syncthreads(); RESC(alB);
  SM2(pB0, pB1, alB); SBAR();
  pv_d0(o, vb0 + (int)SHM_V, pa0, pa1, pa2, pa3);
  float rli[16];
  if (!RET) {
    if (hi == 0) li_l[r32] = l_reg; asm volatile("s_waitcnt lgkmcnt(0)" ::: "memory");
#pragma unroll
    for (int r = 0; r < 16; ++r) rli[r] = __builtin_amdgcn_rcpf(li_l[crow(r, hi)]);
  }
  __syncthreads();
  LAS float* stg = (LAS float*)(lds + wid * 16384);
  store_tile<RET>(o, RET ? nullptr : rli, stg, Ob + (size_t)(wid * QBLK) * LDO, LDO, RET ? Gb + (size_t)(wid * QBLK) * INW : nullptr, INW, lane);
  __syncthreads();
#undef SLOAD
#undef SWRITE
#undef SWAIT
#undef RESC
#undef SM1
#undef SM2
}

__device__ __forceinline__ void ret_state_unit(const bf16* __restrict__ Kh  , const bf16* __restrict__ Vh  , float* __restrict__ outF, float* __restrict__ outB, float lgf, float lgb, LAS char* lds, int tid0) {
  int tid_ = tid0; asm volatile("" : "+v"(tid_));
  const int tid = tid_, wid = __builtin_amdgcn_readfirstlane(tid >> 6), lane = tid & 63, r32 = lane & 31, hi = lane >> 5;
  const int sr = tid >> 4, sc = (tid & 15) * 8, vst0 = v_st(sr, sc), vst1 = v_st(32 + sr, sc);
  LAS char* KF = lds; LAS char* KB = lds + 16384; LAS char* VV = lds + 32768;
  const int dir = wid >> 2, Dd = wid & 3;
  const int ab = (int)(unsigned)(size_t)(dir ? KB : KF) + v_rd_base(lane) + Dd * 512;
  const int bb = (int)(unsigned)(size_t)VV + v_rd_base(lane);
  f32x16 acc[4] = {};
  for (int tile = 0; tile < SEQ / 64; ++tile) {
    const int s0 = tile * 64 + sr, s1 = s0 + 32;
    const bf16x8 k0 = ld8(Kh + (size_t)s0 * 512 + sc), k1 = ld8(Kh + (size_t)s1 * 512 + sc), v0 = ld8(Vh + (size_t)s0 * INW + sc), v1 = ld8(Vh + (size_t)s1 * INW + sc);
    const float wf0 = exp2f((float)(SEQ - 1 - s0) * lgf), wf1 = exp2f((float)(SEQ - 1 - s1) * lgf), wb0 = exp2f((float)s0 * lgb), wb1 = exp2f((float)s1 * lgb);
    f32x8 x0, x1;
#pragma unroll
    for (int j = 0; j < 8; ++j) { x0[j] = bf2f((unsigned short)k0[j]); x1[j] = bf2f((unsigned short)k1[j]); }
    *(LAS bf16x8*)(KF + vst0) = cvt8(x0 * wf0); *(LAS bf16x8*)(KF + vst1) = cvt8(x1 * wf1);
    *(LAS bf16x8*)(KB + vst0) = cvt8(x0 * wb0); *(LAS bf16x8*)(KB + vst1) = cvt8(x1 * wb1);
    *(LAS bf16x8*)(VV + vst0) = v0; *(LAS bf16x8*)(VV + vst1) = v1;
    __syncthreads();
#define RS_STEP(KS) do { const s16x4 al = tr_read<v_rd_off(0, KS, 0)>(ab), ah = tr_read<v_rd_off(0, KS, 1)>(ab); \
      const s16x4 l0 = tr_read<v_rd_off(0, KS, 0)>(bb), h0 = tr_read<v_rd_off(0, KS, 1)>(bb), l1 = tr_read<v_rd_off(1, KS, 0)>(bb), h1 = tr_read<v_rd_off(1, KS, 1)>(bb); \
      const s16x4 l2 = tr_read<v_rd_off(2, KS, 0)>(bb), h2 = tr_read<v_rd_off(2, KS, 1)>(bb), l3 = tr_read<v_rd_off(3, KS, 0)>(bb), h3 = tr_read<v_rd_off(3, KS, 1)>(bb); \
      asm volatile("s_waitcnt lgkmcnt(0)" ::: "memory"); SBAR(); const bf16x8 af = PKLH(al, ah); \
      acc[0] = __builtin_amdgcn_mfma_f32_32x32x16_bf16(af, PKLH(l0, h0), acc[0], 0, 0, 0); acc[1] = __builtin_amdgcn_mfma_f32_32x32x16_bf16(af, PKLH(l1, h1), acc[1], 0, 0, 0); \
      acc[2] = __builtin_amdgcn_mfma_f32_32x32x16_bf16(af, PKLH(l2, h2), acc[2], 0, 0, 0); acc[3] = __builtin_amdgcn_mfma_f32_32x32x16_bf16(af, PKLH(l3, h3), acc[3], 0, 0, 0); } while (0)
    RS_STEP(0); RS_STEP(1); RS_STEP(2); RS_STEP(3);
#undef RS_STEP
    __syncthreads();
  }
  float* out = dir ? outB : outF;
#pragma unroll
  for (int r = 0; r < 16; ++r) { const int d = Dd * 32 + crow(r, hi);
#pragma unroll
    for (int e = 0; e < 4; ++e) out[(size_t)d * 128 + e * 32 + r32] = acc[e][r]; }
}

#ifndef S5_OLD_FMA
#define S5_OLD_FMA 0
#endif
#ifndef S5_OLD_ADDR
#define S5_OLD_ADDR 0
#endif
using f32x4m = __attribute__((ext_vector_type(4))) float;
__device__ __forceinline__ unsigned cvtpk_s(float lo, float hi) { return pg8::cvt_pk_bf16(lo, hi); }
__device__ __forceinline__ float gelu_fast(float x) { const float u = 0.7978845608028654f * (x + 0.044715f * x * x * x); return x * pg8::fast_sigmoid(2.0f * u); }
template <bool OUT, int DIR>
__device__ __forceinline__ void s5_seg_d(KA a, int l, int m0, int t_lo, int len, int g, float& hr, float& hi_, LAS char* wl, int lane) {
  unsigned char* ws = a->ws;
  const bf16* proj = (const bf16*)(ws + WS_PROJ);
  float* YS = (float*)(ws + WS_YS); bf16* YSB = (bf16*)(ws + WS_YSB);
  const int r32 = lane & 31, hi = lane >> 5, fr = lane & 15, q = lane >> 4;
  LAS float* BU = (LAS float*)wl;
  const int ldg = (l * 2 + DIR) * 32 + g;
  const float* lamT = (const float*)(ws + WS_LAM) + ((size_t)ldg * 64 + lane) * 2;
  const float lr = lamT[0], li = lamT[1], nli = -li;
  bf16x8 bfr[4], cfr[4]; float dcoef = 0.f;
  {
    const float* bbT = (const float*)(ws + WS_BBAR);
#pragma unroll
    for (int pb = 0; pb < 2; ++pb) { const GAS f32x4* bp = (const GAS f32x4*)(bbT + (((size_t)ldg * 64 + 32 * pb + r32) * 16 + 8 * hi) * 2);
      const f32x4 w0 = bp[0], w1 = bp[1], w2 = bp[2], w3 = bp[3];
      bfr[pb] = cvt8((f32x8){w0[0], w0[2], w1[0], w1[2], w2[0], w2[2], w3[0], w3[2]});
      bfr[2 + pb] = cvt8((f32x8){w0[1], w0[3], w1[1], w1[3], w2[1], w2[3], w3[1], w3[3]}); }
    if (OUT) {
      dcoef = a->in[I_SSMD][l * 512 + g * 16 + fr];
      const float* cre = a->in[I_CRE] + ((size_t)ldg * 16 + fr) * 64 + 4 * q; const float* cim = a->in[I_CIM] + ((size_t)ldg * 16 + fr) * 64 + 4 * q;
#pragma unroll
      for (int ks = 0; ks < 4; ++ks) { const f32x4 cr = *(const GAS f32x4*)(cre + 16 * ks), ci = *(const GAS f32x4*)(cim + 16 * ks);
        cfr[ks] = cvt8((f32x8){cr[0], -ci[0], cr[1], -ci[1], cr[2], -ci[2], cr[3], -ci[3]}); }
    }
  }
  LAS unsigned* hw[16];
#pragma unroll
  for (int j = 0; j < 16; ++j) hw[j] = (LAS unsigned*)BU + (lane ^ (4 * j));
  const LAS bf16x8* hrd[4];
#pragma unroll
  for (int ks = 0; ks < 4; ++ks) hrd[ks] = (const LAS bf16x8*)((LAS unsigned*)BU + fr * 128 + ((16 * ks + 4 * q) ^ (4 * fr)));
  const LAS float* brd = BU + lane;
  const int NC = len / 32;
  const bf16* ubase = proj + (size_t)m0 * INW + C_US + g * 16;
#define S5_T0(c) (DIR == 0 ? t_lo + 32 * (c) : t_lo + len - 32 * ((c) + 1))
  bf16x8 ua_next = ld8(ubase + (size_t)(S5_T0(0) + r32) * INW + 8 * hi);
#pragma unroll 1
  for (int c = 0; c < NC; ++c) {
    const int T0 = S5_T0(c);
    const bf16x8 ua = ua_next;
    if (c + 1 < NC) ua_next = ld8(ubase + (size_t)(S5_T0(c + 1) + r32) * INW + 8 * hi);
    float ysv[8]; unsigned short uv[8];
    const size_t mrow = (size_t)(m0 + T0 + 4 * q);
    if (OUT && DIR == 0) {
#pragma unroll
      for (int k = 0; k < 8; ++k) { const size_t m = mrow + 16 * (k >> 2) + (k & 3); ysv[k] = YS[m * 512 + g * 16 + fr]; uv[k] = proj[m * INW + C_US + g * 16 + fr]; }
    }
#pragma unroll
    for (int tile = 0; tile < 4; ++tile) {
      const f32x16 d = __builtin_amdgcn_mfma_f32_32x32x16_bf16(ua, bfr[tile], f32x16{}, 0, 0, 0);
#pragma unroll
      for (int r = 0; r < 16; ++r) BU[crow(r, hi) * 128 + tile * 32 + r32] = d[r];
    }
    asm volatile("s_waitcnt lgkmcnt(0)" ::: "memory");
#pragma unroll
    for (int half = 0; half < 2; ++half) {
      float bre[16], bim[16];
#pragma unroll
      for (int k = 0; k < 16; ++k) { constexpr int dummy = 0; const int i = DIR == 0 ? half * 16 + k : 31 - half * 16 - k; bre[k] = brd[i * 128]; bim[k] = brd[i * 128 + 64]; }
      asm volatile("s_waitcnt lgkmcnt(0)" ::: "memory");
#pragma unroll
      for (int k = 0; k < 16; ++k) { const int i = DIR == 0 ? half * 16 + k : 31 - half * 16 - k;
#if S5_OLD_FMA
        const float nr = lr * hr - li * hi_ + bre[k], ni = lr * hi_ + li * hr + bim[k]; hr = nr; hi_ = ni;
#else
        const float nr = fmaf(lr, hr, fmaf(nli, hi_, bre[k])), ni = fmaf(lr, hi_, fmaf(li, hr, bim[k])); hr = nr; hi_ = ni;
#endif
#if S5_OLD_ADDR
        if (OUT) ((LAS unsigned*)BU)[i * 128 + (lane ^ (4 * (i & 15)))] = cvtpk(hr, hi_); }
#else
        if (OUT) hw[i & 15][i * 128] = cvtpk_s(hr, hi_); }
#endif
    }
    if (OUT) {
      asm volatile("s_waitcnt lgkmcnt(0)" ::: "memory");
#pragma unroll
      for (int mt = 0; mt < 2; ++mt) {
        f32x4m y = {0.f, 0.f, 0.f, 0.f};
#pragma unroll
        for (int ks = 0; ks < 4; ++ks) {
#if S5_OLD_ADDR
          const int i_ = 16 * mt + fr; const bf16x8 hf = *(const LAS bf16x8*)((LAS unsigned*)BU + i_ * 128 + ((16 * ks + 4 * q) ^ (4 * (i_ & 15))));
#else
          const bf16x8 hf = hrd[ks][mt * 16 * 32];
#endif
          y = __builtin_amdgcn_mfma_f32_16x16x32_bf16(hf, cfr[ks], y, 0, 0, 0); }
#pragma unroll
        for (int rg = 0; rg < 4; ++rg) { const size_t m = mrow + 16 * mt + rg;
          if (DIR == 1) YS[m * 512 + g * 16 + fr] = y[rg];
          else { const float yt = y[rg] + ysv[mt * 4 + rg] + dcoef * bf2f(uv[mt * 4 + rg]);
            YSB[m * 512 + g * 16 + fr] = (bf16)f2bf(gelu_fast(yt)); } }
      }
    }
    asm volatile("s_waitcnt lgkmcnt(0)" ::: "memory");
  }
  asm volatile("s_waitcnt vmcnt(0)" ::: "memory");
#undef S5_T0
}
template <bool OUT>
__device__ __forceinline__ void s5_seg(KA a, int l, int m0, int t_lo, int len, int g, int dir, float& hr, float& hi_, LAS char* wl, int lane) {
  if (dir == 0) s5_seg_d<OUT, 0>(a, l, m0, t_lo, len, g, hr, hi_, wl, lane); else s5_seg_d<OUT, 1>(a, l, m0, t_lo, len, g, hr, hi_, wl, lane);
}
__device__ __forceinline__ void s5_ctx_wave(KA a, int l, int b, int g, LAS char* lds, int tid0) {
  int tid_ = tid0; asm volatile("" : "+v"(tid_));
  const int lane = tid_ & 63; LAS char* wl = lds + __builtin_amdgcn_readfirstlane(tid_ >> 6) * 16384;
#pragma unroll 1
  for (int dir = 1; dir >= 0; --dir) {
    float hr = 0.f, hi_ = 0.f;
    s5_seg<true>(a, l, b * SEQ, 0, SEQ, g, dir, hr, hi_, wl, lane);
    float* o = a->out + O_SSM + (((((size_t)b * NLAYER + l) * 2 + dir) * 32 + g) * 64 + lane) * 2; o[0] = hr; o[1] = hi_;
  }
}
constexpr int S5X_OFF = RING_BYTES + 1024;
__device__ __forceinline__ void s5_lat_unit(KA a, int l, int v  , LAS char* lds, int tid0) {
  int tid_ = tid0; asm volatile("" : "+v"(tid_));
  const int lane = tid_ & 63, wid = __builtin_amdgcn_readfirstlane(tid_ >> 6); LAS char* wl = lds + wid * 16384;
  const int pr = wid >> 2, seg = wid & 3, bg = 2 * v + pr, b = bg >> 5, g = bg & 31;
  const int m0 = NPR + b * DSEQ;
  LAS float* X = (LAS float*)(lds + S5X_OFF);
#pragma unroll 1
  for (int dir = 1; dir >= 0; --dir) {
    float hr = 0.f, hi_ = 0.f;
    const bool last = dir == 0 ? seg == 3 : seg == 0;
    if (!last) s5_seg<false>(a, l, m0, seg * 256, 256, g, dir, hr, hi_, wl, lane);
    X[(((pr * 2 + dir) * 4 + seg) * 64 + lane) * 2] = hr; X[(((pr * 2 + dir) * 4 + seg) * 64 + lane) * 2 + 1] = hi_;
  }
  __syncthreads();
#pragma unroll 1
  for (int dir = 1; dir >= 0; --dir) {
    const int ldg = (l * 2 + dir) * 32 + g;
    const float* lamT = (const float*)(a->ws + WS_LAM) + ((size_t)ldg * 64 + lane) * 2;
    float pr_ = lamT[0], pi_ = lamT[1];
#pragma unroll
    for (int k = 0; k < 8; ++k) { const float nr = pr_ * pr_ - pi_ * pi_, ni = 2.f * pr_ * pi_; pr_ = nr; pi_ = ni; }
    const float* h0 = a->in[I_SSSM] + (((((size_t)b * NLAYER + l) * 2 + dir) * 32 + g) * 64 + lane) * 2;
    float hr = h0[0], hi_ = h0[1];
    const int nprev = dir == 0 ? seg : 3 - seg;
    for (int k = 0; k < nprev; ++k) { const int sk = dir == 0 ? k : 3 - k;
      const float fr_ = X[(((pr * 2 + dir) * 4 + sk) * 64 + lane) * 2], fi_ = X[(((pr * 2 + dir) * 4 + sk) * 64 + lane) * 2 + 1];
      const float nr = pr_ * hr - pi_ * hi_ + fr_, ni = pr_ * hi_ + pi_ * hr + fi_; hr = nr; hi_ = ni; }
    s5_seg<true>(a, l, m0, seg * 256, 256, g, dir, hr, hi_, wl, lane);
  }
}
#undef KSWZ
#undef SBAR
#undef PK4
#undef PKLH
}

__device__ __forceinline__ void decay_log2(KA a, int l, int h, float& lgf, float& lgb) {
    const float xf = a->in[I_DECAY][(l * 2 + 0) * 4 + h], xb = a->in[I_DECAY][(l * 2 + 1) * 4 + h];
    lgf = -log1pf(expf(-xf)) * 1.4426950408889634f; lgb = -log1pf(expf(-xb)) * 1.4426950408889634f;
}

constexpr int MX_NBIG = 128, MX_NUNITS = 448;
__device__ __forceinline__ void mixer_unit(const Frame& F, KA a, int l, int u, int kmask) {
  unsigned char* ws = a->ws; LAS char* lds = (LAS char*)F.lds;
  const bf16* proj = (const bf16*)(ws + WS_PROJ);
  int kind, lat, b, h = 0, qb = 0, v;
  const int wv_ = F.wave;
  if (u < 64) { kind = 0; lat = 1; qb = u & 3; h = (u >> 2) & 7; b = u >> 5; }
  else if (u < 96) { v = u - 64; kind = 1; lat = 1; qb = v & 3; h = (v >> 2) & 3; b = v >> 4; }
  else if (u < 128) { v = u - 96; kind = 2; lat = 1; b = 0; h = v; }
  else if (u < 256) { v = u - 128; kind = 0; lat = 0; h = v & 7; b = v >> 3; }
  else if (u < 320) { v = u - 256; kind = 1; lat = 0; h = v & 3; b = v >> 2; }
  else if (u < 384) { v = (u - 320) * 8 + wv_; kind = 2; lat = 0; b = v >> 5; h = v & 31; }
  else { v = u - 384; kind = 3; lat = 0; h = v & 3; b = v >> 2; }
  if (!((kmask >> (kind + 4 * lat)) & 1)) return;
  const size_t m0 = lat ? NPR + (size_t)b * DSEQ : (size_t)b * SEQ;
  const size_t m = m0 + (size_t)qb * 256;
  const int L = lat ? DSEQ : SEQ;
#ifndef MXK
#define MXK 15
#endif
  if (kind == 0) { if (MXK & 1) {
    const bf16* Kb = lat ? (const bf16*)(ws + WS_KS) + (size_t)b * KALL * 256 : (const bf16*)(ws + WS_KP) + m0 * 256;
    const bf16* Vb = lat ? (const bf16*)(ws + WS_VS) + (size_t)b * KALL * 256 : (const bf16*)(ws + WS_VP) + m0 * 256;
    mx::unit_body<false, 1024, 256, 256, DM>((const bf16*)(ws + WS_QB) + m * 1024 + h * 128, Kb + (h >> 2) * 128, Vb + (h >> 2) * 128, (bf16*)(ws + WS_MIX) + m * DM + h * 128,
        lat ? KALL : SEQ, lds, 0, 0.f, 0.f, nullptr, nullptr, nullptr, F.tid); }
  } else if (kind == 1) { if (MXK & 2) {
    float lgf, lgb; decay_log2(a, l, h, lgf, lgb);
    const float* S0f = lat ? a->in[I_SRET] + ((((size_t)b * NLAYER + l) * 2 + 0) * 4 + h) * 16384 : nullptr;
    const float* S0b = lat ? a->in[I_SRET] + ((((size_t)b * NLAYER + l) * 2 + 1) * 4 + h) * 16384 : nullptr;
    mx::unit_body<true, 512, 512, INW, DM>((const bf16*)(ws + WS_QR) + m * 512 + h * 128, (const bf16*)(ws + WS_KR) + m0 * 512 + h * 128, proj + m0 * INW + C_VR + h * 128,
        (bf16*)(ws + WS_MIX) + m * DM + 1536 + h * 128, L, lds, qb * 256, lgf, lgb, S0f, S0b, proj + m * INW + C_GR + h * 128, F.tid); }
  } else if (kind == 2) { if (MXK & 4)
    if (lat) mx::s5_lat_unit(a, l, h, lds, F.tid); else mx::s5_ctx_wave(a, l, b, h, lds, F.tid);
  } else if (MXK & 8) {
    float lgf, lgb; decay_log2(a, l, h, lgf, lgb);
    float* oF = a->out + O_RET + ((((size_t)b * NLAYER + l) * 2 + 0) * 4 + h) * 16384; float* oB = a->out + O_RET + ((((size_t)b * NLAYER + l) * 2 + 1) * 4 + h) * 16384;
    mx::ret_state_unit((const bf16*)(ws + WS_KR) + m0 * 512 + h * 128, proj + m0 * INW + C_VR + h * 128, oF, oB, lgf, lgb, lds, F.tid);
  }
}
__device__ __forceinline__ void phase_mixer(const Frame& F, KA a, int l, int kmask = 255) {
  const int w = blockIdx.x;
  if (F.G == 256) {
    if (w < MX_NBIG) { mixer_unit(F, a, l, w, kmask); __syncthreads(); }
    else { for (int u = w; u < MX_NUNITS; u += 256 - MX_NBIG) { mixer_unit(F, a, l, u, kmask); __syncthreads(); } }
  } else { for (int u = w; u < MX_NUNITS; u += F.G) { mixer_unit(F, a, l, u, kmask); __syncthreads(); } }
}

constexpr int N_PHASES = 26;

__device__ __forceinline__ int cur_tid(int widS) { unsigned z = 0; asm volatile("" : "+s"(z)); const int lane = (int)__builtin_amdgcn_mbcnt_hi(~0u, __builtin_amdgcn_mbcnt_lo(~0u, z)); return widS * 64 + lane; }
__device__ __forceinline__ Frame mkframe(LAS unsigned char* lds, int widS) {
    Frame F; F.tid = cur_tid(widS);
    F.lds = lds; F.lane = F.tid & 63; F.wave = widS;
    F.G = gridDim.x; F.gw = blockIdx.x * NWAVES + F.wave; F.NGW = F.G * NWAVES; return F;
}
template <class Epi> __device__ __forceinline__ void run_gemm(LAS unsigned char* lds, int widS, KA a, const bf16* A, const bf16* Bt, int N, int K, const Epi& E, int slot) {
    { pg8::Gemm g{A, Bt, MT, N, K}; pg8::StaticOrder S; S.init(MT, N, (int)gridDim.x, (int)blockIdx.x);
      pg8::gemm_phase<Epi, pg8::StaticOrder, true, true>(lds, g, S, E, cur_tid(widS)); }
    if (slot >= 0) { const Frame F = mkframe(lds, widS); side_jobs(F, a, slot); }
}
#define FR mkframe((LAS unsigned char*)lds, widS)
__global__ void __launch_bounds__(NWAVES * 64, 2) trunk_fwd(KArgs args) {
    extern __shared__ __attribute__((aligned(16))) unsigned char lds[];
    const int widS = __builtin_amdgcn_readfirstlane((int)threadIdx.x >> 6);
    volatile LAS unsigned* MISC = (volatile LAS unsigned*)((LAS unsigned char*)lds + MISC_OFF);
    for (int u = threadIdx.x; u < (LDS_BYTES - LDSCTL_OFF) / 4; u += NWAVES * 64) ((LAS unsigned*)((LAS unsigned char*)lds + LDSCTL_OFF))[u] = 0u;
    __syncthreads();
    unsigned* ctl = (unsigned*)(args.ws + WS_CTL);
    XcdBarrier bar; bar.bar = ctl + CW_BAR; bar.x = 0; bar.st = nullptr;
    const bool multi = (args.ph_hi - args.ph_lo) > 1;
    if (multi) bar = xcd_barrier_post(ctl + CW_BAR, MISC + 8);

    for (int ph = args.ph_lo; ph < args.ph_hi; ++ph) {
        KA ap; { unsigned long long p_ = (unsigned long long)__builtin_amdgcn_kernarg_segment_ptr(); asm volatile("" : "+s"(p_)); ap = (KA)p_; }
        unsigned char* ws = ap->ws;
#ifndef PH_MASK
#define PH_MASK 0xFFFF
#endif
#ifndef MIXER_DUP_KMASK
#define MIXER_DUP_KMASK 255
#endif
#ifndef DUP_MASK
#define DUP_MASK 0
#endif
#define SLOT(x) (rep_ == 1 ? (x) : -1)
#define DUPB(bit, stmt) for (int rep_ = (DUP_MASK & (bit)) ? 0 : 1; rep_ < 2; ++rep_) { stmt; if (rep_ == 0) xcd_barrier(bar, cur_tid(widS)); }
        if (ph == 0) { if (DUP_MASK & 512) { phase_prologue(FR, ap, 4); xcd_barrier(bar, cur_tid(widS)); } if (PH_MASK & 1) phase_prologue(FR, ap, 11); }
        else if (ph == N_PHASES - 1) { DUPB(2, phase_prenorm(FR, ap, 0, 3)) }
        else {
            const int l = (ph - 1) / 12, s = (ph - 1) % 12;
            const float* modl = (const float*)(ws + WS_MOD) + (size_t)l * 3 * MODW;
            switch (s) {
                case 0: DUPB(2, phase_prenorm(FR, ap, l, 0)); break;
                case 3: DUPB(2, phase_prenorm(FR, ap, l, 1)); break;
                case 9: DUPB(2, phase_prenorm(FR, ap, l, 2)); break;
                case 1: case 10: {
                    const int i = s == 1 ? 0 : 1;
                    pg8::EpiPair<0> E{(bf16*)(ws + WS_ACT), DFF, 0};
                    DUPB(4, run_gemm((LAS unsigned char*)lds, widS, ap, (const bf16*)(ws + WS_H), (const bf16*)(ws + WS_WFI) + (size_t)(l * 2 + i) * 2 * DFF * DM, 2 * DFF, DM, E, SLOT(l == 0 ? (i == 0 ? 1 : 5) : (i == 0 ? 7 : -1)))); break; }
                case 2: case 11: {
                    const int i = s == 2 ? 0 : 1, sub = s == 2 ? 0 : 2;
                    pg8::EpiResid E{(float*)(ws + WS_XR), modl + sub * 3 * DM + 2 * DM, MODW, 0.5f, (l == 0 && i == 0) ? ap->in[I_XP] : nullptr, (l == 0 && i == 0) ? ap->in[I_XS] : nullptr};
                    DUPB(8, { pg8::EpiResid E0 = E; if (rep_ == 0) E0.s = 0.f; run_gemm((LAS unsigned char*)lds, widS, ap, (const bf16*)(ws + WS_ACT), (const bf16*)(ws + WS_WFO) + (size_t)(l * 2 + i) * DM * DFF, DM, DFF, E0, SLOT(l == 0 ? (i == 0 ? 2 : 6) : -1)); }); break; }
                case 4: {
                    pg8::EpiBf16 E{(bf16*)(ws + WS_PROJ), INW};
                    DUPB(16, run_gemm((LAS unsigned char*)lds, widS, ap, (const bf16*)(ws + WS_H), (const bf16*)(ws + WS_WIN) + (size_t)l * INW * DM, INW, DM, E, SLOT(l == 0 ? 3 : -1))); break; }
                case 5: DUPB(32, phase_qkvpost(FR, ap, l)); break;
                case 6: DUPB(64, phase_mixer(FR, ap, l, rep_ == 0 ? MIXER_DUP_KMASK : 255)); break;
                case 7: {
                    pg8::EpiPair<1> E{(bf16*)(ws + WS_MIX), DM, 1024};
                    DUPB(128, run_gemm((LAS unsigned char*)lds, widS, ap, (const bf16*)(ws + WS_YSB), (const bf16*)(ws + WS_WGLU) + (size_t)l * 1024 * 512, 1024, 512, E, -1)); break; }
                case 8: {
                    pg8::EpiResid E{(float*)(ws + WS_XR), modl + 1 * 3 * DM + 2 * DM, MODW, 1.0f, nullptr, nullptr};
                    DUPB(256, { pg8::EpiResid E0 = E; if (rep_ == 0) E0.s = 0.f; run_gemm((LAS unsigned char*)lds, widS, ap, (const bf16*)(ws + WS_MIX), (const bf16*)(ws + WS_WOUT) + (size_t)l * DM * DM, DM, DM, E0, SLOT(l == 0 ? 4 : -1)); }); break; }
                default: break;
            }
        }
        if (ph + 1 < args.ph_hi) xcd_barrier(bar, cur_tid(widS));
    }
}

extern "C" void kernel_launch(void* const* d_in, const int* in_sizes, int n_in, void* d_out, int out_size, void* d_ws, size_t ws_size, hipStream_t stream) {
    static int grid = 0;
    if (grid == 0) {
        if (n_in != 28 || out_size != (int)O_END || ws_size < WS_END) { fprintf(stderr, "kernel_launch: unexpected shapes: n_in %d out %d ws %zu (need >= %zu)\n", n_in, out_size, ws_size, (size_t)WS_END); grid = -1; return; }
        int dev = 0, cus = 0, per_cu = 0;
        if (hipGetDevice(&dev) != hipSuccess || hipDeviceGetAttribute(&cus, hipDeviceAttributeMultiprocessorCount, dev) != hipSuccess) { fprintf(stderr, "kernel_launch: device query failed\n"); grid = -1; return; }
        if (hipFuncSetAttribute((const void*)trunk_fwd, hipFuncAttributeMaxDynamicSharedMemorySize, LDS_BYTES) != hipSuccess) { fprintf(stderr, "kernel_launch: hipFuncSetAttribute failed\n"); grid = -1; return; }
        if (hipOccupancyMaxActiveBlocksPerMultiprocessor(&per_cu, (const void*)trunk_fwd, NWAVES * 64, LDS_BYTES) != hipSuccess || per_cu < 1) { fprintf(stderr, "kernel_launch: occupancy query says %d blocks per CU\n", per_cu); (void)hipGetLastError(); grid = -1; return; }
        grid = cus;
        if (grid > 256) grid = 256;
    }
    if (grid < 0) return;
    (void)hipMemsetAsync((char*)d_ws + WS_CTL, 0, CTL_ZERO_BYTES, stream);
    KArgs a{};
    for (int i = 0; i < 28; ++i) a.in[i] = (const float*)d_in[i];
    a.out = (float*)d_out; a.ws = (unsigned char*)d_ws;
#if MK_ONE_LAUNCH
    a.ph_lo = 0; a.ph_hi = N_PHASES; a.li = 0;
    hipLaunchKernelGGL(trunk_fwd, dim3(grid), dim3(NWAVES * 64), LDS_BYTES, stream, a);
#else
    for (int ph = 0; ph < N_PHASES; ++ph) { a.ph_lo = ph; a.ph_hi = ph + 1; a.li = ph;
        hipLaunchKernelGGL(trunk_fwd, dim3(grid), dim3(NWAVES * 64), LDS_BYTES, stream, a); }
#endif
    const hipError_t le = hipPeekAtLastError();
    if (le != hipSuccess) fprintf(stderr, "kernel_launch: launch failed: %s\n", hipGetErrorName(le));
}
```
